# Optimizing an MI355X kernel written in HIP

```python
import math
import jax, jax.numpy as jnp
from jax import lax
import numpy as np

D_MODEL = 2048
BATCH = 2
SEQ = 4096
DEPTH = 1

GRID_W = 64
CTX_LEN = 256
MIX_WIDTH = D_MODEL
HG_WIDTH = MIX_WIDTH // 2
DA_WIDTH = MIX_WIDTH - HG_WIDTH
HG_EXPAND = 128
HG_HEADS = HG_WIDTH // HG_EXPAND
HG_CHUNK = 64
DA_HEAD_DIM = 64
DA_V_DIM = 2 * DA_HEAD_DIM
DA_HEADS = DA_WIDTH // DA_V_DIM
Q_BLOCK = 128
ROPE_BASE = 10000.0
PEER_HEADS = 8
PEER_NKEYS = 128
PEER_EXPERTS = PEER_NKEYS * PEER_NKEYS
PEER_QDIM = 256
PEER_TOPK = 16
PEER_BLOCK = 128
RMS_EPS = 1e-6
IN_WIDTHS = (HG_WIDTH,) * 5 + (DA_WIDTH,) * 3
IN_COLS = sum(IN_WIDTHS)
IN_SPLITS = tuple(int(s) for s in np.cumsum(IN_WIDTHS)[:-1])

kernel_name = 'hybrid_hgrn2_diffattn_peer_block'

F32 = jnp.float32


def rmsnorm(x, g):
    xf = x.astype(F32)
    y = xf * lax.rsqrt(jnp.mean(xf * xf, axis=-1, keepdims=True) + RMS_EPS)
    return (y * g.astype(F32)).astype(x.dtype)


def split_heads(t, n_heads):
    b, s, _ = t.shape
    return t.reshape(b, s, n_heads, -1).transpose(0, 2, 1, 3)


def merge_heads(t):
    b, h, s, d = t.shape
    return t.transpose(0, 2, 1, 3).reshape(b, s, h * d)


def flip_seq(t):
    return jnp.flip(t, axis=2)


def rope_1d(t, ang):
    half = t.shape[-1] // 2
    cos = jnp.cos(ang).astype(t.dtype)
    sin = jnp.sin(ang).astype(t.dtype)
    t1, t2 = t[..., :half], t[..., half:]
    return jnp.concatenate([t1 * cos - t2 * sin, t1 * sin + t2 * cos], axis=-1)


def axial_rope(t, ang_row, ang_col):
    half = t.shape[-1] // 2
    return jnp.concatenate([rope_1d(t[..., :half], ang_row), rope_1d(t[..., half:], ang_col)], axis=-1)


def chunk_recurrence(q, k, v, log_f, s0, with_output):
    b, h, t, dk = k.shape
    dv = v.shape[-1]
    n = t // HG_CHUNK

    def to_chunks(z):
        return z.reshape(b, h, n, HG_CHUNK, z.shape[-1]).transpose(2, 0, 1, 3, 4)

    mask = jnp.tril(jnp.ones((HG_CHUNK, HG_CHUNK), dtype=bool))[:, :, None]

    def step(state, inp):
        kc, vc, lfc = inp[0], inp[1], inp[2]
        cum = jnp.cumsum(lfc, axis=-2)
        last = cum[..., -1:, :]
        new_state = (jnp.exp(last[..., 0, :])[..., None] * state
                     + jnp.einsum('bhsk,bhsv->bhkv', kc * jnp.exp(last - cum), vc))
        if not with_output:
            return new_state, None
        qc = inp[3]
        diff = cum[..., :, None, :] - cum[..., None, :, :]
        decay = jnp.where(mask, jnp.exp(jnp.where(mask, diff, 0.0)), 0.0)
        scores = jnp.einsum('bhtk,bhtsk,bhsk->bhts', qc, decay, kc)
        out = (jnp.einsum('bhtk,bhkv->bhtv', qc * jnp.exp(cum), state)
               + jnp.einsum('bhts,bhsv->bhtv', scores, vc))
        return new_state, out

    inputs = (k, v, log_f) + ((q,) if with_output else ())
    final, outs = lax.scan(step, s0, tuple(to_chunks(z) for z in inputs))
    if with_output:
        outs = outs.transpose(1, 2, 0, 3, 4).reshape(b, h, t, dv)
    return outs, final


def hgrn2_mixer(lat_parts, ctx_parts, lb, norm_g, with_ctx_out):
    dtype = lat_parts[0].dtype
    lb = lb.reshape(2, HG_HEADS, 1, HG_EXPAND)

    def gates(z, lb_dir):
        f = lb_dir + (1.0 - lb_dir) * jax.nn.sigmoid(split_heads(z.astype(F32), HG_HEADS))
        return 1.0 - f, jnp.log(f)

    def readout(o, g):
        o = o * lax.rsqrt(jnp.mean(o * o, axis=-1, keepdims=True) + RMS_EPS)
        o = o * norm_g.astype(F32).reshape(HG_HEADS, 1, HG_EXPAND)
        return merge_heads(o * jax.nn.silu(split_heads(g.astype(F32), HG_HEADS))).astype(dtype)

    def scan_both(parts, s_fwd, s_bwd, with_out):
        q, zf, zb, i = parts[0], parts[1], parts[2], parts[3]
        qh = jax.nn.silu(split_heads(q.astype(F32), HG_HEADS)) if with_out else None
        ih = split_heads(i.astype(F32), HG_HEADS)
        kf, lff = gates(zf, lb[0])
        kb, lfb = gates(zb, lb[1])
        o_f, st_f = chunk_recurrence(qh, kf, ih, lff, s_fwd, with_out)
        o_b, st_b = chunk_recurrence(flip_seq(qh) if with_out else None, flip_seq(kb), flip_seq(ih),
                                     flip_seq(lfb), s_bwd, with_out)
        o = o_f + flip_seq(o_b) if with_out else None
        return o, st_f, st_b

    b = lat_parts[0].shape[0]
    s0 = jnp.zeros((b, HG_HEADS, HG_EXPAND, HG_EXPAND), F32)
    o_ctx, st_f, st_b = scan_both(ctx_parts, s0, s0, with_ctx_out)
    o_lat, _, _ = scan_both(lat_parts, st_f, st_b, True)
    out_lat = readout(o_lat, lat_parts[4])
    out_ctx = readout(o_ctx, ctx_parts[4]) if with_ctx_out else None
    return out_lat, out_ctx


def diff_attend(q1, q2, k1, k2, v, lam):
    scale = DA_HEAD_DIM ** -0.5
    p1 = jax.nn.softmax(jnp.einsum('bhqd,bhkd->bhqk', q1, k1).astype(F32) * scale, axis=-1)
    p2 = jax.nn.softmax(jnp.einsum('bhqd,bhkd->bhqk', q2, k2).astype(F32) * scale, axis=-1)
    return jnp.einsum('bhqk,bhkv->bhqv', (p1 - lam * p2).astype(v.dtype), v)


def diff_attention(lat_parts, ctx_parts, lam, lam_init, subln_g, ang_row, ang_col, with_ctx_out):
    def heads(q, k, v):
        b, t, _ = q.shape
        q = q.reshape(b, t, DA_HEADS, 2, DA_HEAD_DIM).transpose(3, 0, 2, 1, 4)
        k = k.reshape(b, t, DA_HEADS, 2, DA_HEAD_DIM).transpose(3, 0, 2, 1, 4)
        return q[0], q[1], k[0], k[1], split_heads(v, DA_HEADS)

    def subln(o):
        of = o.astype(F32)
        of = of * lax.rsqrt(jnp.mean(of * of, axis=-1, keepdims=True) + RMS_EPS)
        of = of * subln_g.astype(F32).reshape(DA_HEADS, 1, DA_V_DIM) * (1.0 - lam_init)
        return merge_heads(of).astype(o.dtype)

    lq1, lq2, lk1, lk2, lv = heads(*lat_parts)
    lq1, lq2, lk1, lk2 = [axial_rope(z, ang_row, ang_col) for z in (lq1, lq2, lk1, lk2)]
    cq1, cq2, ck1, ck2, cv = heads(*ctx_parts)
    k1 = jnp.concatenate([ck1, lk1], axis=2)
    k2 = jnp.concatenate([ck2, lk2], axis=2)
    v = jnp.concatenate([cv, lv], axis=2)
    b, h, t, d = lq1.shape
    nb = t // Q_BLOCK

    def to_blocks(z):
        return z.reshape(b, h, nb, Q_BLOCK, d).transpose(2, 0, 1, 3, 4)

    o_blocks = lax.map(lambda qs: diff_attend(qs[0], qs[1], k1, k2, v, lam), (to_blocks(lq1), to_blocks(lq2)))
    o_lat = o_blocks.transpose(1, 2, 0, 3, 4).reshape(b, h, t, DA_V_DIM)
    out_lat = subln(o_lat)
    out_ctx = subln(diff_attend(cq1, cq2, ck1, ck2, cv, lam)) if with_ctx_out else None
    return out_lat, out_ctx


def peer(h, w_query, sub_keys, u_tab, v_tab):
    b, t, d = h.shape
    blocks = h.reshape(-1, PEER_BLOCK, d)

    def block_fn(xb):
        p = xb.shape[0]
        q = (xb @ w_query).reshape(p, PEER_HEADS, 2, PEER_QDIM // 2)
        s = jnp.einsum('phjd,hjnd->phjn', q, sub_keys).astype(F32)
        sv, si = lax.top_k(s, PEER_TOPK)
        cand = (sv[:, :, 0, :, None] + sv[:, :, 1, None, :]).reshape(p, PEER_HEADS, PEER_TOPK * PEER_TOPK)
        best, ci = lax.top_k(cand, PEER_TOPK)
        i1 = jnp.take_along_axis(si[:, :, 0, :], ci // PEER_TOPK, axis=-1)
        i2 = jnp.take_along_axis(si[:, :, 1, :], ci % PEER_TOPK, axis=-1)
        idx = i1 * PEER_NKEYS + i2
        g = jax.nn.softmax(best, axis=-1)
        act = jax.nn.gelu(jnp.einsum('pd,phkd->phk', xb, u_tab[idx]).astype(F32), approximate=False)
        return jnp.einsum('phk,phkd->pd', (g * act).astype(xb.dtype), v_tab[idx])

    return lax.map(block_fn, blocks).reshape(b, t, d)


def setup_inputs(seed: int = 0) -> dict:
    key = jax.random.key(seed)
    ks = jax.random.split(key, 22)
    L = DEPTH

    def nrm(k, shape, s):
        return jax.random.normal(k, shape, jnp.float32) * s

    return {
        'x': nrm(ks[0], (BATCH, SEQ, D_MODEL), 1.0),
        'c': nrm(ks[1], (BATCH, D_MODEL), 1.0),
        'ctx': nrm(ks[2], (BATCH, CTX_LEN, D_MODEL), 1.0),
        'c_ctx': nrm(ks[3], (D_MODEL,), 1.0),
        'w_ada': nrm(ks[4], (L, D_MODEL, 6 * D_MODEL), 0.5 * D_MODEL ** -0.5),
        'b_ada': nrm(ks[5], (L, 6 * D_MODEL), 0.01),
        'norm1_g': 1.0 + nrm(ks[6], (L, D_MODEL), 0.1),
        'w_in': nrm(ks[7], (L, D_MODEL, IN_COLS), D_MODEL ** -0.5),
        'hg_gamma': nrm(ks[8], (L + 1, 2, HG_WIDTH), 0.5),
        'hg_norm_g': 1.0 + nrm(ks[9], (L, HG_WIDTH), 0.1),
        'da_lambda_q1': nrm(ks[10], (L, DA_HEAD_DIM), 0.1),
        'da_lambda_k1': nrm(ks[11], (L, DA_HEAD_DIM), 0.1),
        'da_lambda_q2': nrm(ks[12], (L, DA_HEAD_DIM), 0.1),
        'da_lambda_k2': nrm(ks[13], (L, DA_HEAD_DIM), 0.1),
        'da_subln_g': 1.0 + nrm(ks[14], (L, DA_WIDTH), 0.1),
        'w_out': nrm(ks[15], (L, MIX_WIDTH, D_MODEL), MIX_WIDTH ** -0.5),
        'norm2_g': 1.0 + nrm(ks[16], (L, D_MODEL), 0.1),
        'peer_w_query': nrm(ks[17], (L, D_MODEL, PEER_HEADS * PEER_QDIM), D_MODEL ** -0.5),
        'peer_sub_keys': nrm(ks[18], (L, PEER_HEADS, 2, PEER_NKEYS, PEER_QDIM // 2), (PEER_QDIM // 2) ** -0.5),
        'peer_u': nrm(ks[19], (L, PEER_EXPERTS, D_MODEL), D_MODEL ** -0.5),
        'peer_v': nrm(ks[20], (L, PEER_EXPERTS, D_MODEL), 0.5),
        'final_norm_g': 1.0 + nrm(ks[21], (D_MODEL,), 0.1),
    }


def reference(x, c, ctx, c_ctx, w_ada, b_ada, norm1_g, w_in, hg_gamma, hg_norm_g,
              da_lambda_q1, da_lambda_k1, da_lambda_q2, da_lambda_k2, da_subln_g, w_out,
              norm2_g, peer_w_query, peer_sub_keys, peer_u, peer_v, final_norm_g):
    n_lat = x.shape[1]
    ROWS = n_lat // GRID_W
    row = jnp.repeat(jnp.arange(ROWS, dtype=F32), GRID_W)
    col = jnp.tile(jnp.arange(GRID_W, dtype=F32), ROWS)
    n_freq = DA_HEAD_DIM // 4
    inv_freq = ROPE_BASE ** (-jnp.arange(n_freq, dtype=F32) / n_freq)
    ang_row = row[:, None] * inv_freq[None, :]
    ang_col = col[:, None] * inv_freq[None, :]
    lb_all = jnp.cumsum(jax.nn.softmax(hg_gamma.astype(F32), axis=0), axis=0)
    c_act = jax.nn.silu(c)[:, None, :]
    cc_act = jax.nn.silu(c_ctx)[None, None, :]
    xc = ctx
    for l in range(DEPTH):
        with_ctx_out = l < DEPTH - 1
        sh1, sc1, g1, sh2, sc2, g2 = jnp.split(c_act @ w_ada[l] + b_ada[l], 6, axis=-1)
        csh1, csc1, cg1, csh2, csc2, cg2 = jnp.split(cc_act @ w_ada[l] + b_ada[l], 6, axis=-1)
        h = rmsnorm(x, norm1_g[l]) * (1.0 + sc1) + sh1
        hc = rmsnorm(xc, norm1_g[l]) * (1.0 + csc1) + csh1
        parts = jnp.split(h @ w_in[l], IN_SPLITS, axis=-1)
        cparts = jnp.split(hc @ w_in[l], IN_SPLITS, axis=-1)
        lam_init = 0.8 - 0.6 * math.exp(-0.3 * l)
        lam = (jnp.exp(jnp.sum(da_lambda_q1[l].astype(F32) * da_lambda_k1[l].astype(F32)))
               - jnp.exp(jnp.sum(da_lambda_q2[l].astype(F32) * da_lambda_k2[l].astype(F32))) + lam_init)
        hg_lat, hg_ctx = hgrn2_mixer(parts[:5], cparts[:5], lb_all[l], hg_norm_g[l], with_ctx_out)
        da_lat, da_ctx = diff_attention(parts[5:], cparts[5:], lam, lam_init, da_subln_g[l],
                                        ang_row, ang_col, with_ctx_out)
        x = x + g1 * (jnp.concatenate([hg_lat, da_lat], axis=-1) @ w_out[l])
        x = x + g2 * peer(rmsnorm(x, norm2_g[l]) * (1.0 + sc2) + sh2,
                          peer_w_query[l], peer_sub_keys[l], peer_u[l], peer_v[l])
        if with_ctx_out:
            xc = xc + cg1 * (jnp.concatenate([hg_ctx, da_ctx], axis=-1) @ w_out[l])
            xc = xc + cg2 * peer(rmsnorm(xc, norm2_g[l]) * (1.0 + csc2) + csh2,
                                 peer_w_query[l], peer_sub_keys[l], peer_u[l], peer_v[l])
    return rmsnorm(x, final_norm_g)
```

```cpp
#include <hip/hip_runtime.h>
#include <hip/hip_cooperative_groups.h>
#include <cstdio>
#include <cstdint>
namespace cg = cooperative_groups;
#ifndef ONE_LAUNCH
#define ONE_LAUNCH 0
#endif
namespace pg8 {
#define PG8_LAS __attribute__((address_space(3)))
typedef unsigned short bf16_t;
typedef short bf16x8 __attribute__((ext_vector_type(8)));
typedef float f32x4 __attribute__((ext_vector_type(4)));
typedef unsigned u32x4 __attribute__((ext_vector_type(4)));
constexpr int BM = 256, BK = 64, HALF = 128, HTB = HALF * BK * 2  , STAGE_BYTES = 8 * HTB, NXCD = 8, WGM = 8;

__host__ __device__ __forceinline__ int lds_byte(int r, int c) { const int st = (r >> 4) * 2 + (c >> 5), rr = r & 15, cc = c & 31, ob = rr * 64 + cc * 2; return st * 1024 + (ob ^ (((ob >> 9) & 1) << 5)); }
__host__ __device__ __forceinline__ void stage_rc(int b, int& R, int& C) { const int st = b / 1024, sb = b % 1024, swz = sb ^ (((sb >> 9) & 1) << 5); R = (st >> 1) * 16 + swz / 64; C = (st & 1) * 32 + (swz % 64) / 2; }
__host__ __device__ __forceinline__ int perm32(int rho) { const int n = rho >> 4, i = rho & 15; return 8 * (i >> 2) + 4 * n + (i & 3); }

struct Unit { int pm, pn; };
struct Gemm { const bf16_t* A; const bf16_t* Bt; int M, N, K; };

struct StaticOrder {
    int nM, nN, nwg, G, c;
    __host__ __device__ void init(int M, int N, int G_, int c_) { nM = M / BM; nN = N / BM; nwg = nM * nN; G = G_; c = c_; }
    __host__ __device__ bool next(int i, Unit& u) const {
        const long L = (long)i * G + c; if (L >= nwg) return false;
        int wgid = (int)L; { const int q = nwg / NXCD, r = nwg % NXCD, xcd = wgid % NXCD, off = wgid / NXCD; wgid = (xcd < r ? xcd * (q + 1) : r * (q + 1) + (xcd - r) * q) + off; }
        const int nig = WGM * nN, gid = wgid / nig, fm = gid * WGM, gsz = (nM - fm) < WGM ? (nM - fm) : WGM;
        u.pm = fm + ((wgid % nig) % gsz); u.pn = (wgid % nig) / gsz; return true;
    }
    __device__ __forceinline__ void a_ready(const Unit&) const {}
    __device__ __forceinline__ void done(const Unit&) const {}
};

__device__ __forceinline__ unsigned cvt_pk_bf16(float lo, float hi) { unsigned r; asm volatile("v_cvt_pk_bf16_f32 %0, %1, %2" : "=v"(r) : "v"(lo), "v"(hi)); return r; }
typedef float f32x2 __attribute__((ext_vector_type(2)));
__device__ __forceinline__ f32x2 gelu_pk(f32x2 v) {
    const f32x2 av = __builtin_elementwise_abs(v), d = av * 0.2316418882f + 1.0f;
    f32x2 t; t.x = __builtin_amdgcn_rcpf(d.x); t.y = __builtin_amdgcn_rcpf(d.y);
    f32x2 q = t * 0.5307027145f + (-0.7265760135f); q = q * t + 0.7107068705f; q = q * t + (-0.142248368f); q = q * t + 0.127414796f; q = q * t;
    const f32x2 s = (v * v) * (-0.72134752044f);
    f32x2 e; e.x = __builtin_amdgcn_exp2f(s.x); e.y = __builtin_amdgcn_exp2f(s.y);
    const f32x2 m = v * (q * e), r = v - m;
    f32x2 o; o.x = v.x < 0.f ? m.x : r.x; o.y = v.y < 0.f ? m.y : r.y; return o;
}

template <int ACT  > struct EpiBf16 {
    static constexpr bool PERM = true, AFTER_DRAIN = false; static_assert(ACT == 0 || ACT == 1, "EpiBf16: ACT is 0 (none) or 1 (gelu_pk)");
    bf16_t* O; int ldc; const float* bias; int split_cols; size_t split_stride; float scale0;
    __device__ __forceinline__ void operator()(const f32x4 (&acc)[2][2][4][2], const Unit& u, int wr, int wc, int fr, int fq) const {
        const int row0 = u.pm * BM + wr * 64 + fr; int colt = u.pn * BM; bf16_t* base = O;
        float sc = 1.f; if (split_cols) { const int t = colt / split_cols; base += (size_t)t * split_stride; colt -= t * split_cols; if (t == 0) sc = scale0; }
        const int col0 = colt + wc * 32 + 8 * fq, bcol0 = u.pn * BM + wc * 32 + 8 * fq;
        f32x4 bv[2][2];
#pragma unroll
        for (int bj = 0; bj < 2; ++bj)
#pragma unroll
            for (int n = 0; n < 2; ++n) bv[bj][n] = bias ? *(const f32x4*)(bias + bcol0 + bj * HALF + 4 * n) : (f32x4){0.f, 0.f, 0.f, 0.f};
#pragma unroll
        for (int ai = 0; ai < 2; ++ai)
#pragma unroll
            for (int m = 0; m < 4; ++m) { bf16_t* rowp = base + (size_t)(row0 + ai * HALF + m * 16) * ldc + col0;
#pragma unroll
                for (int bj = 0; bj < 2; ++bj) { f32x4 v0 = acc[ai][bj][m][0] + bv[bj][0], v1 = acc[ai][bj][m][1] + bv[bj][1];
                    if (ACT == 1) { f32x2 a = gelu_pk((f32x2){v0[0], v0[1]}), b = gelu_pk((f32x2){v0[2], v0[3]}), c = gelu_pk((f32x2){v1[0], v1[1]}), d = gelu_pk((f32x2){v1[2], v1[3]});
                        v0 = (f32x4){a.x, a.y, b.x, b.y}; v1 = (f32x4){c.x, c.y, d.x, d.y}; }
                    v0 = v0 * sc; v1 = v1 * sc; u32x4 w; w.x = cvt_pk_bf16(v0[0], v0[1]); w.y = cvt_pk_bf16(v0[2], v0[3]); w.z = cvt_pk_bf16(v1[0], v1[1]); w.w = cvt_pk_bf16(v1[2], v1[3]);
                    *(u32x4*)(rowp + bj * HALF) = w; } }
    }
};

struct PanelStats {
    unsigned* xbuf;
    unsigned* cnt;
    unsigned* tmo;
    int ntn; float eps;
    unsigned code;
    __device__ __forceinline__ bool run(const f32x4 (&v)[2][2][4][2], const Unit& u, int wr, int wc, int fr, int fq, PG8_LAS unsigned char* lds, int wid, int lane) const {
        typedef float f32x2v __attribute__((ext_vector_type(2)));
        PG8_LAS f32x2v* P = (PG8_LAS f32x2v*)lds;
        PG8_LAS f32x2v* S = (PG8_LAS f32x2v*)(lds + 8192);
        PG8_LAS unsigned* flag = (PG8_LAS unsigned*)(lds + 8192 + 2048);
#pragma unroll
        for (int ai = 0; ai < 2; ++ai)
#pragma unroll
            for (int m = 0; m < 4; ++m) {
                float s = 0.f;
#pragma unroll
                for (int bj = 0; bj < 2; ++bj)
#pragma unroll
                    for (int n = 0; n < 2; ++n) { const f32x4 x = v[ai][bj][m][n]; s += (x[0] + x[1]) + (x[2] + x[3]); }
                s += __shfl_xor(s, 16); s += __shfl_xor(s, 32);
                const float mw = s * (1.0f / 64.0f); float q = 0.f;
#pragma unroll
                for (int bj = 0; bj < 2; ++bj)
#pragma unroll
                    for (int n = 0; n < 2; ++n) { const f32x4 d = v[ai][bj][m][n] - mw; q += (d[0] * d[0] + d[1] * d[1]) + (d[2] * d[2] + d[3] * d[3]); }
                q += __shfl_xor(q, 16); q += __shfl_xor(q, 32);
                if (fq == 0) P[(ai * HALF + wr * 64 + m * 16 + fr) * 4 + wc] = (f32x2v){mw, q};
            }
        asm volatile("s_waitcnt lgkmcnt(0)" ::: "memory"); __builtin_amdgcn_s_barrier(); asm volatile("" ::: "memory");
#if defined(BROKEN_EXCHANGE_NO_WAIT)
#warning BROKEN CONTROL BUILD: the row-statistics exchange does not wait; results are wrong by design
        if (blockIdx.x >= 64) { const long long t0_ = clock64(); while (clock64() - t0_ < 60000) __builtin_amdgcn_s_sleep(8); }
#endif
        const int row = wid * 32 + (lane & 31);
        if (lane < 32) {
            const f32x2v a = P[row * 4 + 0], b = P[row * 4 + 1], c = P[row * 4 + 2], d = P[row * 4 + 3];
            const float mt = (a.x + b.x + c.x + d.x) * 0.25f;
            const float da = a.x - mt, db = b.x - mt, dc = c.x - mt, dd = d.x - mt;
            const float m2 = (a.y + b.y) + (c.y + d.y) + 64.0f * ((da * da + db * db) + (dc * dc + dd * dd));
            unsigned long long* slot = (unsigned long long*)xbuf + ((size_t)(u.pm * BM + row) * 4 + u.pn);
            __hip_atomic_store(slot, ((unsigned long long)__float_as_uint(m2) << 32) | __float_as_uint(mt), __ATOMIC_RELAXED, __HIP_MEMORY_SCOPE_AGENT);
        }
        asm volatile("s_waitcnt vmcnt(0)" ::: "memory");
        if (lane == 0) __hip_atomic_fetch_add(cnt + 64 * u.pm, 1u, __ATOMIC_RELAXED, __HIP_MEMORY_SCOPE_AGENT);
        if (wid == 0) {
            bool dead = false; const unsigned long long t0 = __builtin_amdgcn_s_memrealtime(); const unsigned want = 8u * (unsigned)ntn;
            for (;;) {
#if defined(BROKEN_EXCHANGE_NO_WAIT)
                break;
#endif
                if ((unsigned)__builtin_amdgcn_readfirstlane(__hip_atomic_load(cnt + 64 * u.pm, __ATOMIC_RELAXED, __HIP_MEMORY_SCOPE_AGENT)) >= want) break;
                if (__builtin_amdgcn_s_memrealtime() - t0 > 2000000ull) {
                    if (lane == 0) { unsigned expect = 0u; __hip_atomic_compare_exchange_strong(tmo + 1, &expect, code | (unsigned)(u.pm & 0xff), __ATOMIC_RELAXED, __ATOMIC_RELAXED, __HIP_MEMORY_SCOPE_AGENT);
                                     __hip_atomic_store(tmo, 1u, __ATOMIC_RELAXED, __HIP_MEMORY_SCOPE_AGENT); }
                    dead = true; break; }
                __builtin_amdgcn_s_sleep(2);
            }
            __builtin_amdgcn_fence(__ATOMIC_ACQUIRE, "agent");
            if (lane == 0) flag[0] = dead ? 1u : 0u;
        }
        asm volatile("s_waitcnt vmcnt(0) lgkmcnt(0)" ::: "memory"); __builtin_amdgcn_s_barrier(); asm volatile("" ::: "memory");
        const bool bad = flag[0] != 0u;
        if (lane < 32) {
            const unsigned long long* slot = (const unsigned long long*)xbuf + (size_t)(u.pm * BM + row) * 4; float mt[4], m2[4]; float ms = 0.f;
#pragma unroll
            for (int t = 0; t < 4; ++t) { if (t < ntn) { const unsigned long long w = __hip_atomic_load(slot + t, __ATOMIC_RELAXED, __HIP_MEMORY_SCOPE_AGENT); mt[t] = __uint_as_float((unsigned)w); m2[t] = __uint_as_float((unsigned)(w >> 32)); } else { mt[t] = 0.f; m2[t] = 0.f; } ms += mt[t]; }
            const float mean = ms / (float)ntn; float q = 0.f;
#pragma unroll
            for (int t = 0; t < 4; ++t) if (t < ntn) { const float dm = mt[t] - mean; q += m2[t] + 256.0f * dm * dm; }
            S[row] = (f32x2v){mean, 1.0f / sqrtf(q / (256.0f * (float)ntn) + eps)};
        }
        asm volatile("s_waitcnt lgkmcnt(0)" ::: "memory"); __builtin_amdgcn_s_barrier(); asm volatile("" ::: "memory");
        return bad;
    }
};
struct EpiLnRes {
    static constexpr bool PERM = false, AFTER_DRAIN = true;
    const float* base; float* out; int ldc; const float* bias; PanelStats st; unsigned poison;
    __device__ __forceinline__ void fused(f32x4 (&acc)[2][2][4][2], const Unit& u, int wr, int wc, int fr, int fq, PG8_LAS unsigned char* lds, int wid, int lane) const {
        typedef float f32x2v __attribute__((ext_vector_type(2)));
        const PG8_LAS f32x2v* S = (const PG8_LAS f32x2v*)(lds + 8192);
        const int col0 = u.pn * BM + wc * 32 + 4 * fq;
#pragma unroll
        for (int bj = 0; bj < 2; ++bj)
#pragma unroll
            for (int n = 0; n < 2; ++n) { const f32x4 bv = bias ? *(const f32x4*)(bias + col0 + bj * HALF + n * 16) : (f32x4){0.f, 0.f, 0.f, 0.f};
#pragma unroll
                for (int ai = 0; ai < 2; ++ai)
#pragma unroll
                    for (int m = 0; m < 4; ++m) acc[ai][bj][m][n] += bv; }
        f32x4 pre[4][2][2];
#pragma unroll
        for (int m = 0; m < 4; ++m) { const size_t off = (size_t)(u.pm * BM + wr * 64 + m * 16 + fr) * ldc + col0;
#pragma unroll
            for (int bj = 0; bj < 2; ++bj)
#pragma unroll
                for (int n = 0; n < 2; ++n) pre[m][bj][n] = *(const f32x4*)(base + off + bj * HALF + n * 16); }
        const bool bad = st.run(acc, u, wr, wc, fr, fq, lds, wid, lane) || poison != 0u;
        const float qnan = __builtin_nanf("");
#pragma unroll
        for (int ai = 0; ai < 2; ++ai)
#pragma unroll
            for (int m = 0; m < 4; ++m) { const int r = ai * HALF + wr * 64 + m * 16 + fr; const f32x2v sr = S[r]; const size_t off = (size_t)(u.pm * BM + r) * ldc + col0;
#pragma unroll
                for (int bj = 0; bj < 2; ++bj)
#pragma unroll
                    for (int n = 0; n < 2; ++n) { const f32x4 bs = ai == 0 ? pre[m][bj][n] : *(const f32x4*)(base + off + bj * HALF + n * 16); f32x4 o = bs + (acc[ai][bj][m][n] - sr.x) * sr.y;
                        if (bad) o = (f32x4){qnan, qnan, qnan, qnan}; *(f32x4*)(out + off + bj * HALF + n * 16) = o; }
                if (m & 1) asm volatile("" ::: "memory"); }
    }
};
struct EpiLnResLn {
    static constexpr bool PERM = false, AFTER_DRAIN = true;
    const float* base; float* out; bf16_t* xn; int ldc; const float* bias; PanelStats st1, st2; unsigned poison;
    __device__ __forceinline__ void fused(f32x4 (&acc)[2][2][4][2], const Unit& u, int wr, int wc, int fr, int fq, PG8_LAS unsigned char* lds, int wid, int lane) const {
        typedef float f32x2v __attribute__((ext_vector_type(2))); typedef unsigned u32x2v __attribute__((ext_vector_type(2)));
        const PG8_LAS f32x2v* S = (const PG8_LAS f32x2v*)(lds + 8192);
        const int col0 = u.pn * BM + wc * 32 + 4 * fq;
#pragma unroll
        for (int bj = 0; bj < 2; ++bj)
#pragma unroll
            for (int n = 0; n < 2; ++n) { const f32x4 bv = bias ? *(const f32x4*)(bias + col0 + bj * HALF + n * 16) : (f32x4){0.f, 0.f, 0.f, 0.f};
#pragma unroll
                for (int ai = 0; ai < 2; ++ai)
#pragma unroll
                    for (int m = 0; m < 4; ++m) acc[ai][bj][m][n] += bv; }
        bool bad = st1.run(acc, u, wr, wc, fr, fq, lds, wid, lane) || poison != 0u;
        const float qnan = __builtin_nanf("");
#pragma unroll
        for (int ai = 0; ai < 2; ++ai)
#pragma unroll
            for (int m = 0; m < 4; ++m) { const int r = ai * HALF + wr * 64 + m * 16 + fr; const f32x2v sr = S[r]; const size_t off = (size_t)(u.pm * BM + r) * ldc + col0;
#pragma unroll
                for (int bj = 0; bj < 2; ++bj)
#pragma unroll
                    for (int n = 0; n < 2; ++n) { const f32x4 bs = *(const f32x4*)(base + off + bj * HALF + n * 16); acc[ai][bj][m][n] = bs + (acc[ai][bj][m][n] - sr.x) * sr.y; }
                asm volatile("" : "+v"(acc[ai][0][m][0]), "+v"(acc[ai][0][m][1]), "+v"(acc[ai][1][m][0]), "+v"(acc[ai][1][m][1]));
                if (m & 1) asm volatile("" ::: "memory"); }
        const bool bad1 = bad;
        bad = st2.run(acc, u, wr, wc, fr, fq, lds, wid, lane) || bad;
#pragma unroll
        for (int ai = 0; ai < 2; ++ai)
#pragma unroll
            for (int m = 0; m < 4; ++m) { const int r = ai * HALF + wr * 64 + m * 16 + fr; const f32x2v sr = S[r]; const size_t off = (size_t)(u.pm * BM + r) * ldc + col0;
#pragma unroll
                for (int bj = 0; bj < 2; ++bj)
#pragma unroll
                    for (int n = 0; n < 2; ++n) { const f32x4 x1 = acc[ai][bj][m][n]; *(f32x4*)(out + off + bj * HALF + n * 16) = bad1 ? (f32x4){qnan, qnan, qnan, qnan} : x1;
                        const f32x4 o = (x1 - sr.x) * sr.y; u32x2v w; w.x = cvt_pk_bf16(o[0], o[1]); w.y = cvt_pk_bf16(o[2], o[3]);
                        if (bad) { w.x = 0x7fc07fc0u; w.y = 0x7fc07fc0u; } *(u32x2v*)(xn + off + bj * HALF + n * 16) = w; }
                asm volatile("" ::: "memory"); }
    }
};

template <class Epi, class Sched, bool ALIGN_EPI = false, bool SP2 = false>
__device__ __forceinline__ void gemm_phase(PG8_LAS unsigned char* lds, const Gemm g, const Sched& S, const Epi& E) {
    const int tid = threadIdx.x, wid = __builtin_amdgcn_readfirstlane(tid >> 6), lane = tid & 63, wr = wid >> 2, wc = wid & 3, fr = lane & 15, fq = lane >> 4;
    const int K = g.K, nt = K / BK;
    unsigned voffA[2], voffB[2];
#pragma unroll
    for (int i = 0; i < 2; ++i) { int R, C; stage_rc(tid * 16 + i * 8192, R, C); const int Rb = Epi::PERM ? ((R & ~31) + perm32(R & 31)) : R;
        voffA[i] = (unsigned)(R * K + C) * 2u; voffB[i] = (unsigned)(Rb * K + C) * 2u; }
    const size_t kstep = (size_t)(BK * 2);
    const size_t hstep = (size_t)HALF * K * 2;
    const size_t tstep = 2 * hstep;
    const unsigned ldsw = (unsigned)wid * 1024u;
    const int aoff = lds_byte(wr * 64 + fr, fq * 8), boff = lds_byte(wc * 32 + fr, fq * 8);
#define PG8_SA(b, h) (((b) * 2 + (h)) * HTB)
#define PG8_SB(b, h) ((4 + (b) * 2 + (h)) * HTB)
#define PG8_STAGE(bufoff, gbase, voff) do { _Pragma("unroll") for (int _i = 0; _i < 2; ++_i) \
        __builtin_amdgcn_global_load_lds((const unsigned*)((const char*)(gbase) + (voff)[_i]), (PG8_LAS unsigned*)(lds + (bufoff) + ldsw + _i * 8192), 16, 0, 0); } while (0)
#define PG8_LDA(dst, b, h) do { _Pragma("unroll") for (int m = 0; m < 4; ++m) _Pragma("unroll") for (int k = 0; k < 2; ++k) dst[m][k] = *(const PG8_LAS bf16x8*)(lds + PG8_SA(b, h) + aoff + m * 2048 + k * 1024); } while (0)
#define PG8_LDB(dst, b, h) do { _Pragma("unroll") for (int n = 0; n < 2; ++n) _Pragma("unroll") for (int k = 0; k < 2; ++k) dst[n][k] = *(const PG8_LAS bf16x8*)(lds + PG8_SB(b, h) + boff + n * 2048 + k * 1024); } while (0)
#define PG8_MMA(ai, bj, At, Bt) do { __builtin_amdgcn_s_setprio(1); _Pragma("unroll") for (int m = 0; m < 4; ++m) _Pragma("unroll") for (int n = 0; n < 2; ++n) _Pragma("unroll") for (int k = 0; k < 2; ++k) \
        acc[ai][bj][m][n] = __builtin_amdgcn_mfma_f32_16x16x32_bf16(Bt[n][k], At[m][k], acc[ai][bj][m][n], 0, 0, 0); __builtin_amdgcn_s_setprio(0); } while (0)
#define PG8_WAIT_V(n) asm volatile("s_waitcnt vmcnt(" #n ")" ::: "memory")
#define PG8_WAIT_L(n) asm volatile("s_waitcnt lgkmcnt(" #n ")" ::: "memory")
#define PG8_BAR __builtin_amdgcn_s_barrier()
#define PG8_SCHED __builtin_amdgcn_sched_barrier(0)
    Unit cur, nxt; int ui = 0;
    if (!S.next(0, cur)) return;
    f32x4 acc[2][2][4][2];
#pragma unroll
    for (int a = 0; a < 2; ++a)
#pragma unroll
        for (int b = 0; b < 2; ++b)
#pragma unroll
            for (int m = 0; m < 4; ++m)
#pragma unroll
                for (int n = 0; n < 2; ++n) acc[a][b][m][n] = (f32x4){0.f, 0.f, 0.f, 0.f};
    bf16x8 At[4][2], B0[2][2], B1[2][2];
    const char* cA = (const char*)g.A + (size_t)cur.pm * tstep; const char* cB = (const char*)g.Bt + (size_t)cur.pn * tstep;
    S.a_ready(cur);
    if constexpr (SP2) {
        PG8_STAGE(PG8_SB(0, 0), cB, voffB); PG8_STAGE(PG8_SB(0, 1), cB + hstep, voffB); PG8_STAGE(PG8_SA(0, 0), cA, voffA); PG8_STAGE(PG8_SA(0, 1), cA + hstep, voffA);
        if (wr == 1) PG8_BAR;
        PG8_WAIT_V(2); PG8_BAR;
        PG8_STAGE(PG8_SB(1, 0), cB + kstep, voffB); PG8_STAGE(PG8_SA(1, 0), cA + kstep, voffA); PG8_STAGE(PG8_SB(1, 1), cB + hstep + kstep, voffB);
        PG8_WAIT_V(6); PG8_BAR;
    } else {
        PG8_STAGE(PG8_SB(0, 0), cB, voffB); PG8_STAGE(PG8_SA(0, 0), cA, voffA); PG8_STAGE(PG8_SB(0, 1), cB + hstep, voffB); PG8_STAGE(PG8_SA(0, 1), cA + hstep, voffA);
        if (wr == 1) PG8_BAR;
        PG8_WAIT_V(4); PG8_BAR;
        PG8_STAGE(PG8_SB(1, 0), cB + kstep, voffB); PG8_STAGE(PG8_SA(1, 0), cA + kstep, voffA); PG8_STAGE(PG8_SB(1, 1), cB + hstep + kstep, voffB);
        PG8_WAIT_V(6); PG8_BAR;
    }
    for (;;) {
        const bool has_next = S.next(ui + 1, nxt);
        const char* nA = has_next ? (const char*)g.A + (size_t)nxt.pm * tstep : cA; const char* nB = has_next ? (const char*)g.Bt + (size_t)nxt.pn * tstep : cB;
        for (int t = 0; t < nt; t += 2) {
            const bool last = (t == nt - 2);
            const char* a1 = cA + (size_t)(t + 1) * kstep;
            const char* a2 = last ? nA : cA + (size_t)(t + 2) * kstep; const char* b2 = last ? nB : cB + (size_t)(t + 2) * kstep;
            const char* a3 = a2 + kstep; const char* b3 = b2 + kstep;
            if (last && has_next) S.a_ready(nxt);
            if constexpr (SP2) {
            PG8_LDB(B0, 0, 0); PG8_LDB(B1, 0, 1); PG8_SCHED; PG8_LDA(At, 0, 0); PG8_STAGE(PG8_SA(1, 1), a1 + hstep, voffA);
            PG8_WAIT_V(8); PG8_WAIT_L(0); PG8_BAR; PG8_MMA(0, 0, At, B0); PG8_MMA(0, 1, At, B1); PG8_BAR; PG8_SCHED;
            PG8_LDA(At, 0, 1); PG8_STAGE(PG8_SB(0, 0), b2, voffB); PG8_STAGE(PG8_SB(0, 1), b2 + hstep, voffB); PG8_STAGE(PG8_SA(0, 0), a2, voffA);
            PG8_WAIT_V(8); PG8_WAIT_L(0); PG8_BAR; PG8_MMA(1, 0, At, B0); PG8_MMA(1, 1, At, B1); PG8_BAR; PG8_SCHED;
            PG8_LDB(B0, 1, 0); PG8_LDB(B1, 1, 1); PG8_SCHED; PG8_LDA(At, 1, 0); PG8_STAGE(PG8_SA(0, 1), a2 + hstep, voffA);
            PG8_WAIT_V(8); PG8_WAIT_L(0); PG8_BAR; PG8_MMA(0, 0, At, B0); PG8_MMA(0, 1, At, B1); PG8_BAR; PG8_SCHED;
            PG8_LDA(At, 1, 1); PG8_STAGE(PG8_SB(1, 0), b3, voffB); PG8_STAGE(PG8_SB(1, 1), b3 + hstep, voffB); PG8_STAGE(PG8_SA(1, 0), a3, voffA);
            PG8_WAIT_V(8); PG8_WAIT_L(0); PG8_BAR; PG8_MMA(1, 0, At, B0); PG8_MMA(1, 1, At, B1); PG8_BAR; PG8_SCHED;
            } else {
            PG8_LDB(B0, 0, 0); PG8_SCHED; PG8_LDA(At, 0, 0); PG8_STAGE(PG8_SA(1, 1), a1 + hstep, voffA);
            PG8_WAIT_L(8); PG8_BAR; PG8_WAIT_L(0); PG8_MMA(0, 0, At, B0); PG8_BAR; PG8_SCHED;
            PG8_LDB(B1, 0, 1); PG8_STAGE(PG8_SB(0, 0), b2, voffB);
            PG8_BAR; PG8_WAIT_L(0); PG8_MMA(0, 1, At, B1); PG8_BAR;
            PG8_LDA(At, 0, 1); PG8_STAGE(PG8_SA(0, 0), a2, voffA);
            PG8_BAR; PG8_WAIT_L(0); PG8_MMA(1, 0, At, B0); PG8_BAR; PG8_SCHED;
            PG8_STAGE(PG8_SB(0, 1), b2 + hstep, voffB);
            PG8_WAIT_V(6); PG8_BAR; PG8_MMA(1, 1, At, B1); PG8_BAR;
            PG8_LDB(B0, 1, 0); PG8_SCHED; PG8_LDA(At, 1, 0); PG8_STAGE(PG8_SA(0, 1), a2 + hstep, voffA);
            PG8_WAIT_L(8); PG8_BAR; PG8_WAIT_L(0); PG8_MMA(0, 0, At, B0); PG8_BAR; PG8_SCHED;
            PG8_LDB(B1, 1, 1); PG8_STAGE(PG8_SB(1, 0), b3, voffB);
            PG8_BAR; PG8_WAIT_L(0); PG8_MMA(0, 1, At, B1); PG8_BAR;
            PG8_LDA(At, 1, 1); PG8_STAGE(PG8_SA(1, 0), a3, voffA);
            PG8_BAR; PG8_WAIT_L(0); PG8_MMA(1, 0, At, B0); PG8_BAR; PG8_SCHED;
            PG8_STAGE(PG8_SB(1, 1), b3 + hstep, voffB);
            PG8_WAIT_V(6); PG8_BAR; PG8_MMA(1, 1, At, B1); PG8_BAR;
            }
        }
        if constexpr (ALIGN_EPI) { if (wr == 0) PG8_BAR; }
        if constexpr (!Epi::AFTER_DRAIN) { E(acc, cur, wr, wc, fr, fq); S.done(cur); }
        if (!has_next) break;
#pragma unroll
        for (int a = 0; a < 2; ++a)
#pragma unroll
            for (int b = 0; b < 2; ++b)
#pragma unroll
                for (int m = 0; m < 4; ++m)
#pragma unroll
                    for (int n = 0; n < 2; ++n) acc[a][b][m][n] = (f32x4){0.f, 0.f, 0.f, 0.f};
        cur = nxt; cA = nA; cB = nB; ++ui;
        if constexpr (ALIGN_EPI) { if (wr == 1) PG8_BAR; }
    }
    PG8_WAIT_V(0);
    if constexpr (!ALIGN_EPI) { if (wr == 0) PG8_BAR; }
    PG8_BAR;
    if constexpr (Epi::AFTER_DRAIN) { E.fused(acc, cur, wr, wc, fr, fq, lds, wid, lane); S.done(cur); }
#undef PG8_SA
#undef PG8_SB
#undef PG8_STAGE
#undef PG8_LDA
#undef PG8_LDB
#undef PG8_MMA
#undef PG8_WAIT_V
#undef PG8_WAIT_L
#undef PG8_BAR
#undef PG8_SCHED
}
}

#define LAS __attribute__((address_space(3)))
typedef unsigned short bf16_t;
typedef short bf16x8 __attribute__((ext_vector_type(8)));
typedef short s16x4 __attribute__((ext_vector_type(4)));
typedef float f32x2 __attribute__((ext_vector_type(2)));
typedef float f32x4 __attribute__((ext_vector_type(4)));
typedef float f32x16 __attribute__((ext_vector_type(16)));
typedef unsigned u32x2 __attribute__((ext_vector_type(2)));
typedef unsigned u32x4 __attribute__((ext_vector_type(4)));
typedef int i32x4 __attribute__((ext_vector_type(4)));
typedef __bf16 bf16x2_t __attribute__((ext_vector_type(2)));

constexpr int NWAVES = 8, NTHR = 512;
constexpr int D = 2048, BATCH = 2, SEQ = 4096, CTX = 256, TPB = SEQ + CTX, M1 = BATCH * TPB, ML = BATCH * SEQ, NIN = 8192;
constexpr int C_HQ = 0, C_FF = 1024, C_FB = 2048, C_HI = 3072, C_HG = 4096, C_DQ = 5120, C_DK = 6144, C_DV = 7168;
constexpr float RMS_EPS = 1e-6f;
constexpr int NEXP = 16384, NMOD = 6 * D;
constexpr int LDS_BYTES = 155648;

constexpr size_t MiB = 1u << 20;
constexpr size_t WS_CTL = 0, CTL_BYTES = 1 * MiB;
constexpr size_t WS_MOD = 512 * 1024;
constexpr size_t WS_SMALL = 1 * MiB;
constexpr size_t WS_WIN = 2 * MiB, WS_WOUT = 34 * MiB, WS_WQ = 42 * MiB, WS_UBF = 50 * MiB, WS_VBF = 114 * MiB, WS_H = 178 * MiB, WS_PARTS = 212 * MiB,
                 WS_MIX = 348 * MiB, WS_HST = 380 * MiB, WS_HD = 412 * MiB, WS_IDX = 413 * MiB, WS_COEF = 417 * MiB, WS_OF = 421 * MiB, WS_END = 453 * MiB;
constexpr size_t WS_QP = WS_PARTS;

struct Args { const float* in[22]; float* out; unsigned char* ws; int ph_lo, ph_hi; };
enum { I_X = 0, I_C, I_CTX, I_CCTX, I_WADA, I_BADA, I_N1G, I_WIN, I_HGG, I_HGNG, I_LQ1, I_LK1, I_LQ2, I_LK2, I_SUBG, I_WOUT, I_N2G, I_WQ, I_KEYS, I_PU, I_PV, I_FNG };

__device__ __forceinline__ float bf2f(unsigned short h) { return __uint_as_float((unsigned)h << 16); }
__device__ __forceinline__ unsigned pk2(float lo, float hi) { f32x2 v = {lo, hi}; bf16x2_t b = __builtin_convertvector(v, bf16x2_t); return __builtin_bit_cast(unsigned, b); }
__device__ __forceinline__ unsigned short f2bf(float f) { return (unsigned short)(pk2(f, 0.f) & 0xffffu); }
__device__ __forceinline__ float wave_sum(float v) {
#pragma unroll
    for (int o = 1; o < 64; o <<= 1) v += __shfl_xor(v, o);
    return v;
}
__device__ __forceinline__ int crow(int r, int hi) { return (r & 3) + 8 * (r >> 2) + 4 * hi; }
__device__ __forceinline__ float silu_f(float x) { return x / (1.f + __expf(-x)); }
#define SBAR() __builtin_amdgcn_sched_barrier(0)

__device__ __forceinline__ int v_st(int k, int c) { const int kk = (k & ~0xC) | ((k & 4) << 1) | ((k & 8) >> 1); return ((kk >> 3) * 4 + (c >> 5)) * 512 + ((kk & 7) * 32 + (c & 31)) * 2; }
__device__ __forceinline__ int v_rd_base(int lane) { return ((lane & 3) << 3) | (((lane >> 2) & 3) << 6) | (((lane >> 4) & 1) << 5) | (((lane >> 5) & 1) << 8); }
constexpr int v_rd_off(int d0, int ks, int half) { return d0 * 512 + ks * 4096 + half * 2048; }
template <int OFF> __device__ __forceinline__ s16x4 tr_read(int vb) {
  s16x4 r; asm volatile("ds_read_b64_tr_b16 %0, %1 offset:%2" : "=&v"(r) : "v"(vb), "i"(OFF) : "memory"); return r;
}
template <int D0> __device__ __forceinline__ void pv_one(f32x16& od, int vb, bf16x8 pa0, bf16x8 pa1, bf16x8 pa2, bf16x8 pa3) {
  const s16x4 l0 = tr_read<v_rd_off(D0, 0, 0)>(vb), h0 = tr_read<v_rd_off(D0, 0, 1)>(vb), l1 = tr_read<v_rd_off(D0, 1, 0)>(vb), h1 = tr_read<v_rd_off(D0, 1, 1)>(vb);
  const s16x4 l2 = tr_read<v_rd_off(D0, 2, 0)>(vb), h2 = tr_read<v_rd_off(D0, 2, 1)>(vb), l3 = tr_read<v_rd_off(D0, 3, 0)>(vb), h3 = tr_read<v_rd_off(D0, 3, 1)>(vb);
  asm volatile("s_waitcnt lgkmcnt(0)" ::: "memory"); SBAR();
#define PK(L, H) (bf16x8){L[0], L[1], L[2], L[3], H[0], H[1], H[2], H[3]}
  od = __builtin_amdgcn_mfma_f32_32x32x16_bf16(pa0, PK(l0, h0), od, 0, 0, 0);
  od = __builtin_amdgcn_mfma_f32_32x32x16_bf16(pa1, PK(l1, h1), od, 0, 0, 0);
  od = __builtin_amdgcn_mfma_f32_32x32x16_bf16(pa2, PK(l2, h2), od, 0, 0, 0);
  od = __builtin_amdgcn_mfma_f32_32x32x16_bf16(pa3, PK(l3, h3), od, 0, 0, 0);
#undef PK
}

__device__ __forceinline__ void p0_transpose_item(const float* W, int K, int N, bf16_t* WT, LAS float* scr, int item, int lane) {
    const int nblk = N / 32, kb = item / nblk, nb = item % nblk, k0 = 64 * kb, n0 = 32 * nb;
#pragma unroll 8
    for (int i = 0; i < 32; ++i) { const int kk = 2 * i + (lane >> 5); scr[kk * 33 + (lane & 31)] = W[(size_t)(k0 + kk) * N + n0 + (lane & 31)]; }
    asm volatile("s_waitcnt lgkmcnt(0)" ::: "memory");
    const int c = lane & 7;
#pragma unroll
    for (int j = 0; j < 4; ++j) { const int n = (lane >> 3) + 8 * j; const LAS float* s = scr + (8 * c) * 33 + n;
        u32x4 o; o.x = pk2(s[0 * 33], s[1 * 33]); o.y = pk2(s[2 * 33], s[3 * 33]); o.z = pk2(s[4 * 33], s[5 * 33]); o.w = pk2(s[6 * 33], s[7 * 33]);
        *(u32x4*)(WT + (size_t)(n0 + n) * K + k0 + 8 * c) = o; }
    asm volatile("s_waitcnt lgkmcnt(0)" ::: "memory");
}
__device__ __forceinline__ void cvt8(const float* src, bf16_t* dst) {
    const f32x4 a = *(const f32x4*)src, b = *(const f32x4*)(src + 4);
    u32x4 o; o.x = pk2(a.x, a.y); o.y = pk2(a.z, a.w); o.z = pk2(b.x, b.y); o.w = pk2(b.z, b.w); *(u32x4*)dst = o;
}
__device__ __forceinline__ void p0_prologue(const Args& a, unsigned char* lds, int vcu, int G, int tid, int lane, int wave) {
    unsigned char* ws = a.ws;
    LAS float* scr = (LAS float*)lds + wave * 4096;
    const int gw = vcu * NWAVES + wave, NGW = G * NWAVES;
    float* mod = (float*)(ws + WS_MOD);
    if (vcu < 192) {
        LAS float* sl = (LAS float*)lds;
        for (int i = tid; i < 3 * D; i += NTHR) { const int v = i >> 11, k = i & 2047; const float cv = v < 2 ? a.in[I_C][v * D + k] : a.in[I_CCTX][k]; sl[i] = silu_f(cv); }
        __syncthreads();
        const int rs = lane >> 4, c4 = lane & 15;
        const float* wp = a.in[I_WADA] + (size_t)(wave * 256 + rs) * NMOD + vcu * 64 + 4 * c4;
        f32x4 acc0 = {0.f, 0.f, 0.f, 0.f}, acc1 = acc0, acc2 = acc0;
#pragma unroll 8
        for (int i = 0; i < 64; ++i) { const int k = wave * 256 + 4 * i + rs; const f32x4 w = *(const f32x4*)(wp + (size_t)(4 * i) * NMOD);
            acc0 += w * sl[k]; acc1 += w * sl[D + k]; acc2 += w * sl[2 * D + k]; }
        LAS float* pr = sl + 3 * D;
#pragma unroll
        for (int e = 0; e < 4; ++e) {
            float x0 = acc0[e], x1 = acc1[e], x2 = acc2[e];
            x0 += __shfl_xor(x0, 16); x0 += __shfl_xor(x0, 32); x1 += __shfl_xor(x1, 16); x1 += __shfl_xor(x1, 32); x2 += __shfl_xor(x2, 16); x2 += __shfl_xor(x2, 32);
            if (rs == 0) { pr[(wave * 3 + 0) * 64 + 4 * c4 + e] = x0; pr[(wave * 3 + 1) * 64 + 4 * c4 + e] = x1; pr[(wave * 3 + 2) * 64 + 4 * c4 + e] = x2; }
        }
        __syncthreads();
        if (tid < 192) { const int v = tid >> 6, c = tid & 63; float s = 0.f;
#pragma unroll
            for (int w = 0; w < 8; ++w) s += pr[(w * 3 + v) * 64 + c];
            mod[v * NMOD + vcu * 64 + c] = s; }
        __syncthreads();
    }
    constexpr int I_IN = (D / 64) * (NIN / 32), I_O = (D / 64) * (D / 32);
    for (int it = gw; it < I_IN + 2 * I_O; it += NGW) {
        int r = it;
        if (r < I_IN) { p0_transpose_item(a.in[I_WIN], D, NIN, (bf16_t*)(ws + WS_WIN), scr, r, lane); continue; } r -= I_IN;
        if (r < I_O) { p0_transpose_item(a.in[I_WOUT], D, D, (bf16_t*)(ws + WS_WOUT), scr, r, lane); continue; } r -= I_O;
        p0_transpose_item(a.in[I_WQ], D, D, (bf16_t*)(ws + WS_WQ), scr, r, lane);
    }
    {
        const long N8 = (long)NEXP * D / 8, NK8 = 8 * 2 * 128 * 128 / 8, gt = (long)vcu * NTHR + tid, NT = (long)G * NTHR;
        for (long i = gt; i < 2 * N8 + NK8; i += NT) {
            if (i < N8) cvt8(a.in[I_PU] + i * 8, (bf16_t*)(ws + WS_UBF) + i * 8);
            else if (i < 2 * N8) cvt8(a.in[I_PV] + (i - N8) * 8, (bf16_t*)(ws + WS_VBF) + (i - N8) * 8);
            else cvt8(a.in[I_KEYS] + (i - 2 * N8) * 8, (bf16_t*)(ws + WS_SMALL + 512 * 1024) + (i - 2 * N8) * 8);
        }
    }
    if (vcu == 0) {
        float* sm = (float*)(ws + WS_SMALL);
        for (int i = tid; i < 2048; i += NTHR) { const float g0 = a.in[I_HGG][i], g1 = a.in[I_HGG][2048 + i]; sm[i] = 1.f / (1.f + expf(g1 - g0)); }
        if (tid < 16) {
            const float invf = expf(-(float)tid * (1.f / 16.f) * 9.210340371976184f);
            const double w = (double)invf, w2 = w * w;
            double cs = 1.0, sn = w, tc = 1.0, tsn = w;
            for (int n = 1; n < 12; ++n) { tc = -tc * w2 / (double)((2 * n - 1) * (2 * n)); tsn = -tsn * w2 / (double)((2 * n) * (2 * n + 1)); cs += tc; sn += tsn; }
            double c = 1.0, s = 0.0;
            for (int pos = 0; pos < 64; ++pos) {
                sm[4096 + pos * 16 + tid] = (float)c; sm[5120 + pos * 16 + tid] = (float)s;
                const double c2 = c * cs - s * sn, s2 = s * cs + c * sn; c = c2; s = s2;
            }
        }
        if (tid == 64) {
            float d1 = 0.f, d2 = 0.f;
            for (int i = 0; i < 64; ++i) { d1 += a.in[I_LQ1][i] * a.in[I_LK1][i]; d2 += a.in[I_LQ2][i] * a.in[I_LK2][i]; }
            sm[2048] = expf(d1) - expf(d2) + 0.2f;
        }
    }
}

template <int WHICH> __device__ __forceinline__ void norm_phase(const Args& a, int vcu, int G, int lane, int wave) {
    const int gw = vcu * NWAVES + wave, NGW = G * NWAVES;
    const float* mod = (const float*)(a.ws + WS_MOD);
    const float* bada = a.in[I_BADA];
    const float* gain = a.in[WHICH == 0 ? I_N1G : I_N2G];
    bf16_t* H = (bf16_t*)(a.ws + WS_H);
    constexpr int NR = WHICH == 0 ? M1 : ML, CSH = WHICH == 0 ? 0 : 3 * D, CSC = WHICH == 0 ? D : 4 * D;
    for (int R = gw; R < NR; R += NGW) {
        const float* src; int v;
        if (WHICH == 0) { const int b = R / TPB, p = R % TPB; if (p < CTX) { src = a.in[I_CTX] + (size_t)(b * CTX + p) * D; v = 2; } else { src = a.in[I_X] + (size_t)(b * SEQ + p - CTX) * D; v = b; } }
        else { src = a.out + (size_t)R * D; v = R / SEQ; }
        f32x4 x[8]; float ss = 0.f;
#pragma unroll
        for (int j = 0; j < 8; ++j) { x[j] = *(const f32x4*)(src + 256 * j + 4 * lane); ss += (x[j].x * x[j].x + x[j].y * x[j].y) + (x[j].z * x[j].z + x[j].w * x[j].w); }
        const float rstd = rsqrtf(wave_sum(ss) * (1.f / D) + RMS_EPS);
#pragma unroll
        for (int j = 0; j < 8; ++j) {
            const int col = 256 * j + 4 * lane;
            const f32x4 g = *(const f32x4*)(gain + col);
            const f32x4 sh = *(const f32x4*)(mod + v * NMOD + CSH + col) + *(const f32x4*)(bada + CSH + col);
            const f32x4 sc = *(const f32x4*)(mod + v * NMOD + CSC + col) + *(const f32x4*)(bada + CSC + col);
            const f32x4 y = x[j] * rstd * g * (sc + 1.f) + sh;
            u32x2 o; o.x = pk2(y.x, y.y); o.y = pk2(y.z, y.w);
            *(u32x2*)(H + (size_t)R * D + col) = o;
        }
    }
}

namespace pg8 {
struct OrderIn {
    int G, c;
    __device__ bool next(int i, Unit& u) const {
        const long L = (long)i * G + c; if (L >= 1064) return false;
        if (L < 1024) {
            int wgid = (int)L; wgid = (wgid & 7) * 128 + (wgid >> 3);
            const int pml = (wgid >> 8) * 8 + (wgid & 7);
            u.pm = pml < 16 ? pml + 1 : pml + 2; u.pn = (wgid & 255) >> 3;
        } else {
            const int e = (int)L - 1024, k = e % 20, g = k >> 2;
            u.pm = (e / 20) * 17; u.pn = (g < 3 ? g + 1 : g + 3) * 4 + (k & 3);
        }
        return true;
    }
    __device__ __forceinline__ void a_ready(const Unit&) const {}
    __device__ __forceinline__ void done(const Unit&) const {}
};
struct EpiIn {
    static constexpr bool PERM = false, AFTER_DRAIN = false;
    bf16_t* O; const float* lb; const float* ropec; const float* ropes;
    __device__ __forceinline__ void operator()(const f32x4 (&acc)[2][2][4][2], const Unit& u, int wr, int wc, int fr, int fq) const {
        const int part = u.pn >> 2; const bool is_ctx = (u.pm == 0 || u.pm == 17);
        const int row0 = u.pm * BM + wr * 64 + fr, col0 = u.pn * BM + wc * 32 + 4 * fq;
        f32x4 lbv[2][2];
        if (part == 1 || part == 2) {
#pragma unroll
            for (int bj = 0; bj < 2; ++bj)
#pragma unroll
                for (int n = 0; n < 2; ++n) lbv[bj][n] = *(const f32x4*)(lb + (col0 + bj * HALF + n * 16 - 1024));
        }
        const int tb = (u.pm >= 17) ? (row0 - 4352 - 256) : (row0 - 256);
#pragma unroll
        for (int ai = 0; ai < 2; ++ai)
#pragma unroll
            for (int m = 0; m < 4; ++m) {
                const int row = row0 + ai * HALF + m * 16;
                bf16_t* rowp = O + (size_t)row * 8192 + col0;
                f32x4 cs = {1.f, 1.f, 1.f, 1.f}, sn = {0.f, 0.f, 0.f, 0.f};
                if ((part == 5 || part == 6) && !is_ctx) { const int t = tb + ai * HALF + m * 16; const int pos = (wc & 1) ? (t & 63) : (t >> 6);
                    cs = *(const f32x4*)(ropec + pos * 16 + 4 * fq); sn = *(const f32x4*)(ropes + pos * 16 + 4 * fq); }
#pragma unroll
                for (int bj = 0; bj < 2; ++bj) {
                    f32x4 v0 = acc[ai][bj][m][0], v1 = acc[ai][bj][m][1];
                    if (part == 0 || part == 4) {
#pragma unroll
                        for (int j = 0; j < 4; ++j) { v0[j] = v0[j] / (1.f + __expf(-v0[j])); v1[j] = v1[j] / (1.f + __expf(-v1[j])); }
                    } else if (part == 1 || part == 2) {
#pragma unroll
                        for (int j = 0; j < 4; ++j) { const float l0 = lbv[bj][0][j], l1 = lbv[bj][1][j];
                            v0[j] = __logf(l0 + (1.f - l0) / (1.f + __expf(-v0[j]))); v1[j] = __logf(l1 + (1.f - l1) / (1.f + __expf(-v1[j]))); }
                    } else if (part == 5 || part == 6) {
                        const f32x4 a = v0 * cs - v1 * sn, b = v0 * sn + v1 * cs; v0 = a; v1 = b;
                    }
                    u32x2 w0, w1; w0.x = pk2(v0[0], v0[1]); w0.y = pk2(v0[2], v0[3]); w1.x = pk2(v1[0], v1[1]); w1.y = pk2(v1[2], v1[3]);
                    *(u32x2*)(rowp + bj * HALF) = w0; *(u32x2*)(rowp + bj * HALF + 16) = w1;
                }
            }
    }
};
struct EpiOut {
    static constexpr bool PERM = false, AFTER_DRAIN = false;
    const float* x; float* out; const float* mod; const float* bada;
    __device__ __forceinline__ void operator()(const f32x4 (&acc)[2][2][4][2], const Unit& u, int wr, int wc, int fr, int fq) const {
        const int row0 = u.pm * BM + wr * 64 + fr, col0 = u.pn * BM + wc * 32 + 4 * fq;
        const int b = (u.pm * BM) / 4096;
        f32x4 gv[2][2];
#pragma unroll
        for (int bj = 0; bj < 2; ++bj)
#pragma unroll
            for (int n = 0; n < 2; ++n) { const int c = col0 + bj * HALF + n * 16; gv[bj][n] = *(const f32x4*)(mod + b * 12288 + 4096 + c) + *(const f32x4*)(bada + 4096 + c); }
#pragma unroll
        for (int ai = 0; ai < 2; ++ai)
#pragma unroll
            for (int m = 0; m < 4; ++m) { const size_t off = (size_t)(row0 + ai * HALF + m * 16) * 2048 + col0;
#pragma unroll
                for (int bj = 0; bj < 2; ++bj)
#pragma unroll
                    for (int n = 0; n < 2; ++n) { const f32x4 xv = *(const f32x4*)(x + off + bj * HALF + n * 16); *(f32x4*)(out + off + bj * HALF + n * 16) = xv + gv[bj][n] * acc[ai][bj][m][n]; } }
    }
};
}

namespace att {
constexpr int QBLK = 32, KVBLK = 64, NT = TPB / KVBLK;
constexpr float SCALE = 0.125f, THR = 8.f;
constexpr int SHM_V = 16384, SHM_K = 16384, OFF_WS = 65536, OFF_X = 67584, XROW = 132;
#define KSWZ(row, colB) ((row) * 256 + ((colB) ^ (((row) & 7) << 4)))
__device__ __forceinline__ unsigned cvtpk(float lo, float hi) { unsigned r; asm volatile("v_cvt_pk_bf16_f32 %0, %1, %2" : "=v"(r) : "v"(lo), "v"(hi)); return r; }
__device__ __forceinline__ void partialSM(f32x16& p0, f32x16& p1, float& m_reg, float& mn, float& alpha) {
  constexpr float C = SCALE * 1.4426950408889634f;
  float pmax = p0[0];
#pragma unroll
  for (int r = 1; r < 16; ++r) pmax = fmaxf(pmax, p0[r]);
#pragma unroll
  for (int r = 0; r < 16; ++r) pmax = fmaxf(pmax, p1[r]);
  { auto rr = __builtin_amdgcn_permlane32_swap(__float_as_uint(pmax), __float_as_uint(pmax), false, false);
    pmax = fmaxf(__uint_as_float(rr[0]), __uint_as_float(rr[1])); }
  if (__builtin_expect(__all(pmax - m_reg <= THR / SCALE), 1)) { mn = m_reg; alpha = 1.f; }
  else { mn = fmaxf(m_reg, pmax); alpha = __builtin_amdgcn_exp2f((m_reg - mn) * C); m_reg = mn; }
  float mnC = -mn * C;
#pragma unroll
  for (int r = 0; r < 16; ++r) p0[r] = fmaf(p0[r], C, mnC);
#pragma unroll
  for (int r = 0; r < 16; ++r) p1[r] = fmaf(p1[r], C, mnC);
#pragma unroll
  for (int r = 0; r < 16; ++r) p0[r] = __builtin_amdgcn_exp2f(p0[r]);
}
__device__ __forceinline__ void finishSM(f32x16& p0, f32x16& p1, float alpha, float& l_reg, bf16x8& pa0, bf16x8& pa1, bf16x8& pa2, bf16x8& pa3) {
#pragma unroll
  for (int r = 0; r < 16; ++r) p1[r] = __builtin_amdgcn_exp2f(p1[r]);
  float ps = 0;
#pragma unroll
  for (int r = 0; r < 16; ++r) ps += p0[r];
#pragma unroll
  for (int r = 0; r < 16; ++r) ps += p1[r];
  { auto rr = __builtin_amdgcn_permlane32_swap(__float_as_uint(ps), __float_as_uint(ps), false, false);
    ps = __uint_as_float(rr[0]) + __uint_as_float(rr[1]); }
  l_reg = l_reg * alpha + ps;
#define PK4(P, BASE, OUT) do { unsigned a0 = cvtpk(P[BASE + 0], P[BASE + 1]), a1 = cvtpk(P[BASE + 2], P[BASE + 3]);   \
    unsigned b0 = cvtpk(P[BASE + 4], P[BASE + 5]), b1 = cvtpk(P[BASE + 6], P[BASE + 7]);                              \
    auto r0 = __builtin_amdgcn_permlane32_swap(a0, b0, false, false); auto r1 = __builtin_amdgcn_permlane32_swap(a1, b1, false, false); \
    u32x4 w = {r0[0], r1[0], r0[1], r1[1]}; OUT = *reinterpret_cast<bf16x8*>(&w); } while (0)
  PK4(p0, 0, pa0); PK4(p0, 8, pa1); PK4(p1, 0, pa2); PK4(p1, 8, pa3);
#undef PK4
}
__device__ __forceinline__ void qkt(f32x16& p0, f32x16& p1, const char* Ks, const bf16x8* qr, int r32, int hi, int stb) {
  p0 = f32x16{}; p1 = f32x16{};
#pragma unroll
  for (int d0 = 0; d0 < 4; ++d0) { int cb = stb + (d0 * 16 + hi * 8) * 2;
    bf16x8 b0 = *reinterpret_cast<const bf16x8*>(Ks + KSWZ(r32, cb));
    bf16x8 b1 = *reinterpret_cast<const bf16x8*>(Ks + KSWZ(32 + r32, cb));
    p0 = __builtin_amdgcn_mfma_f32_32x32x16_bf16(b0, qr[d0], p0, 0, 0, 0);
    p1 = __builtin_amdgcn_mfma_f32_32x32x16_bf16(b1, qr[d0], p1, 0, 0, 0); }
}
__device__ __forceinline__ void pv_d0(f32x16* o, int vb, bf16x8 pa0, bf16x8 pa1, bf16x8 pa2, bf16x8 pa3) {
  pv_one<0>(o[0], vb, pa0, pa1, pa2, pa3); pv_one<1>(o[1], vb, pa0, pa1, pa2, pa3); pv_one<2>(o[2], vb, pa0, pa1, pa2, pa3); pv_one<3>(o[3], vb, pa0, pa1, pa2, pa3);
}
__device__ __forceinline__ void attn_unit(const bf16_t* __restrict__ parts, bf16_t* __restrict__ mix, const float* __restrict__ subg, float lam, int b, int h, int qb, char* lds) {
  const int tid = threadIdx.x, wid = tid >> 6, lane = tid & 63, r32 = lane & 31, hi = lane >> 5;
  const int st = wid >> 2, rb = wid & 3;
  char* V_lds = lds; char* K_lds = lds + 2 * SHM_V;
  float* ws = (float*)(lds + OFF_WS) + wid * 64; float* li_l = ws; float* al_l = ws + 32;
  float m_reg = -1e30f, l_reg = 0; f32x16 o[4] = {}; bf16x8 qr[4];
  const bf16_t* Kh = parts + (size_t)b * TPB * NIN + C_DK + h * 128;
  const bf16_t* Vh = parts + (size_t)b * TPB * NIN + C_DV + h * 128;
  const bf16_t* Qw = parts + ((size_t)b * TPB + CTX + qb * 128 + rb * QBLK + r32) * NIN + C_DQ + h * 128 + st * 64 + hi * 8;
#pragma unroll
  for (int d0 = 0; d0 < 4; ++d0) qr[d0] = *reinterpret_cast<const bf16x8*>(Qw + d0 * 16);
  const int stb = st * 128;
  const int sr = tid >> 4, sc = (tid & 15) * 8, vst0 = v_st(sr, sc), vst1 = v_st(32 + sr, sc);
  const int vb0 = (int)(uintptr_t)V_lds + v_rd_base(lane);
  struct { bf16x8 vs0, vs1, ks0, ks1; } sr_[2];
#define SLOAD(i, k0) do { sr_[i].vs0 = *reinterpret_cast<const bf16x8*>(&Vh[(size_t)((k0) + sr) * NIN + sc]); sr_[i].vs1 = *reinterpret_cast<const bf16x8*>(&Vh[(size_t)((k0) + 32 + sr) * NIN + sc]); \
    sr_[i].ks0 = *reinterpret_cast<const bf16x8*>(&Kh[(size_t)((k0) + sr) * NIN + sc]); sr_[i].ks1 = *reinterpret_cast<const bf16x8*>(&Kh[(size_t)((k0) + 32 + sr) * NIN + sc]); } while (0)
#define SWRITE(bb, i) do { *(bf16x8*)(V_lds + (bb) * SHM_V + vst0) = sr_[i].vs0;          \
    *(bf16x8*)(V_lds + (bb) * SHM_V + vst1) = sr_[i].vs1; int kc = sc * 2;               \
    *(bf16x8*)(K_lds + (bb) * SHM_K + KSWZ(sr, kc)) = sr_[i].ks0;                       \
    *(bf16x8*)(K_lds + (bb) * SHM_K + KSWZ(32 + sr, kc)) = sr_[i].ks1; } while (0)
#define SWAIT() asm volatile("s_waitcnt vmcnt(4)" ::: "memory")
#define RESC(a) do { if (__any((a) < 1.f)) { if (hi == 0) al_l[r32] = (a); asm volatile("s_waitcnt lgkmcnt(0)" ::: "memory"); \
    _Pragma("unroll") for (int d = 0; d < 4; ++d) _Pragma("unroll") for (int r = 0; r < 16; ++r) o[d][r] *= al_l[crow(r, hi)]; } } while (0)
  f32x16 pA0, pA1, pB0, pB1; float mnA, mnB, alA, alB; bf16x8 pa0, pa1, pa2, pa3;
  constexpr int SE = 0, SO = 1;
  SLOAD(SE, 0); asm volatile("s_waitcnt vmcnt(0)" ::: "memory"); SWRITE(0, SE); __syncthreads();
  qkt(pA0, pA1, K_lds, qr, r32, hi, stb); partialSM(pA0, pA1, m_reg, mnA, alA);
  SLOAD(SO, KVBLK); SLOAD(SE, 2 * KVBLK);
  SWAIT(); SWRITE(1, SO); __syncthreads();
  for (int j = 1; j + 1 < NT; j += 2) {
    SBAR(); qkt(pB0, pB1, K_lds + SHM_K, qr, r32, hi, stb);
    finishSM(pA0, pA1, alA, l_reg, pa0, pa1, pa2, pa3); SBAR();
    SLOAD(SO, (j + 2) * KVBLK); SBAR();
    pv_d0(o, vb0, pa0, pa1, pa2, pa3); partialSM(pB0, pB1, m_reg, mnB, alB);
    __syncthreads(); SWAIT(); SWRITE(0, SE);
    RESC(alB); __syncthreads();
    SBAR(); qkt(pA0, pA1, K_lds, qr, r32, hi, stb);
    finishSM(pB0, pB1, alB, l_reg, pa0, pa1, pa2, pa3); SBAR();
    if (j + 3 < NT) SLOAD(SE, (j + 3) * KVBLK); SBAR();
    pv_d0(o, vb0 + SHM_V, pa0, pa1, pa2, pa3); partialSM(pA0, pA1, m_reg, mnA, alA);
    __syncthreads(); SWAIT(); SWRITE(1, SO);
    RESC(alA); __syncthreads();
  }
  SBAR(); qkt(pB0, pB1, K_lds + SHM_K, qr, r32, hi, stb);
  finishSM(pA0, pA1, alA, l_reg, pa0, pa1, pa2, pa3); SBAR();
  pv_d0(o, vb0, pa0, pa1, pa2, pa3); partialSM(pB0, pB1, m_reg, mnB, alB);
  __syncthreads(); RESC(alB);
  finishSM(pB0, pB1, alB, l_reg, pa0, pa1, pa2, pa3); SBAR();
  pv_d0(o, vb0 + SHM_V, pa0, pa1, pa2, pa3);
  if (hi == 0) li_l[r32] = l_reg; asm volatile("s_waitcnt lgkmcnt(0)" ::: "memory");
  float rli[16];
#pragma unroll
  for (int r = 0; r < 16; ++r) rli[r] = __builtin_amdgcn_rcpf(li_l[crow(r, hi)]);
  float* X = (float*)(lds + OFF_X);
  if (st == 1) {
#pragma unroll
    for (int r = 0; r < 16; ++r)
#pragma unroll
      for (int d0 = 0; d0 < 4; ++d0) X[(32 * rb + crow(r, hi)) * XROW + 32 * d0 + r32] = o[d0][r] * rli[r] * lam;
  }
  __syncthreads();
  if (st == 0) {
    float ss[16];
#pragma unroll
    for (int r = 0; r < 16; ++r) { float acc = 0.f;
#pragma unroll
      for (int d0 = 0; d0 < 4; ++d0) { const float v = o[d0][r] * rli[r] - X[(32 * rb + crow(r, hi)) * XROW + 32 * d0 + r32]; o[d0][r] = v; acc += v * v; }
      ss[r] = acc; }
#pragma unroll
    for (int r = 0; r < 16; ++r) {
#pragma unroll
      for (int m = 1; m < 32; m <<= 1) ss[r] += __shfl_xor(ss[r], m); }
    float gsc[4];
#pragma unroll
    for (int d0 = 0; d0 < 4; ++d0) gsc[d0] = subg[h * 128 + 32 * d0 + r32] * 0.8f;
    bf16_t* mo = mix + ((size_t)b * SEQ + qb * 128 + rb * QBLK) * D + 1024 + h * 128 + r32;
#pragma unroll
    for (int r = 0; r < 16; ++r) { const float rs = rsqrtf(ss[r] * (1.f / 128.f) + RMS_EPS);
#pragma unroll
      for (int d0 = 0; d0 < 4; ++d0) mo[(size_t)crow(r, hi) * D + 32 * d0] = f2bf(o[d0][r] * rs * gsc[d0]); }
  }
  __syncthreads();
#undef SLOAD
#undef SWRITE
#undef SWAIT
#undef RESC
}
}

namespace hg {
constexpr int O_V = 0, O_QR = 16384, O_KR = 33792, O_KT = 51200, O_PL = 69632, O_ST = 78848, O_TAB = 113664, O_RS = 117248;
constexpr int RQ = 272, RT = 144;

template <bool WITH_Q> __device__ __forceinline__ float elem_stage(const bf16_t* __restrict__ parts, size_t r0, int h, int dir, char* lds, int tid) {
    const int dk = tid & 127, q4 = tid >> 7;
    const bf16_t* plf = parts + (r0 + 16 * q4) * NIN + (dir ? C_FB : C_FF) + h * 128 + dk;
    float lfv[16], cum[16], qv[16];
#pragma unroll
    for (int i = 0; i < 16; ++i) lfv[i] = bf2f(plf[(size_t)i * NIN]);
    if (WITH_Q) { const bf16_t* pq = parts + (r0 + 16 * q4) * NIN + C_HQ + h * 128 + dk;
#pragma unroll
        for (int i = 0; i < 16; ++i) qv[i] = bf2f(pq[(size_t)i * NIN]); }
    const int sr = tid >> 4, scn = (tid & 15) * 8;
    const bf16x8 v0 = *(const bf16x8*)(parts + (r0 + sr) * NIN + C_HI + h * 128 + scn), v1 = *(const bf16x8*)(parts + (r0 + 32 + sr) * NIN + C_HI + h * 128 + scn);
    float run = 0.f;
    if (dir == 0) {
#pragma unroll
        for (int i = 0; i < 16; ++i) { run += lfv[i]; cum[i] = run; }
    } else {
#pragma unroll
        for (int i = 15; i >= 0; --i) { run += lfv[i]; cum[i] = run; }
    }
    float* TAB = (float*)(lds + O_TAB);
    TAB[q4 * 128 + dk] = run;
    *(bf16x8*)(lds + O_V + v_st(sr, scn)) = v0; *(bf16x8*)(lds + O_V + v_st(32 + sr, scn)) = v1;
    __syncthreads();
    const float s0 = TAB[dk], s1 = TAB[128 + dk], s2 = TAB[256 + dk], s3 = TAB[384 + dk];
    const float total = (s0 + s1) + (s2 + s3);
    float off, ref;
    if (dir == 0) { off = (q4 > 0 ? s0 : 0.f) + (q4 > 1 ? s1 : 0.f) + (q4 > 2 ? s2 : 0.f); ref = s0 + s1; }
    else { off = (q4 < 3 ? s3 : 0.f) + (q4 < 2 ? s2 : 0.f) + (q4 < 1 ? s1 : 0.f); ref = s2 + s3; }
    unsigned kp[8];
#pragma unroll
    for (int i = 0; i < 16; i += 2) {
        const float c0 = cum[i] + off, c1 = cum[i + 1] + off;
        const float k0 = (1.f - __expf(lfv[i])) * __expf(ref - c0), k1 = (1.f - __expf(lfv[i + 1])) * __expf(ref - c1);
        kp[i >> 1] = pk2(k0, k1);
        if (WITH_Q) {
            const int s = 16 * q4 + i;
            *(bf16_t*)(lds + O_KR + s * RQ + dk * 2) = (bf16_t)(kp[i >> 1] & 0xffffu); *(bf16_t*)(lds + O_KR + (s + 1) * RQ + dk * 2) = (bf16_t)(kp[i >> 1] >> 16);
            const unsigned qp = pk2(qv[i] * __expf(c0 - ref), qv[i + 1] * __expf(c1 - ref));
            *(bf16_t*)(lds + O_QR + s * RQ + dk * 2) = (bf16_t)(qp & 0xffffu); *(bf16_t*)(lds + O_QR + (s + 1) * RQ + dk * 2) = (bf16_t)(qp >> 16);
        }
    }
    *(u32x4*)(lds + O_KT + dk * RT + q4 * 32) = (u32x4){kp[0], kp[1], kp[2], kp[3]};
    *(u32x4*)(lds + O_KT + dk * RT + q4 * 32 + 16) = (u32x4){kp[4], kp[5], kp[6], kp[7]};
    if (q4 == 0) { TAB[512 + dk] = __expf(ref); TAB[640 + dk] = __expf(total); TAB[768 + dk] = __expf(total - ref); }
    return total;
}
__device__ __forceinline__ void state_update(f32x16 (&S)[2], const char* lds, int mt, int nt0, int r32, int hi, int vb) {
    const float* TAB = (const float*)(lds + O_TAB);
    float el[16], er[16];
#pragma unroll
    for (int r = 0; r < 16; ++r) { const int d = 32 * mt + crow(r, hi); el[r] = TAB[640 + d]; er[r] = TAB[768 + d]; }
    bf16x8 kt[4];
#pragma unroll
    for (int ks = 0; ks < 4; ++ks) kt[ks] = *(const bf16x8*)(lds + O_KT + (32 * mt + r32) * RT + (16 * ks + 8 * hi) * 2);
#pragma unroll
    for (int t2 = 0; t2 < 2; ++t2) { f32x16 U = {}; pv_one<0>(U, vb + (nt0 + t2) * 512, kt[0], kt[1], kt[2], kt[3]);
#pragma unroll
        for (int r = 0; r < 16; ++r) S[t2][r] = el[r] * S[t2][r] + er[r] * U[r]; }
}
__device__ __forceinline__ void task_trans(const bf16_t* __restrict__ parts, float* __restrict__ hst, float* __restrict__ hd, int b, int h, int dir, int j, char* lds) {
    const int tid = threadIdx.x, wid = tid >> 6, lane = tid & 63, r32 = lane & 31, hi = lane >> 5, mt = wid >> 1, nt0 = 2 * (wid & 1);
    const int p0 = (j == 0) ? 0 : CTX + 256 * (dir == 0 ? j - 1 : 16 - j);
    const int vb = (int)(uintptr_t)(lds + O_V) + v_rd_base(lane);
    f32x16 S[2] = {}; float lsum = 0.f;
    for (int cc = 0; cc < 4; ++cc) {
        const int c = dir ? 3 - cc : cc;
        lsum += elem_stage<false>(parts, (size_t)b * TPB + p0 + 64 * c, h, dir, lds, tid);
        __syncthreads();
        state_update(S, lds, mt, nt0, r32, hi, vb);
        __syncthreads();
    }
    const int chain = (b * 8 + h) * 2 + dir;
    float* sp = hst + (size_t)(chain * 16 + j) * 16384;
#pragma unroll
    for (int t2 = 0; t2 < 2; ++t2)
#pragma unroll
        for (int r = 0; r < 16; ++r) sp[(32 * mt + crow(r, hi)) * 128 + 32 * (nt0 + t2) + r32] = S[t2][r];
    if (tid < 128) hd[(chain * 16 + j) * 128 + tid] = __expf(lsum);
}
__device__ __forceinline__ void scan_phase(float* __restrict__ hst, const float* __restrict__ hd, int vcu, int G, int tid) {
    for (int idx = vcu * NTHR + tid; idx < 32 * 4096; idx += G * NTHR) {
        const int chain = idx >> 12, e4 = idx & 4095, dk = e4 >> 5;
        f32x4 S = {0.f, 0.f, 0.f, 0.f};
        float* p = hst + (size_t)chain * 16 * 16384 + e4 * 4;
        f32x4 u[16]; float d[16];
#pragma unroll
        for (int j = 0; j < 16; ++j) { u[j] = *(const f32x4*)(p + (size_t)j * 16384); d[j] = hd[(chain * 16 + j) * 128 + dk]; }
#pragma unroll
        for (int j = 0; j < 16; ++j) { S = S * d[j] + u[j]; *(f32x4*)(p + (size_t)j * 16384) = S; }
    }
}
__device__ __forceinline__ void task_out(const bf16_t* __restrict__ parts, bf16_t* __restrict__ mix, const float* __restrict__ hst, float* __restrict__ of, const float* __restrict__ ng,
                                         int b, int h, int sc, char* lds) {
    const int tid = threadIdx.x, wid = tid >> 6, lane = tid & 63, r32 = lane & 31, hi = lane >> 5;
    const int mt = wid >> 1, nt0 = 2 * (wid & 1), rt = wid >> 2, ct = wid & 3;
    const int vb = (int)(uintptr_t)(lds + O_V) + v_rd_base(lane);
    const float* TAB = (const float*)(lds + O_TAB);
    for (int dir = 0; dir < 2; ++dir) {
        const int chain = (b * 8 + h) * 2 + dir, jj = dir == 0 ? sc : 15 - sc;
        const float* sp = hst + (size_t)(chain * 16 + jj) * 16384;
        f32x16 S[2];
#pragma unroll
        for (int t2 = 0; t2 < 2; ++t2)
#pragma unroll
            for (int r = 0; r < 16; ++r) S[t2][r] = sp[(32 * mt + crow(r, hi)) * 128 + 32 * (nt0 + t2) + r32];
        for (int cc = 0; cc < 4; ++cc) {
            const int c = dir ? 3 - cc : cc;
            const size_t r0 = (size_t)b * TPB + CTX + 256 * sc + 64 * c;
            elem_stage<true>(parts, r0, h, dir, lds, tid);
            __syncthreads();
            {
                float ef[16];
#pragma unroll
                for (int r = 0; r < 16; ++r) ef[r] = TAB[512 + 32 * mt + crow(r, hi)];
#pragma unroll
                for (int t2 = 0; t2 < 2; ++t2)
#pragma unroll
                    for (int g = 0; g < 4; ++g) { u32x2 w; w.x = pk2(S[t2][4 * g] * ef[4 * g], S[t2][4 * g + 1] * ef[4 * g + 1]); w.y = pk2(S[t2][4 * g + 2] * ef[4 * g + 2], S[t2][4 * g + 3] * ef[4 * g + 3]);
                        *(u32x2*)(lds + O_ST + (32 * (nt0 + t2) + r32) * RQ + (32 * mt + 8 * g + 4 * hi) * 2) = w; }
            }
            if (wid < 4) {
                const int si = wid >> 1, ti = wid & 1;
                f32x16 P = {};
#pragma unroll
                for (int ks = 0; ks < 8; ++ks) {
                    const bf16x8 ka = *(const bf16x8*)(lds + O_KR + (32 * si + r32) * RQ + (16 * ks + 8 * hi) * 2);
                    const bf16x8 qb = *(const bf16x8*)(lds + O_QR + (32 * ti + r32) * RQ + (16 * ks + 8 * hi) * 2);
                    P = __builtin_amdgcn_mfma_f32_32x32x16_bf16(ka, qb, P, 0, 0, 0);
                }
                const int t = 32 * ti + r32;
#pragma unroll
                for (int g = 0; g < 4; ++g) {
                    float pv[4];
#pragma unroll
                    for (int e = 0; e < 4; ++e) { const int s = 32 * si + 8 * g + 4 * hi + e; const bool keep = dir == 0 ? (s <= t) : (s >= t); pv[e] = keep ? P[4 * g + e] : 0.f; }
                    u32x2 w; w.x = pk2(pv[0], pv[1]); w.y = pk2(pv[2], pv[3]);
                    *(u32x2*)(lds + O_PL + t * RT + (32 * si + 8 * g + 4 * hi) * 2) = w;
                }
            }
            __syncthreads();
            f32x16 o = {};
            {
                bf16x8 pa[4];
#pragma unroll
                for (int ks = 0; ks < 4; ++ks) pa[ks] = *(const bf16x8*)(lds + O_PL + (32 * rt + r32) * RT + (16 * ks + 8 * hi) * 2);
                pv_one<0>(o, vb + ct * 512, pa[0], pa[1], pa[2], pa[3]);
#pragma unroll
                for (int ks = 0; ks < 8; ++ks) {
                    const bf16x8 qa = *(const bf16x8*)(lds + O_QR + (32 * rt + r32) * RQ + (16 * ks + 8 * hi) * 2);
                    const bf16x8 sb = *(const bf16x8*)(lds + O_ST + (32 * ct + r32) * RQ + (16 * ks + 8 * hi) * 2);
                    o = __builtin_amdgcn_mfma_f32_32x32x16_bf16(qa, sb, o, 0, 0, 0);
                }
            }
            state_update(S, lds, mt, nt0, r32, hi, vb);
            float* ofp = of + ((((size_t)(b * 8 + h) * 16 + sc) * 4 + c) * 8 + wid) * 1024 + lane;
            if (dir == 0) {
#pragma unroll
                for (int r = 0; r < 16; ++r) ofp[r * 64] = o[r];
                __syncthreads();
            } else {
                float* OT = (float*)(lds + O_RS);
#pragma unroll
                for (int r = 0; r < 16; ++r) OT[(32 * rt + crow(r, hi)) * 132 + 32 * ct + r32] = o[r] + ofp[r * 64];
                __syncthreads();
                const int row = tid >> 3, seg = tid & 7;
                f32x4 x[4]; float ss = 0.f;
#pragma unroll
                for (int q = 0; q < 4; ++q) { x[q] = *(const f32x4*)(OT + row * 132 + 16 * seg + 4 * q); ss += (x[q].x * x[q].x + x[q].y * x[q].y) + (x[q].z * x[q].z + x[q].w * x[q].w); }
                ss += __shfl_xor(ss, 1); ss += __shfl_xor(ss, 2); ss += __shfl_xor(ss, 4);
                const float rs = rsqrtf(ss * (1.f / 128.f) + RMS_EPS);
                const int trow = 256 * sc + 64 * c + row;
                const bf16_t* gp = parts + ((size_t)b * TPB + CTX + trow) * NIN + C_HG + h * 128 + 16 * seg;
                const u32x4 g0 = *(const u32x4*)gp, g1 = *(const u32x4*)(gp + 8);
                const float* ngp = ng + h * 128 + 16 * seg;
                const f32x4 n0 = *(const f32x4*)ngp * rs, n1 = *(const f32x4*)(ngp + 4) * rs, n2 = *(const f32x4*)(ngp + 8) * rs, n3 = *(const f32x4*)(ngp + 12) * rs;
                u32x4 w0, w1;
#define GLO(w) __uint_as_float((w) << 16)
#define GHI(w) __uint_as_float((w) & 0xffff0000u)
                w0.x = pk2(x[0].x * n0.x * GLO(g0.x), x[0].y * n0.y * GHI(g0.x)); w0.y = pk2(x[0].z * n0.z * GLO(g0.y), x[0].w * n0.w * GHI(g0.y));
                w0.z = pk2(x[1].x * n1.x * GLO(g0.z), x[1].y * n1.y * GHI(g0.z)); w0.w = pk2(x[1].z * n1.z * GLO(g0.w), x[1].w * n1.w * GHI(g0.w));
                w1.x = pk2(x[2].x * n2.x * GLO(g1.x), x[2].y * n2.y * GHI(g1.x)); w1.y = pk2(x[2].z * n2.z * GLO(g1.y), x[2].w * n2.w * GHI(g1.y));
                w1.z = pk2(x[3].x * n3.x * GLO(g1.z), x[3].y * n3.y * GHI(g1.z)); w1.w = pk2(x[3].z * n3.z * GLO(g1.w), x[3].w * n3.w * GHI(g1.w));
#undef GLO
#undef GHI
                bf16_t* mo = mix + ((size_t)(b * SEQ + trow)) * D + h * 128 + 16 * seg;
                *(u32x4*)mo = w0; *(u32x4*)(mo + 8) = w1;
            }
        }
    }
    __syncthreads();
}
}

namespace tk {
constexpr int SROW = 260, EROW = 17;
__device__ __forceinline__ void ins16(float (&v)[16], int (&ix)[16], float x, int id) {
#pragma unroll
    for (int k = 0; k < 16; ++k) { const bool c = x > v[k]; const float tv = c ? v[k] : x; const int ti = c ? ix[k] : id; v[k] = c ? x : v[k]; ix[k] = c ? id : ix[k]; x = tv; id = ti; asm volatile("" : "+v"(x), "+v"(id)); }
}
__device__ __forceinline__ void task(const bf16_t* __restrict__ qp, const bf16_t* __restrict__ keys, int* __restrict__ idx, float* __restrict__ coef, int tb, int h, char* lds) {
    const int tid = threadIdx.x, wid = tid >> 6, lane = tid & 63, r32 = lane & 31, hi = lane >> 5;
    float* sc = (float*)lds;
    {
        const int j = wid >> 2, n0 = 32 * (wid & 3);
        bf16x8 bk[8];
        const bf16_t* kp = keys + (size_t)((h * 2 + j) * 128 + n0 + r32) * 128 + 8 * hi;
#pragma unroll
        for (int ks = 0; ks < 8; ++ks) bk[ks] = *(const bf16x8*)(kp + 16 * ks);
#pragma unroll
        for (int tt = 0; tt < 4; ++tt) {
            const bf16_t* qrow = qp + (size_t)(tb * 128 + 32 * tt + r32) * D + h * 256 + j * 128 + 8 * hi;
            f32x16 acc = {};
#pragma unroll
            for (int ks = 0; ks < 8; ++ks) { const bf16x8 a = *(const bf16x8*)(qrow + 16 * ks); acc = __builtin_amdgcn_mfma_f32_32x32x16_bf16(a, bk[ks], acc, 0, 0, 0); }
#pragma unroll
            for (int r = 0; r < 16; ++r) sc[(32 * tt + crow(r, hi)) * SROW + j * 128 + n0 + r32] = acc[r];
        }
    }
    __syncthreads();
    const int token = tid & 127, jj = (tid >> 7) & 1, half = tid >> 8;
    float v[16]; int ix[16];
#pragma unroll
    for (int k = 0; k < 16; ++k) { v[k] = -3.0e38f; ix[k] = 0; }
    {
        const f32x4* sp = (const f32x4*)(sc + token * SROW + jj * 128 + half * 64);
#pragma nounroll
        for (int i4 = 0; i4 < 16; ++i4) { const f32x4 x = sp[i4]; const int n = half * 64 + 4 * i4;
            ins16(v, ix, x.x, n); ins16(v, ix, x.y, n + 1); ins16(v, ix, x.z, n + 2); ins16(v, ix, x.w, n + 3); }
    }
    __syncthreads();
    float* exv = (float*)lds; int* exi = (int*)(lds + 32768);
    const int eo = (jj * 128 + token) * EROW;
    if (half == 1) {
#pragma unroll
        for (int k = 0; k < 16; ++k) { exv[eo + k] = v[k]; exi[eo + k] = ix[k]; }
    }
    __syncthreads();
    if (half == 0) {
#pragma nounroll
        for (int k = 0; k < 16; ++k) ins16(v, ix, exv[eo + k], exi[eo + k]);
    }
    __syncthreads();
    if (half == 0) {
#pragma unroll
        for (int k = 0; k < 16; ++k) { exv[eo + k] = v[k]; exi[eo + k] = ix[k]; }
    }
    __syncthreads();
    if (half == 0 && jj == 0) {
        float bv[16]; int be[16];
#pragma unroll
        for (int k = 0; k < 16; ++k) { bv[k] = -3.0e38f; be[k] = 0; }
        const int e1 = (128 + token) * EROW;
#pragma nounroll
        for (int aa = 0; aa < 16; ++aa) {
            const float sa = exv[eo + aa]; const int ia = exi[eo + aa] * 128; const int nb = 16 / (aa + 1);
#pragma nounroll
            for (int bq = 0; bq < nb; ++bq) ins16(bv, be, sa + exv[e1 + bq], ia + exi[e1 + bq]);
        }
        float e[16], sum = 0.f;
#pragma unroll
        for (int k = 0; k < 16; ++k) { e[k] = __expf(bv[k] - bv[0]); sum += e[k]; }
        const float inv = 1.f / sum;
        const size_t o = ((size_t)(tb * 128 + token) * 8 + h) * 16;
#pragma unroll
        for (int k4 = 0; k4 < 4; ++k4) { *(i32x4*)(idx + o + 4 * k4) = (i32x4){be[4 * k4], be[4 * k4 + 1], be[4 * k4 + 2], be[4 * k4 + 3]};
            *(f32x4*)(coef + o + 4 * k4) = (f32x4){e[4 * k4] * inv, e[4 * k4 + 1] * inv, e[4 * k4 + 2] * inv, e[4 * k4 + 3] * inv}; }
    }
    __syncthreads();
}
}

namespace pe {
__device__ __forceinline__ float gelu_erf(float x) { return 0.5f * x * (1.f + erff(x * 0.7071067811865476f)); }
__device__ __forceinline__ float lo16(unsigned w) { return __uint_as_float(w << 16); }
__device__ __forceinline__ float hi16(unsigned w) { return __uint_as_float(w & 0xffff0000u); }
__device__ __forceinline__ void token_task(const Args& a, int t, int lane) {
    const bf16_t* H2 = (const bf16_t*)(a.ws + WS_H);
    const char* UB = (const char*)(a.ws + WS_UBF); const char* VB = (const char*)(a.ws + WS_VBF);
    const int* idx = (const int*)(a.ws + WS_IDX) + (size_t)t * 128; const float* coef = (const float*)(a.ws + WS_COEF) + (size_t)t * 128;
    float hx[32];
#pragma unroll
    for (int j = 0; j < 4; ++j) { const u32x4 w = *(const u32x4*)(H2 + (size_t)t * D + 512 * j + 8 * lane);
        hx[8 * j] = lo16(w.x); hx[8 * j + 1] = hi16(w.x); hx[8 * j + 2] = lo16(w.y); hx[8 * j + 3] = hi16(w.y); hx[8 * j + 4] = lo16(w.z); hx[8 * j + 5] = hi16(w.z); hx[8 * j + 6] = lo16(w.w); hx[8 * j + 7] = hi16(w.w); }
    float y[32];
#pragma unroll
    for (int i = 0; i < 32; ++i) y[i] = 0.f;
    for (int bt = 0; bt < 2; ++bt) {
        const int myid = idx[bt * 64 + lane]; const float myg = coef[bt * 64 + lane];
        float p[64];
#pragma unroll
        for (int e = 0; e < 64; ++e) {
            const int row = __builtin_amdgcn_readlane(myid, e);
            const char* rp = UB + (size_t)row * (D * 2) + 16 * lane;
            float acc = 0.f;
#pragma unroll
            for (int j = 0; j < 4; ++j) { const u32x4 w = *(const u32x4*)(rp + 1024 * j);
                acc += lo16(w.x) * hx[8 * j] + hi16(w.x) * hx[8 * j + 1] + lo16(w.y) * hx[8 * j + 2] + hi16(w.y) * hx[8 * j + 3]
                     + lo16(w.z) * hx[8 * j + 4] + hi16(w.z) * hx[8 * j + 5] + lo16(w.w) * hx[8 * j + 6] + hi16(w.w) * hx[8 * j + 7]; }
            p[e] = acc;
        }
#define TRS(N, M) _Pragma("unroll") for (int i = 0; i < N; ++i) { const float snd = (lane & M) ? p[i] : p[i + N]; const float kp = (lane & M) ? p[i + N] : p[i]; p[i] = kp + __shfl_xor(snd, M); }
        TRS(32, 32) TRS(16, 16) TRS(8, 8) TRS(4, 4) TRS(2, 2) TRS(1, 1)
#undef TRS
        const float ce = myg * gelu_erf(p[0]);
#pragma unroll 4
        for (int e = 0; e < 64; ++e) {
            const int row = __builtin_amdgcn_readlane(myid, e);
            const float cs = __int_as_float(__builtin_amdgcn_readlane(__float_as_int(ce), e));
            const char* rp = VB + (size_t)row * (D * 2) + 16 * lane;
#pragma unroll
            for (int j = 0; j < 4; ++j) { const u32x4 w = *(const u32x4*)(rp + 1024 * j);
                y[8 * j] += cs * lo16(w.x); y[8 * j + 1] += cs * hi16(w.x); y[8 * j + 2] += cs * lo16(w.y); y[8 * j + 3] += cs * hi16(w.y);
                y[8 * j + 4] += cs * lo16(w.z); y[8 * j + 5] += cs * hi16(w.z); y[8 * j + 6] += cs * lo16(w.w); y[8 * j + 7] += cs * hi16(w.w); }
        }
    }
    const int b = t / SEQ;
    const float* mod = (const float*)(a.ws + WS_MOD) + b * NMOD + 5 * D; const float* bada = a.in[I_BADA] + 5 * D; const float* fg = a.in[I_FNG];
    float* xo = a.out + (size_t)t * D;
    float ss = 0.f;
#pragma unroll
    for (int j = 0; j < 4; ++j)
#pragma unroll
        for (int q = 0; q < 2; ++q) { const int col = 512 * j + 8 * lane + 4 * q;
            const f32x4 x1 = *(const f32x4*)(xo + col); const f32x4 g2 = *(const f32x4*)(mod + col) + *(const f32x4*)(bada + col);
#pragma unroll
            for (int e = 0; e < 4; ++e) { const float v = x1[e] + g2[e] * y[8 * j + 4 * q + e]; y[8 * j + 4 * q + e] = v; ss += v * v; } }
    const float rstd = rsqrtf(wave_sum(ss) * (1.f / D) + RMS_EPS);
#pragma unroll
    for (int j = 0; j < 4; ++j)
#pragma unroll
        for (int q = 0; q < 2; ++q) { const int col = 512 * j + 8 * lane + 4 * q; const f32x4 g = *(const f32x4*)(fg + col);
            f32x4 o;
#pragma unroll
            for (int e = 0; e < 4; ++e) o[e] = y[8 * j + 4 * q + e] * rstd * g[e];
            *(f32x4*)(xo + col) = o; }
}
}

__global__ void __launch_bounds__(NTHR, 2) fwd_kernel(Args a) {
    extern __shared__ __attribute__((aligned(16))) unsigned char lds[];
    const int tid = threadIdx.x, lane = tid & 63, wave = __builtin_amdgcn_readfirstlane(tid >> 6);
    const int G = gridDim.x, bx = blockIdx.x, vcu = (G % 8 == 0) ? (bx % 8) * (G / 8) + bx / 8 : bx;
    unsigned char* ws = a.ws;
    const int lo = a.ph_lo, hi_ = a.ph_hi;
#if ONE_LAUNCH
    cg::grid_group grid = cg::this_grid();
#define SEAM(k) do { if (lo <= (k) && (k) + 1 < hi_) grid.sync(); } while (0)
#else
#define SEAM(k) do { } while (0)
#endif
#ifndef PHASE_MASK
#define PHASE_MASK 0x7ff
#endif
#define IN(k) ((((PHASE_MASK) >> (k)) & 1) && lo <= (k) && (k) < hi_)
    bf16_t* PARTS = (bf16_t*)(ws + WS_PARTS); bf16_t* MIX = (bf16_t*)(ws + WS_MIX);
    const float* sm = (const float*)(ws + WS_SMALL);
    if (IN(0)) { p0_prologue(a, lds, vcu, G, tid, lane, wave); SEAM(0); }
    if (IN(1)) { norm_phase<0>(a, vcu, G, lane, wave); SEAM(1); }
    if (IN(2)) {
        pg8::Gemm g{(const bf16_t*)(ws + WS_H), (const bf16_t*)(ws + WS_WIN), M1, NIN, D};
        pg8::OrderIn S{G, bx};
        pg8::EpiIn E{PARTS, sm, sm + 4096, sm + 5120};
        pg8::gemm_phase<pg8::EpiIn, pg8::OrderIn, true, true>((LAS unsigned char*)lds, g, S, E);
        SEAM(2);
    }
    if (IN(3) || IN(4)) {
        const float lam = sm[2048];
        for (int rnd = 0; rnd < 2; ++rnd) {
            if (!IN(3 + rnd)) continue;
            for (int u = vcu; u < 256; u += G) { const int bh = (u >> 5) + 8 * rnd; att::attn_unit(PARTS, MIX, a.in[I_SUBG], lam, bh >> 3, bh & 7, u & 31, (char*)lds); }
            if (rnd == 0) {
                for (int u = vcu; u < 512; u += G) { const int chain = u >> 4, j = u & 15; hg::task_trans(PARTS, (float*)(ws + WS_HST), (float*)(ws + WS_HD), chain >> 4, (chain >> 1) & 7, chain & 1, j, (char*)lds); }
            } else {
                hg::scan_phase((float*)(ws + WS_HST), (const float*)(ws + WS_HD), vcu, G, tid);
            }
            SEAM(3 + rnd);
        }
    }
    if (IN(5)) {
        for (int u = vcu; u < 256; u += G) hg::task_out(PARTS, MIX, (const float*)(ws + WS_HST), (float*)(ws + WS_OF), a.in[I_HGNG], u >> 7, (u >> 4) & 7, u & 15, (char*)lds);
        SEAM(5);
    }
    if (IN(6)) {
        pg8::Gemm g{MIX, (const bf16_t*)(ws + WS_WOUT), ML, D, D};
        pg8::StaticOrder S; S.init(ML, D, G, bx);
        pg8::EpiOut E{a.in[I_X], a.out, (const float*)(ws + WS_MOD), a.in[I_BADA]};
        pg8::gemm_phase<pg8::EpiOut, pg8::StaticOrder, true, true>((LAS unsigned char*)lds, g, S, E);
        SEAM(6);
    }
    if (IN(7)) { norm_phase<1>(a, vcu, G, lane, wave); SEAM(7); }
    if (IN(8)) {
        pg8::Gemm g{(const bf16_t*)(ws + WS_H), (const bf16_t*)(ws + WS_WQ), ML, D, D};
        pg8::StaticOrder S; S.init(ML, D, G, bx);
        pg8::EpiBf16<0> E{(bf16_t*)(ws + WS_QP), D, nullptr, 0, 0, 1.f};
        pg8::gemm_phase<pg8::EpiBf16<0>, pg8::StaticOrder, true, true>((LAS unsigned char*)lds, g, S, E);
        SEAM(8);
    }
    if (IN(9)) {
        for (int u = vcu; u < 512; u += G) tk::task((const bf16_t*)(ws + WS_QP), (const bf16_t*)(ws + WS_SMALL + 512 * 1024), (int*)(ws + WS_IDX), (float*)(ws + WS_COEF), u >> 3, u & 7, (char*)lds);
        SEAM(9);
    }
    if (IN(10)) {
        const int gw = vcu * NWAVES + wave, NGW = G * NWAVES;
        for (int t = gw; t < ML; t += NGW) pe::token_task(a, t, lane);
    }
#undef IN
#undef SEAM
}

constexpr int N_PHASES = 11;
extern "C" void kernel_launch(void* const* d_in, const int* in_sizes, int n_in, void* d_out, int out_size, void* d_ws, size_t ws_size, hipStream_t stream) {
    static int grid = 0;
    if (grid == 0) {
        if (n_in != 22 || out_size != ML * D || ws_size < WS_END) { fprintf(stderr, "kernel_launch: unexpected shapes (n_in %d out %d ws %zu, need ws >= %zu); nothing launched\n", n_in, out_size, ws_size, (size_t)WS_END); grid = -1; return; }
        int dev = 0, cus = 0, per_cu = 0;
        if (hipGetDevice(&dev) != hipSuccess || hipDeviceGetAttribute(&cus, hipDeviceAttributeMultiprocessorCount, dev) != hipSuccess) { fprintf(stderr, "kernel_launch: device query failed\n"); grid = -1; return; }
        if (hipFuncSetAttribute((const void*)fwd_kernel, hipFuncAttributeMaxDynamicSharedMemorySize, LDS_BYTES) != hipSuccess) { fprintf(stderr, "kernel_launch: hipFuncSetAttribute failed\n"); grid = -1; return; }
        if (hipOccupancyMaxActiveBlocksPerMultiprocessor(&per_cu, (const void*)fwd_kernel, NTHR, LDS_BYTES) != hipSuccess || per_cu < 1) { fprintf(stderr, "kernel_launch: occupancy query says %d blocks per CU\n", per_cu); (void)hipGetLastError(); grid = -1; return; }
        grid = cus;
        if (grid > 256) grid = 256;
    }
    if (grid < 0) return;
    (void)hipMemsetAsync((char*)d_ws + WS_CTL, 0, CTL_BYTES, stream);
    Args a{};
    for (int i = 0; i < 22; ++i) a.in[i] = (const float*)d_in[i];
    a.out = (float*)d_out; a.ws = (unsigned char*)d_ws;
#if ONE_LAUNCH
    a.ph_lo = 0; a.ph_hi = N_PHASES;
    void* args[] = {&a};
    hipError_t e = hipLaunchCooperativeKernel((const void*)fwd_kernel, dim3(grid), dim3(NTHR), args, LDS_BYTES, stream);
    if (e != hipSuccess) fprintf(stderr, "kernel_launch: cooperative launch failed: %s (grid %d)\n", hipGetErrorString(e), grid);
#else
    for (int k = 0; k < N_PHASES; ++k) { a.ph_lo = k; a.ph_hi = k + 1; hipLaunchKernelGGL(fwd_kernel, dim3(grid), dim3(NTHR), LDS_BYTES, stream, a); }
    const hipError_t le = hipPeekAtLastError();
    if (le != hipSuccess) fprintf(stderr, "kernel_launch: launch failed: %s\n", hipGetErrorName(le));
#endif
}
```

```cpp
#include <hip/hip_runtime.h>
#include <hip/hip_cooperative_groups.h>
#include <cstdio>
#include <cstdint>
namespace cg = cooperative_groups;
#ifndef ONE_LAUNCH
#define ONE_LAUNCH 1
#endif
namespace pg8 {
#define PG8_LAS __attribute__((address_space(3)))
typedef unsigned short bf16_t;
typedef short bf16x8 __attribute__((ext_vector_type(8)));
typedef float f32x4 __attribute__((ext_vector_type(4)));
typedef unsigned u32x4 __attribute__((ext_vector_type(4)));
constexpr int BM = 256, BK = 64, HALF = 128, HTB = HALF * BK * 2  , STAGE_BYTES = 8 * HTB, NXCD = 8, WGM = 8;

__host__ __device__ __forceinline__ int lds_byte(int r, int c) { const int st = (r >> 4) * 2 + (c >> 5), rr = r & 15, cc = c & 31, ob = rr * 64 + cc * 2; return st * 1024 + (ob ^ (((ob >> 9) & 1) << 5)); }
__host__ __device__ __forceinline__ void stage_rc(int b, int& R, int& C) { const int st = b / 1024, sb = b % 1024, swz = sb ^ (((sb >> 9) & 1) << 5); R = (st >> 1) * 16 + swz / 64; C = (st & 1) * 32 + (swz % 64) / 2; }
__host__ __device__ __forceinline__ int perm32(int rho) { const int n = rho >> 4, i = rho & 15; return 8 * (i >> 2) + 4 * n + (i & 3); }

struct Unit { int pm, pn; };
struct Gemm { const bf16_t* A; const bf16_t* Bt; int M, N, K; };

struct StaticOrder {
    int nM, nN, nwg, G, c;
    __host__ __device__ void init(int M, int N, int G_, int c_) { nM = M / BM; nN = N / BM; nwg = nM * nN; G = G_; c = c_; }
    __host__ __device__ bool next(int i, Unit& u) const {
        const long L = (long)i * G + c; if (L >= nwg) return false;
        int wgid = (int)L; { const int q = nwg / NXCD, r = nwg % NXCD, xcd = wgid % NXCD, off = wgid / NXCD; wgid = (xcd < r ? xcd * (q + 1) : r * (q + 1) + (xcd - r) * q) + off; }
        const int nig = WGM * nN, gid = wgid / nig, fm = gid * WGM, gsz = (nM - fm) < WGM ? (nM - fm) : WGM;
        u.pm = fm + ((wgid % nig) % gsz); u.pn = (wgid % nig) / gsz; return true;
    }
    __device__ __forceinline__ void a_ready(const Unit&) const {}
    __device__ __forceinline__ void done(const Unit&) const {}
};

__device__ __forceinline__ unsigned cvt_pk_bf16(float lo, float hi) { unsigned r; asm volatile("v_cvt_pk_bf16_f32 %0, %1, %2" : "=v"(r) : "v"(lo), "v"(hi)); return r; }
typedef float f32x2 __attribute__((ext_vector_type(2)));
__device__ __forceinline__ f32x2 gelu_pk(f32x2 v) {
    const f32x2 av = __builtin_elementwise_abs(v), d = av * 0.2316418882f + 1.0f;
    f32x2 t; t.x = __builtin_amdgcn_rcpf(d.x); t.y = __builtin_amdgcn_rcpf(d.y);
    f32x2 q = t * 0.5307027145f + (-0.7265760135f); q = q * t + 0.7107068705f; q = q * t + (-0.142248368f); q = q * t + 0.127414796f; q = q * t;
    const f32x2 s = (v * v) * (-0.72134752044f);
    f32x2 e; e.x = __builtin_amdgcn_exp2f(s.x); e.y = __builtin_amdgcn_exp2f(s.y);
    const f32x2 m = v * (q * e), r = v - m;
    f32x2 o; o.x = v.x < 0.f ? m.x : r.x; o.y = v.y < 0.f ? m.y : r.y; return o;
}

template <int ACT  > struct EpiBf16 {
    static constexpr bool PERM = true, AFTER_DRAIN = false; static_assert(ACT == 0 || ACT == 1, "EpiBf16: ACT is 0 (none) or 1 (gelu_pk)");
    bf16_t* O; int ldc; const float* bias; int split_cols; size_t split_stride; float scale0;
    __device__ __forceinline__ void operator()(const f32x4 (&acc)[2][2][4][2], const Unit& u, int wr, int wc, int fr, int fq) const {
        const int row0 = u.pm * BM + wr * 64 + fr; int colt = u.pn * BM; bf16_t* base = O;
        float sc = 1.f; if (split_cols) { const int t = colt / split_cols; base += (size_t)t * split_stride; colt -= t * split_cols; if (t == 0) sc = scale0; }
        const int col0 = colt + wc * 32 + 8 * fq, bcol0 = u.pn * BM + wc * 32 + 8 * fq;
        f32x4 bv[2][2];
#pragma unroll
        for (int bj = 0; bj < 2; ++bj)
#pragma unroll
            for (int n = 0; n < 2; ++n) bv[bj][n] = bias ? *(const f32x4*)(bias + bcol0 + bj * HALF + 4 * n) : (f32x4){0.f, 0.f, 0.f, 0.f};
#pragma unroll
        for (int ai = 0; ai < 2; ++ai)
#pragma unroll
            for (int m = 0; m < 4; ++m) { bf16_t* rowp = base + (size_t)(row0 + ai * HALF + m * 16) * ldc + col0;
#pragma unroll
                for (int bj = 0; bj < 2; ++bj) { f32x4 v0 = acc[ai][bj][m][0] + bv[bj][0], v1 = acc[ai][bj][m][1] + bv[bj][1];
                    if (ACT == 1) { f32x2 a = gelu_pk((f32x2){v0[0], v0[1]}), b = gelu_pk((f32x2){v0[2], v0[3]}), c = gelu_pk((f32x2){v1[0], v1[1]}), d = gelu_pk((f32x2){v1[2], v1[3]});
                        v0 = (f32x4){a.x, a.y, b.x, b.y}; v1 = (f32x4){c.x, c.y, d.x, d.y}; }
                    v0 = v0 * sc; v1 = v1 * sc; u32x4 w; w.x = cvt_pk_bf16(v0[0], v0[1]); w.y = cvt_pk_bf16(v0[2], v0[3]); w.z = cvt_pk_bf16(v1[0], v1[1]); w.w = cvt_pk_bf16(v1[2], v1[3]);
                    *(u32x4*)(rowp + bj * HALF) = w; } }
    }
};

struct PanelStats {
    unsigned* xbuf;
    unsigned* cnt;
    unsigned* tmo;
    int ntn; float eps;
    unsigned code;
    __device__ __forceinline__ bool run(const f32x4 (&v)[2][2][4][2], const Unit& u, int wr, int wc, int fr, int fq, PG8_LAS unsigned char* lds, int wid, int lane) const {
        typedef float f32x2v __attribute__((ext_vector_type(2)));
        PG8_LAS f32x2v* P = (PG8_LAS f32x2v*)lds;
        PG8_LAS f32x2v* S = (PG8_LAS f32x2v*)(lds + 8192);
        PG8_LAS unsigned* flag = (PG8_LAS unsigned*)(lds + 8192 + 2048);
#pragma unroll
        for (int ai = 0; ai < 2; ++ai)
#pragma unroll
            for (int m = 0; m < 4; ++m) {
                float s = 0.f;
#pragma unroll
                for (int bj = 0; bj < 2; ++bj)
#pragma unroll
                    for (int n = 0; n < 2; ++n) { const f32x4 x = v[ai][bj][m][n]; s += (x[0] + x[1]) + (x[2] + x[3]); }
                s += __shfl_xor(s, 16); s += __shfl_xor(s, 32);
                const float mw = s * (1.0f / 64.0f); float q = 0.f;
#pragma unroll
                for (int bj = 0; bj < 2; ++bj)
#pragma unroll
                    for (int n = 0; n < 2; ++n) { const f32x4 d = v[ai][bj][m][n] - mw; q += (d[0] * d[0] + d[1] * d[1]) + (d[2] * d[2] + d[3] * d[3]); }
                q += __shfl_xor(q, 16); q += __shfl_xor(q, 32);
                if (fq == 0) P[(ai * HALF + wr * 64 + m * 16 + fr) * 4 + wc] = (f32x2v){mw, q};
            }
        asm volatile("s_waitcnt lgkmcnt(0)" ::: "memory"); __builtin_amdgcn_s_barrier(); asm volatile("" ::: "memory");
#if defined(BROKEN_EXCHANGE_NO_WAIT)
#warning BROKEN CONTROL BUILD: the row-statistics exchange does not wait; results are wrong by design
        if (blockIdx.x >= 64) { const long long t0_ = clock64(); while (clock64() - t0_ < 60000) __builtin_amdgcn_s_sleep(8); }
#endif
        const int row = wid * 32 + (lane & 31);
        if (lane < 32) {
            const f32x2v a = P[row * 4 + 0], b = P[row * 4 + 1], c = P[row * 4 + 2], d = P[row * 4 + 3];
            const float mt = (a.x + b.x + c.x + d.x) * 0.25f;
            const float da = a.x - mt, db = b.x - mt, dc = c.x - mt, dd = d.x - mt;
            const float m2 = (a.y + b.y) + (c.y + d.y) + 64.0f * ((da * da + db * db) + (dc * dc + dd * dd));
            unsigned long long* slot = (unsigned long long*)xbuf + ((size_t)(u.pm * BM + row) * 4 + u.pn);
            __hip_atomic_store(slot, ((unsigned long long)__float_as_uint(m2) << 32) | __float_as_uint(mt), __ATOMIC_RELAXED, __HIP_MEMORY_SCOPE_AGENT);
        }
        asm volatile("s_waitcnt vmcnt(0)" ::: "memory");
        if (lane == 0) __hip_atomic_fetch_add(cnt + 64 * u.pm, 1u, __ATOMIC_RELAXED, __HIP_MEMORY_SCOPE_AGENT);
        if (wid == 0) {
            bool dead = false; const unsigned long long t0 = __builtin_amdgcn_s_memrealtime(); const unsigned want = 8u * (unsigned)ntn;
            for (;;) {
#if defined(BROKEN_EXCHANGE_NO_WAIT)
                break;
#endif
                if ((unsigned)__builtin_amdgcn_readfirstlane(__hip_atomic_load(cnt + 64 * u.pm, __ATOMIC_RELAXED, __HIP_MEMORY_SCOPE_AGENT)) >= want) break;
                if (__builtin_amdgcn_s_memrealtime() - t0 > 2000000ull) {
                    if (lane == 0) { unsigned expect = 0u; __hip_atomic_compare_exchange_strong(tmo + 1, &expect, code | (unsigned)(u.pm & 0xff), __ATOMIC_RELAXED, __ATOMIC_RELAXED, __HIP_MEMORY_SCOPE_AGENT);
                                     __hip_atomic_store(tmo, 1u, __ATOMIC_RELAXED, __HIP_MEMORY_SCOPE_AGENT); }
                    dead = true; break; }
                __builtin_amdgcn_s_sleep(2);
            }
            __builtin_amdgcn_fence(__ATOMIC_ACQUIRE, "agent");
            if (lane == 0) flag[0] = dead ? 1u : 0u;
        }
        asm volatile("s_waitcnt vmcnt(0) lgkmcnt(0)" ::: "memory"); __builtin_amdgcn_s_barrier(); asm volatile("" ::: "memory");
        const bool bad = flag[0] != 0u;
        if (lane < 32) {
            const unsigned long long* slot = (const unsigned long long*)xbuf + (size_t)(u.pm * BM + row) * 4; float mt[4], m2[4]; float ms = 0.f;
#pragma unroll
            for (int t = 0; t < 4; ++t) { if (t < ntn) { const unsigned long long w = __hip_atomic_load(slot + t, __ATOMIC_RELAXED, __HIP_MEMORY_SCOPE_AGENT); mt[t] = __uint_as_float((unsigned)w); m2[t] = __uint_as_float((unsigned)(w >> 32)); } else { mt[t] = 0.f; m2[t] = 0.f; } ms += mt[t]; }
            const float mean = ms / (float)ntn; float q = 0.f;
#pragma unroll
            for (int t = 0; t < 4; ++t) if (t < ntn) { const float dm = mt[t] - mean; q += m2[t] + 256.0f * dm * dm; }
            S[row] = (f32x2v){mean, 1.0f / sqrtf(q / (256.0f * (float)ntn) + eps)};
        }
        asm volatile("s_waitcnt lgkmcnt(0)" ::: "memory"); __builtin_amdgcn_s_barrier(); asm volatile("" ::: "memory");
        return bad;
    }
};
struct EpiLnRes {
    static constexpr bool PERM = false, AFTER_DRAIN = true;
    const float* base; float* out; int ldc; const float* bias; PanelStats st; unsigned poison;
    __device__ __forceinline__ void fused(f32x4 (&acc)[2][2][4][2], const Unit& u, int wr, int wc, int fr, int fq, PG8_LAS unsigned char* lds, int wid, int lane) const {
        typedef float f32x2v __attribute__((ext_vector_type(2)));
        const PG8_LAS f32x2v* S = (const PG8_LAS f32x2v*)(lds + 8192);
        const int col0 = u.pn * BM + wc * 32 + 4 * fq;
#pragma unroll
        for (int bj = 0; bj < 2; ++bj)
#pragma unroll
            for (int n = 0; n < 2; ++n) { const f32x4 bv = bias ? *(const f32x4*)(bias + col0 + bj * HALF + n * 16) : (f32x4){0.f, 0.f, 0.f, 0.f};
#pragma unroll
                for (int ai = 0; ai < 2; ++ai)
#pragma unroll
                    for (int m = 0; m < 4; ++m) acc[ai][bj][m][n] += bv; }
        f32x4 pre[4][2][2];
#pragma unroll
        for (int m = 0; m < 4; ++m) { const size_t off = (size_t)(u.pm * BM + wr * 64 + m * 16 + fr) * ldc + col0;
#pragma unroll
            for (int bj = 0; bj < 2; ++bj)
#pragma unroll
                for (int n = 0; n < 2; ++n) pre[m][bj][n] = *(const f32x4*)(base + off + bj * HALF + n * 16); }
        const bool bad = st.run(acc, u, wr, wc, fr, fq, lds, wid, lane) || poison != 0u;
        const float qnan = __builtin_nanf("");
#pragma unroll
        for (int ai = 0; ai < 2; ++ai)
#pragma unroll
            for (int m = 0; m < 4; ++m) { const int r = ai * HALF + wr * 64 + m * 16 + fr; const f32x2v sr = S[r]; const size_t off = (size_t)(u.pm * BM + r) * ldc + col0;
#pragma unroll
                for (int bj = 0; bj < 2; ++bj)
#pragma unroll
                    for (int n = 0; n < 2; ++n) { const f32x4 bs = ai == 0 ? pre[m][bj][n] : *(const f32x4*)(base + off + bj * HALF + n * 16); f32x4 o = bs + (acc[ai][bj][m][n] - sr.x) * sr.y;
                        if (bad) o = (f32x4){qnan, qnan, qnan, qnan}; *(f32x4*)(out + off + bj * HALF + n * 16) = o; }
                if (m & 1) asm volatile("" ::: "memory"); }
    }
};
struct EpiLnResLn {
    static constexpr bool PERM = false, AFTER_DRAIN = true;
    const float* base; float* out; bf16_t* xn; int ldc; const float* bias; PanelStats st1, st2; unsigned poison;
    __device__ __forceinline__ void fused(f32x4 (&acc)[2][2][4][2], const Unit& u, int wr, int wc, int fr, int fq, PG8_LAS unsigned char* lds, int wid, int lane) const {
        typedef float f32x2v __attribute__((ext_vector_type(2))); typedef unsigned u32x2v __attribute__((ext_vector_type(2)));
        const PG8_LAS f32x2v* S = (const PG8_LAS f32x2v*)(lds + 8192);
        const int col0 = u.pn * BM + wc * 32 + 4 * fq;
#pragma unroll
        for (int bj = 0; bj < 2; ++bj)
#pragma unroll
            for (int n = 0; n < 2; ++n) { const f32x4 bv = bias ? *(const f32x4*)(bias + col0 + bj * HALF + n * 16) : (f32x4){0.f, 0.f, 0.f, 0.f};
#pragma unroll
                for (int ai = 0; ai < 2; ++ai)
#pragma unroll
                    for (int m = 0; m < 4; ++m) acc[ai][bj][m][n] += bv; }
        bool bad = st1.run(acc, u, wr, wc, fr, fq, lds, wid, lane) || poison != 0u;
        const float qnan = __builtin_nanf("");
#pragma unroll
        for (int ai = 0; ai < 2; ++ai)
#pragma unroll
            for (int m = 0; m < 4; ++m) { const int r = ai * HALF + wr * 64 + m * 16 + fr; const f32x2v sr = S[r]; const size_t off = (size_t)(u.pm * BM + r) * ldc + col0;
#pragma unroll
                for (int bj = 0; bj < 2; ++bj)
#pragma unroll
                    for (int n = 0; n < 2; ++n) { const f32x4 bs = *(const f32x4*)(base + off + bj * HALF + n * 16); acc[ai][bj][m][n] = bs + (acc[ai][bj][m][n] - sr.x) * sr.y; }
                asm volatile("" : "+v"(acc[ai][0][m][0]), "+v"(acc[ai][0][m][1]), "+v"(acc[ai][1][m][0]), "+v"(acc[ai][1][m][1]));
                if (m & 1) asm volatile("" ::: "memory"); }
        const bool bad1 = bad;
        bad = st2.run(acc, u, wr, wc, fr, fq, lds, wid, lane) || bad;
#pragma unroll
        for (int ai = 0; ai < 2; ++ai)
#pragma unroll
            for (int m = 0; m < 4; ++m) { const int r = ai * HALF + wr * 64 + m * 16 + fr; const f32x2v sr = S[r]; const size_t off = (size_t)(u.pm * BM + r) * ldc + col0;
#pragma unroll
                for (int bj = 0; bj < 2; ++bj)
#pragma unroll
                    for (int n = 0; n < 2; ++n) { const f32x4 x1 = acc[ai][bj][m][n]; *(f32x4*)(out + off + bj * HALF + n * 16) = bad1 ? (f32x4){qnan, qnan, qnan, qnan} : x1;
                        const f32x4 o = (x1 - sr.x) * sr.y; u32x2v w; w.x = cvt_pk_bf16(o[0], o[1]); w.y = cvt_pk_bf16(o[2], o[3]);
                        if (bad) { w.x = 0x7fc07fc0u; w.y = 0x7fc07fc0u; } *(u32x2v*)(xn + off + bj * HALF + n * 16) = w; }
                asm volatile("" ::: "memory"); }
    }
};

template <class Epi, class Sched, bool ALIGN_EPI = false, bool SP2 = false>
__device__ __forceinline__ void gemm_phase(PG8_LAS unsigned char* lds, const Gemm g, const Sched& S, const Epi& E) {
    const int tid = threadIdx.x, wid = __builtin_amdgcn_readfirstlane(tid >> 6), lane = tid & 63, wr = wid >> 2, wc = wid & 3, fr = lane & 15, fq = lane >> 4;
    const int K = g.K, nt = K / BK;
    unsigned voffA[2], voffB[2];
#pragma unroll
    for (int i = 0; i < 2; ++i) { int R, C; stage_rc(tid * 16 + i * 8192, R, C); const int Rb = Epi::PERM ? ((R & ~31) + perm32(R & 31)) : R;
        voffA[i] = (unsigned)(R * K + C) * 2u; voffB[i] = (unsigned)(Rb * K + C) * 2u; }
    const size_t kstep = (size_t)(BK * 2);
    const size_t hstep = (size_t)HALF * K * 2;
    const size_t tstep = 2 * hstep;
    const unsigned ldsw = (unsigned)wid * 1024u;
    const int aoff = lds_byte(wr * 64 + fr, fq * 8), boff = lds_byte(wc * 32 + fr, fq * 8);
#define PG8_SA(b, h) (((b) * 2 + (h)) * HTB)
#define PG8_SB(b, h) ((4 + (b) * 2 + (h)) * HTB)
#define PG8_STAGE(bufoff, gbase, voff) do { _Pragma("unroll") for (int _i = 0; _i < 2; ++_i) \
        __builtin_amdgcn_global_load_lds((const unsigned*)((const char*)(gbase) + (voff)[_i]), (PG8_LAS unsigned*)(lds + (bufoff) + ldsw + _i * 8192), 16, 0, 0); } while (0)
#define PG8_LDA(dst, b, h) do { _Pragma("unroll") for (int m = 0; m < 4; ++m) _Pragma("unroll") for (int k = 0; k < 2; ++k) dst[m][k] = *(const PG8_LAS bf16x8*)(lds + PG8_SA(b, h) + aoff + m * 2048 + k * 1024); } while (0)
#define PG8_LDB(dst, b, h) do { _Pragma("unroll") for (int n = 0; n < 2; ++n) _Pragma("unroll") for (int k = 0; k < 2; ++k) dst[n][k] = *(const PG8_LAS bf16x8*)(lds + PG8_SB(b, h) + boff + n * 2048 + k * 1024); } while (0)
#define PG8_MMA(ai, bj, At, Bt) do { __builtin_amdgcn_s_setprio(1); _Pragma("unroll") for (int m = 0; m < 4; ++m) _Pragma("unroll") for (int n = 0; n < 2; ++n) _Pragma("unroll") for (int k = 0; k < 2; ++k) \
        acc[ai][bj][m][n] = __builtin_amdgcn_mfma_f32_16x16x32_bf16(Bt[n][k], At[m][k], acc[ai][bj][m][n], 0, 0, 0); __builtin_amdgcn_s_setprio(0); } while (0)
#define PG8_WAIT_V(n) asm volatile("s_waitcnt vmcnt(" #n ")" ::: "memory")
#define PG8_WAIT_L(n) asm volatile("s_waitcnt lgkmcnt(" #n ")" ::: "memory")
#define PG8_BAR __builtin_amdgcn_s_barrier()
#define PG8_SCHED __builtin_amdgcn_sched_barrier(0)
    Unit cur, nxt; int ui = 0;
    if (!S.next(0, cur)) return;
    f32x4 acc[2][2][4][2];
#pragma unroll
    for (int a = 0; a < 2; ++a)
#pragma unroll
        for (int b = 0; b < 2; ++b)
#pragma unroll
            for (int m = 0; m < 4; ++m)
#pragma unroll
                for (int n = 0; n < 2; ++n) acc[a][b][m][n] = (f32x4){0.f, 0.f, 0.f, 0.f};
    bf16x8 At[4][2], B0[2][2], B1[2][2];
    const char* cA = (const char*)g.A + (size_t)cur.pm * tstep; const char* cB = (const char*)g.Bt + (size_t)cur.pn * tstep;
    S.a_ready(cur);
    if constexpr (SP2) {
        PG8_STAGE(PG8_SB(0, 0), cB, voffB); PG8_STAGE(PG8_SB(0, 1), cB + hstep, voffB); PG8_STAGE(PG8_SA(0, 0), cA, voffA); PG8_STAGE(PG8_SA(0, 1), cA + hstep, voffA);
        if (wr == 1) PG8_BAR;
        PG8_WAIT_V(2); PG8_BAR;
        PG8_STAGE(PG8_SB(1, 0), cB + kstep, voffB); PG8_STAGE(PG8_SA(1, 0), cA + kstep, voffA); PG8_STAGE(PG8_SB(1, 1), cB + hstep + kstep, voffB);
        PG8_WAIT_V(6); PG8_BAR;
    } else {
        PG8_STAGE(PG8_SB(0, 0), cB, voffB); PG8_STAGE(PG8_SA(0, 0), cA, voffA); PG8_STAGE(PG8_SB(0, 1), cB + hstep, voffB); PG8_STAGE(PG8_SA(0, 1), cA + hstep, voffA);
        if (wr == 1) PG8_BAR;
        PG8_WAIT_V(4); PG8_BAR;
        PG8_STAGE(PG8_SB(1, 0), cB + kstep, voffB); PG8_STAGE(PG8_SA(1, 0), cA + kstep, voffA); PG8_STAGE(PG8_SB(1, 1), cB + hstep + kstep, voffB);
        PG8_WAIT_V(6); PG8_BAR;
    }
    for (;;) {
        const bool has_next = S.next(ui + 1, nxt);
        const char* nA = has_next ? (const char*)g.A + (size_t)nxt.pm * tstep : cA; const char* nB = has_next ? (const char*)g.Bt + (size_t)nxt.pn * tstep : cB;
        for (int t = 0; t < nt; t += 2) {
            const bool last = (t == nt - 2);
            const char* a1 = cA + (size_t)(t + 1) * kstep;
            const char* a2 = last ? nA : cA + (size_t)(t + 2) * kstep; const char* b2 = last ? nB : cB + (size_t)(t + 2) * kstep;
            const char* a3 = a2 + kstep; const char* b3 = b2 + kstep;
            if (last && has_next) S.a_ready(nxt);
            if constexpr (SP2) {
            PG8_LDB(B0, 0, 0); PG8_LDB(B1, 0, 1); PG8_SCHED; PG8_LDA(At, 0, 0); PG8_STAGE(PG8_SA(1, 1), a1 + hstep, voffA);
            PG8_WAIT_V(8); PG8_WAIT_L(0); PG8_BAR; PG8_MMA(0, 0, At, B0); PG8_MMA(0, 1, At, B1); PG8_BAR; PG8_SCHED;
            PG8_LDA(At, 0, 1); PG8_STAGE(PG8_SB(0, 0), b2, voffB); PG8_STAGE(PG8_SB(0, 1), b2 + hstep, voffB); PG8_STAGE(PG8_SA(0, 0), a2, voffA);
            PG8_WAIT_V(8); PG8_WAIT_L(0); PG8_BAR; PG8_MMA(1, 0, At, B0); PG8_MMA(1, 1, At, B1); PG8_BAR; PG8_SCHED;
            PG8_LDB(B0, 1, 0); PG8_LDB(B1, 1, 1); PG8_SCHED; PG8_LDA(At, 1, 0); PG8_STAGE(PG8_SA(0, 1), a2 + hstep, voffA);
            PG8_WAIT_V(8); PG8_WAIT_L(0); PG8_BAR; PG8_MMA(0, 0, At, B0); PG8_MMA(0, 1, At, B1); PG8_BAR; PG8_SCHED;
            PG8_LDA(At, 1, 1); PG8_STAGE(PG8_SB(1, 0), b3, voffB); PG8_STAGE(PG8_SB(1, 1), b3 + hstep, voffB); PG8_STAGE(PG8_SA(1, 0), a3, voffA);
            PG8_WAIT_V(8); PG8_WAIT_L(0); PG8_BAR; PG8_MMA(1, 0, At, B0); PG8_MMA(1, 1, At, B1); PG8_BAR; PG8_SCHED;
            } else {
            PG8_LDB(B0, 0, 0); PG8_SCHED; PG8_LDA(At, 0, 0); PG8_STAGE(PG8_SA(1, 1), a1 + hstep, voffA);
            PG8_WAIT_L(8); PG8_BAR; PG8_WAIT_L(0); PG8_MMA(0, 0, At, B0); PG8_BAR; PG8_SCHED;
            PG8_LDB(B1, 0, 1); PG8_STAGE(PG8_SB(0, 0), b2, voffB);
            PG8_BAR; PG8_WAIT_L(0); PG8_MMA(0, 1, At, B1); PG8_BAR;
            PG8_LDA(At, 0, 1); PG8_STAGE(PG8_SA(0, 0), a2, voffA);
            PG8_BAR; PG8_WAIT_L(0); PG8_MMA(1, 0, At, B0); PG8_BAR; PG8_SCHED;
            PG8_STAGE(PG8_SB(0, 1), b2 + hstep, voffB);
            PG8_WAIT_V(6); PG8_BAR; PG8_MMA(1, 1, At, B1); PG8_BAR;
            PG8_LDB(B0, 1, 0); PG8_SCHED; PG8_LDA(At, 1, 0); PG8_STAGE(PG8_SA(0, 1), a2 + hstep, voffA);
            PG8_WAIT_L(8); PG8_BAR; PG8_WAIT_L(0); PG8_MMA(0, 0, At, B0); PG8_BAR; PG8_SCHED;
            PG8_LDB(B1, 1, 1); PG8_STAGE(PG8_SB(1, 0), b3, voffB);
            PG8_BAR; PG8_WAIT_L(0); PG8_MMA(0, 1, At, B1); PG8_BAR;
            PG8_LDA(At, 1, 1); PG8_STAGE(PG8_SA(1, 0), a3, voffA);
            PG8_BAR; PG8_WAIT_L(0); PG8_MMA(1, 0, At, B0); PG8_BAR; PG8_SCHED;
            PG8_STAGE(PG8_SB(1, 1), b3 + hstep, voffB);
            PG8_WAIT_V(6); PG8_BAR; PG8_MMA(1, 1, At, B1); PG8_BAR;
            }
        }
        if constexpr (ALIGN_EPI) { if (wr == 0) PG8_BAR; }
        if constexpr (!Epi::AFTER_DRAIN) { E(acc, cur, wr, wc, fr, fq); S.done(cur); }
        if (!has_next) break;
#pragma unroll
        for (int a = 0; a < 2; ++a)
#pragma unroll
            for (int b = 0; b < 2; ++b)
#pragma unroll
                for (int m = 0; m < 4; ++m)
#pragma unroll
                    for (int n = 0; n < 2; ++n) acc[a][b][m][n] = (f32x4){0.f, 0.f, 0.f, 0.f};
        cur = nxt; cA = nA; cB = nB; ++ui;
        if constexpr (ALIGN_EPI) { if (wr == 1) PG8_BAR; }
    }
    PG8_WAIT_V(0);
    if constexpr (!ALIGN_EPI) { if (wr == 0) PG8_BAR; }
    PG8_BAR;
    if constexpr (Epi::AFTER_DRAIN) { E.fused(acc, cur, wr, wc, fr, fq, lds, wid, lane); S.done(cur); }
#undef PG8_SA
#undef PG8_SB
#undef PG8_STAGE
#undef PG8_LDA
#undef PG8_LDB
#undef PG8_MMA
#undef PG8_WAIT_V
#undef PG8_WAIT_L
#undef PG8_BAR
#undef PG8_SCHED
}
}

#define LAS __attribute__((address_space(3)))
typedef unsigned short bf16_t;
typedef short bf16x8 __attribute__((ext_vector_type(8)));
typedef short s16x4 __attribute__((ext_vector_type(4)));
typedef float f32x2 __attribute__((ext_vector_type(2)));
typedef float f32x4 __attribute__((ext_vector_type(4)));
typedef float f32x16 __attribute__((ext_vector_type(16)));
typedef unsigned u32x2 __attribute__((ext_vector_type(2)));
typedef unsigned u32x4 __attribute__((ext_vector_type(4)));
typedef int i32x4 __attribute__((ext_vector_type(4)));
typedef __bf16 bf16x2_t __attribute__((ext_vector_type(2)));

constexpr int NWAVES = 8, NTHR = 512;
constexpr int D = 2048, BATCH = 2, SEQ = 4096, CTX = 256, TPB = SEQ + CTX, M1 = BATCH * TPB, ML = BATCH * SEQ, NIN = 8192;
constexpr int C_HQ = 0, C_FF = 1024, C_FB = 2048, C_HI = 3072, C_HG = 4096, C_DQ = 5120, C_DK = 6144, C_DV = 7168;
constexpr float RMS_EPS = 1e-6f;
constexpr int NEXP = 16384, NMOD = 6 * D;
constexpr int LDS_BYTES = 155648;

constexpr size_t MiB = 1u << 20;
constexpr size_t WS_CTL = 0, CTL_BYTES = 1 * MiB;
constexpr size_t WS_MOD = 512 * 1024;
constexpr size_t WS_SMALL = 1 * MiB;
constexpr size_t WS_WIN = 2 * MiB, WS_WOUT = 34 * MiB, WS_WQ = 42 * MiB, WS_UBF = 50 * MiB, WS_VBF = 114 * MiB, WS_H = 178 * MiB, WS_PARTS = 212 * MiB,
                 WS_MIX = 348 * MiB, WS_HST = 380 * MiB, WS_HD = 412 * MiB, WS_IDX = 413 * MiB, WS_COEF = 417 * MiB, WS_OF = 421 * MiB, WS_KH = 453 * MiB, WS_VH = 471 * MiB, WS_END = 489 * MiB;
constexpr size_t WS_QP = WS_PARTS, WS_X1B = WS_PARTS + 96 * MiB;

struct Args { const float* in[22]; float* out; unsigned char* ws; int ph_lo, ph_hi; };
enum { I_X = 0, I_C, I_CTX, I_CCTX, I_WADA, I_BADA, I_N1G, I_WIN, I_HGG, I_HGNG, I_LQ1, I_LK1, I_LQ2, I_LK2, I_SUBG, I_WOUT, I_N2G, I_WQ, I_KEYS, I_PU, I_PV, I_FNG };

__device__ __forceinline__ float bf2f(unsigned short h) { return __uint_as_float((unsigned)h << 16); }
__device__ __forceinline__ unsigned pk2(float lo, float hi) { f32x2 v = {lo, hi}; bf16x2_t b = __builtin_convertvector(v, bf16x2_t); return __builtin_bit_cast(unsigned, b); }
__device__ __forceinline__ unsigned short f2bf(float f) { return (unsigned short)(pk2(f, 0.f) & 0xffffu); }
__device__ __forceinline__ float wave_sum(float v) {
#pragma unroll
    for (int o = 1; o < 64; o <<= 1) v += __shfl_xor(v, o);
    return v;
}
__device__ __forceinline__ int crow(int r, int hi) { return (r & 3) + 8 * (r >> 2) + 4 * hi; }
__device__ __forceinline__ float silu_f(float x) { return x / (1.f + __expf(-x)); }
#define SBAR() __builtin_amdgcn_sched_barrier(0)

__device__ __forceinline__ int v_st(int k, int c) { const int kk = (k & ~0xC) | ((k & 4) << 1) | ((k & 8) >> 1); return ((kk >> 3) * 4 + (c >> 5)) * 512 + ((kk & 7) * 32 + (c & 31)) * 2; }
__device__ __forceinline__ int v_rd_base(int lane) { return ((lane & 3) << 3) | (((lane >> 2) & 3) << 6) | (((lane >> 4) & 1) << 5) | (((lane >> 5) & 1) << 8); }
constexpr int v_rd_off(int d0, int ks, int half) { return d0 * 512 + ks * 4096 + half * 2048; }
template <int OFF> __device__ __forceinline__ s16x4 tr_read(int vb) {
  s16x4 r; asm volatile("ds_read_b64_tr_b16 %0, %1 offset:%2" : "=&v"(r) : "v"(vb), "i"(OFF) : "memory"); return r;
}
template <int D0> __device__ __forceinline__ void pv_one(f32x16& od, int vb, bf16x8 pa0, bf16x8 pa1, bf16x8 pa2, bf16x8 pa3) {
  const s16x4 l0 = tr_read<v_rd_off(D0, 0, 0)>(vb), h0 = tr_read<v_rd_off(D0, 0, 1)>(vb), l1 = tr_read<v_rd_off(D0, 1, 0)>(vb), h1 = tr_read<v_rd_off(D0, 1, 1)>(vb);
  const s16x4 l2 = tr_read<v_rd_off(D0, 2, 0)>(vb), h2 = tr_read<v_rd_off(D0, 2, 1)>(vb), l3 = tr_read<v_rd_off(D0, 3, 0)>(vb), h3 = tr_read<v_rd_off(D0, 3, 1)>(vb);
  asm volatile("s_waitcnt lgkmcnt(0)" ::: "memory"); SBAR();
#define PK(L, H) (bf16x8){L[0], L[1], L[2], L[3], H[0], H[1], H[2], H[3]}
  od = __builtin_amdgcn_mfma_f32_32x32x16_bf16(pa0, PK(l0, h0), od, 0, 0, 0);
  od = __builtin_amdgcn_mfma_f32_32x32x16_bf16(pa1, PK(l1, h1), od, 0, 0, 0);
  od = __builtin_amdgcn_mfma_f32_32x32x16_bf16(pa2, PK(l2, h2), od, 0, 0, 0);
  od = __builtin_amdgcn_mfma_f32_32x32x16_bf16(pa3, PK(l3, h3), od, 0, 0, 0);
#undef PK
}

__device__ __forceinline__ void p0_transpose_item(const float* W, int K, int N, bf16_t* WT, LAS float* scr, int item, int lane) {
    const int nblk = N / 32, kb = item / nblk, nb = item % nblk, k0 = 64 * kb, n0 = 32 * nb;
    float wv_[32];
#pragma unroll
    for (int i = 0; i < 32; ++i) wv_[i] = __builtin_nontemporal_load(W + (size_t)(k0 + 2 * i + (lane >> 5)) * N + n0 + (lane & 31));
#pragma unroll
    for (int i = 0; i < 32; ++i) scr[(2 * i + (lane >> 5)) * 33 + (lane & 31)] = wv_[i];
    asm volatile("s_waitcnt lgkmcnt(0)" ::: "memory");
    const int c = lane & 7;
#pragma unroll
    for (int j = 0; j < 4; ++j) { const int n = (lane >> 3) + 8 * j; const LAS float* s = scr + (8 * c) * 33 + n;
        u32x4 o; o.x = pk2(s[0 * 33], s[1 * 33]); o.y = pk2(s[2 * 33], s[3 * 33]); o.z = pk2(s[4 * 33], s[5 * 33]); o.w = pk2(s[6 * 33], s[7 * 33]);
        *(u32x4*)(WT + (size_t)(n0 + n) * K + k0 + 8 * c) = o; }
    asm volatile("s_waitcnt lgkmcnt(0)" ::: "memory");
}
__device__ __forceinline__ void cvt8(const float* src, bf16_t* dst) {
    const f32x4 a = *(const f32x4*)src, b = *(const f32x4*)(src + 4);
    u32x4 o; o.x = pk2(a.x, a.y); o.y = pk2(a.z, a.w); o.z = pk2(b.x, b.y); o.w = pk2(b.z, b.w); *(u32x4*)dst = o;
}
__device__ __forceinline__ void p0_prologue(const Args& a, unsigned char* lds, int vcu, int G, int tid, int lane, int wave) {
    unsigned char* ws = a.ws;
    LAS float* scr = (LAS float*)lds + wave * 4096;
    const int gw = vcu * NWAVES + wave, NGW = G * NWAVES;
    float* mod = (float*)(ws + WS_MOD);
    if (vcu < 192) {
        LAS float* sl = (LAS float*)lds;
        for (int i = tid; i < 3 * D; i += NTHR) { const int v = i >> 11, k = i & 2047; const float cv = v < 2 ? a.in[I_C][v * D + k] : a.in[I_CCTX][k]; sl[i] = silu_f(cv); }
        __syncthreads();
        const int rs = lane >> 4, c4 = lane & 15;
        const float* wp = a.in[I_WADA] + (size_t)(wave * 256 + rs) * NMOD + vcu * 64 + 4 * c4;
        f32x4 acc0 = {0.f, 0.f, 0.f, 0.f}, acc1 = acc0, acc2 = acc0;
#pragma unroll 8
        for (int i = 0; i < 64; ++i) { const int k = wave * 256 + 4 * i + rs; const f32x4 w = __builtin_nontemporal_load((const f32x4*)(wp + (size_t)(4 * i) * NMOD));
            acc0 += w * sl[k]; acc1 += w * sl[D + k]; acc2 += w * sl[2 * D + k]; }
        LAS float* pr = sl + 3 * D;
#pragma unroll
        for (int e = 0; e < 4; ++e) {
            float x0 = acc0[e], x1 = acc1[e], x2 = acc2[e];
            x0 += __shfl_xor(x0, 16); x0 += __shfl_xor(x0, 32); x1 += __shfl_xor(x1, 16); x1 += __shfl_xor(x1, 32); x2 += __shfl_xor(x2, 16); x2 += __shfl_xor(x2, 32);
            if (rs == 0) { pr[(wave * 3 + 0) * 64 + 4 * c4 + e] = x0; pr[(wave * 3 + 1) * 64 + 4 * c4 + e] = x1; pr[(wave * 3 + 2) * 64 + 4 * c4 + e] = x2; }
        }
        __syncthreads();
        if (tid < 192) { const int v = tid >> 6, c = tid & 63; float s = 0.f;
#pragma unroll
            for (int w = 0; w < 8; ++w) s += pr[(w * 3 + v) * 64 + c];
            __hip_atomic_store((unsigned*)mod + v * NMOD + vcu * 64 + c, __float_as_uint(s), __ATOMIC_RELAXED, __HIP_MEMORY_SCOPE_AGENT); }
        asm volatile("s_waitcnt vmcnt(0)" ::: "memory");
        __syncthreads();
        if (tid == 0) __hip_atomic_fetch_add((unsigned*)(ws + WS_CTL) + 12288, 1u, __ATOMIC_RELAXED, __HIP_MEMORY_SCOPE_AGENT);
    }
    constexpr int I_IN = (D / 64) * (NIN / 32), I_O = (D / 64) * (D / 32);
    for (int it = gw; it < I_IN + 2 * I_O; it += NGW) {
        int r = it;
        if (r < I_IN) { p0_transpose_item(a.in[I_WIN], D, NIN, (bf16_t*)(ws + WS_WIN), scr, r, lane); continue; } r -= I_IN;
        if (r < I_O) { p0_transpose_item(a.in[I_WOUT], D, D, (bf16_t*)(ws + WS_WOUT), scr, r, lane); continue; } r -= I_O;
        p0_transpose_item(a.in[I_WQ], D, D, (bf16_t*)(ws + WS_WQ), scr, r, lane);
    }
    {
        const long NK8 = 8 * 2 * 128 * 128 / 8, gt = (long)vcu * NTHR + tid, NT = (long)G * NTHR;
        for (long i = gt; i < NK8; i += NT) cvt8(a.in[I_KEYS] + i * 8, (bf16_t*)(ws + WS_SMALL + 512 * 1024) + i * 8);
    }
    if (vcu == (G > 192 ? G - 1 : 0)) {
        float* sm = (float*)(ws + WS_SMALL);
        for (int i = tid; i < 2048; i += NTHR) { const float g0 = a.in[I_HGG][i], g1 = a.in[I_HGG][2048 + i]; sm[i] = 1.f / (1.f + expf(g1 - g0)); }
        if (tid < 16) {
            const float invf = expf(-(float)tid * (1.f / 16.f) * 9.210340371976184f);
            const double w = (double)invf, w2 = w * w;
            double cs = 1.0, sn = w, tc = 1.0, tsn = w;
#pragma unroll
            for (int n = 1; n < 12; ++n) { tc = -tc * w2 * (1.0 / (double)((2 * n - 1) * (2 * n))); tsn = -tsn * w2 * (1.0 / (double)((2 * n) * (2 * n + 1))); cs += tc; sn += tsn; }
            double c = 1.0, s = 0.0;
            for (int pos = 0; pos < 64; ++pos) {
                sm[4096 + pos * 16 + tid] = (float)c; sm[5120 + pos * 16 + tid] = (float)s;
                const double c2 = c * cs - s * sn, s2 = s * cs + c * sn; c = c2; s = s2;
            }
        }
        if (tid == 64) {
            float d1 = 0.f, d2 = 0.f;
            for (int i = 0; i < 64; ++i) { d1 += a.in[I_LQ1][i] * a.in[I_LK1][i]; d2 += a.in[I_LQ2][i] * a.in[I_LK2][i]; }
            sm[2048] = expf(d1) - expf(d2) + 0.2f;
        }
    }
}

template <int WHICH> __device__ __forceinline__ void norm_phase(const Args& a, int vcu, int G, int lane, int wave) {
    const int gw = vcu * NWAVES + wave, NGW = G * NWAVES;
    const float* mod = (const float*)(a.ws + WS_MOD);
    const float* bada = a.in[I_BADA];
    const float* gain = a.in[WHICH == 0 ? I_N1G : I_N2G];
    bf16_t* H = (bf16_t*)(a.ws + WS_H);
    constexpr int NR = WHICH == 0 ? M1 : ML, CSH = WHICH == 0 ? 0 : 3 * D, CSC = WHICH == 0 ? D : 4 * D;
    for (int R = gw; R < NR; R += NGW) {
        const float* src; int v;
        if (WHICH == 0) { const int b = R / TPB, p = R % TPB; if (p < CTX) { src = a.in[I_CTX] + (size_t)(b * CTX + p) * D; v = 2; } else { src = a.in[I_X] + (size_t)(b * SEQ + p - CTX) * D; v = b; } }
        else { src = nullptr; v = R / SEQ; }
        f32x4 x[8]; float ss = 0.f;
#pragma unroll
        for (int j = 0; j < 8; ++j) {
            if (WHICH == 0) x[j] = __builtin_nontemporal_load((const f32x4*)(src + 256 * j + 4 * lane));
            else { const u32x2 w = *(const u32x2*)((const bf16_t*)(a.ws + WS_X1B) + (size_t)R * D + 256 * j + 4 * lane);
                   x[j] = (f32x4){__uint_as_float(w.x << 16), __uint_as_float(w.x & 0xffff0000u), __uint_as_float(w.y << 16), __uint_as_float(w.y & 0xffff0000u)}; }
            ss += (x[j].x * x[j].x + x[j].y * x[j].y) + (x[j].z * x[j].z + x[j].w * x[j].w); }
        const float rstd = rsqrtf(wave_sum(ss) * (1.f / D) + RMS_EPS);
#pragma unroll
        for (int j = 0; j < 8; ++j) {
            const int col = 256 * j + 4 * lane;
            const f32x4 g = *(const f32x4*)(gain + col);
            const f32x4 sh = *(const f32x4*)(mod + v * NMOD + CSH + col) + *(const f32x4*)(bada + CSH + col);
            const f32x4 sc = *(const f32x4*)(mod + v * NMOD + CSC + col) + *(const f32x4*)(bada + CSC + col);
            const f32x4 y = x[j] * rstd * g * (sc + 1.f) + sh;
            u32x2 o; o.x = pk2(y.x, y.y); o.y = pk2(y.z, y.w);
            *(u32x2*)(H + (size_t)R * D + col) = o;
        }
    }
}

#define GAS __attribute__((address_space(1)))
#ifndef SYNC_XCD
#define SYNC_XCD 1
#endif
#define XB_TMO      128
#define XB_XCNT(j)  (256  + 64 * (j))
#define XB_XSUB(j)  (1280 + 64 * (j))
#define XB_XGEN(j)  (2304 + 64 * (j))
#define XB_TOP      3328
#define XB_TOPGEN   3392
#define XCD_BAR_WORDS 3456
#define XB_SPIN_CAP (1u << 18)

__device__ __forceinline__ unsigned xb_ld(unsigned* p)              { return __hip_atomic_load(p, __ATOMIC_RELAXED, __HIP_MEMORY_SCOPE_AGENT); }
__device__ __forceinline__ unsigned xb_add(unsigned* p, unsigned v) { return __hip_atomic_fetch_add(p, v, __ATOMIC_RELAXED, __HIP_MEMORY_SCOPE_AGENT); }
__device__ __forceinline__ unsigned xb_xcc_id() { return (unsigned)__builtin_amdgcn_s_getreg((3 << 11) | 20) & 0xFu; }
#define XB_SPIN(cond, bar) do { unsigned _sp = 0; while (cond) { __builtin_amdgcn_s_sleep(1); \
    if ((++_sp & 255u) == 0u) { if (xb_ld(&(bar)[XB_TMO])) break; if (_sp > XB_SPIN_CAP) { atomicAdd(&(bar)[XB_TMO], 1u); break; } } } } while (0)

struct XcdBarrier {
    unsigned* bar; unsigned x;
    volatile LAS unsigned* st;
};

__device__ __forceinline__ XcdBarrier xcd_barrier_post(unsigned* bar, volatile LAS unsigned* st) {
    XcdBarrier b; b.bar = bar; b.x = xb_xcc_id(); b.st = st;
    if (threadIdx.x == 0) (void)xb_add(&bar[XB_XCNT(b.x)], 1u);
    return b;
}
__device__ __forceinline__ void xcd_barrier_complete(unsigned* bar, unsigned x, unsigned& nloc, unsigned& nx) {
    const unsigned G = gridDim.x * gridDim.y * gridDim.z;
    unsigned sum, cnt, mine, sp = 0u;
    for (;;) {
        sum = 0u; cnt = 0u; mine = 0u;
#pragma unroll
        for (unsigned j = 0; j < 16; ++j) { const unsigned c = xb_ld(&bar[XB_XCNT(j)]); sum += c; cnt += (c > 0u) ? 1u : 0u; mine = (j == x) ? c : mine; }
        if (sum == G) break;
        __builtin_amdgcn_s_sleep(1);
        if ((++sp & 255u) == 0u) { if (xb_ld(&bar[XB_TMO])) break; if (sp > XB_SPIN_CAP) { atomicAdd(&bar[XB_TMO], 1u); break; } }
    }
    nloc = mine > 0u ? mine : 1u; nx = cnt > 0u ? cnt : 1u;
}

__device__ __forceinline__ void xcd_barrier(const XcdBarrier& b) {
    asm volatile("s_waitcnt vmcnt(0)" ::: "memory");
    __syncthreads();
    if (threadIdx.x == 0) {
        unsigned* bar = b.bar;
        __builtin_amdgcn_s_waitcnt(0);
        unsigned nloc = b.st[0], nx = b.st[1];
        if (nloc == 0u) { xcd_barrier_complete(bar, b.x, nloc, nx); b.st[0] = nloc; b.st[1] = nx; }
        const unsigned old = xb_add(&bar[XB_XSUB(b.x)], 1u);
        const unsigned gen = old / nloc;
        if (old + 1u == (gen + 1u) * nloc) {
            __builtin_amdgcn_fence(__ATOMIC_RELEASE, "agent");
            asm volatile("s_waitcnt vmcnt(0)" ::: "memory");
            const unsigned og = xb_add(&bar[XB_TOP], 1u);
            const unsigned tg = og / nx;
            if (og + 1u == (tg + 1u) * nx) xb_add(&bar[XB_TOPGEN], 1u);
            else XB_SPIN(xb_ld(&bar[XB_TOPGEN]) == tg, bar);
            __builtin_amdgcn_fence(__ATOMIC_ACQUIRE, "agent");
            xb_add(&bar[XB_XGEN(b.x)], 1u);
            asm volatile("s_waitcnt vmcnt(0)" ::: "memory");
        } else {
            XB_SPIN(xb_ld(&bar[XB_XGEN(b.x)]) == gen, bar);
            __builtin_amdgcn_fence(__ATOMIC_ACQUIRE, "agent");
            asm volatile("s_waitcnt vmcnt(0)" ::: "memory");
        }
    }
    __syncthreads();
}

namespace pg8 {
struct OrderIn {
    int G, c;
    __device__ bool next(int i, Unit& u) const {
        const long L = (long)i * G + c; if (L >= 1064) return false;
        if (L < 1024) {
            int wgid = (int)L; wgid = (wgid & 7) * 128 + (wgid >> 3);
            const int pml = (wgid >> 8) * 8 + (wgid & 7);
            u.pm = pml < 16 ? pml + 1 : pml + 2; u.pn = (wgid & 255) >> 3;
        } else {
            const int e = (int)L - 1024, k = e % 20, g = k >> 2;
            u.pm = (e / 20) * 17; u.pn = (g < 3 ? g + 1 : g + 3) * 4 + (k & 3);
        }
        return true;
    }
    __device__ __forceinline__ void a_ready(const Unit&) const {}
    __device__ __forceinline__ void done(const Unit&) const {}
};
constexpr float QSC = 0.125f * 1.4426950408889634f;
struct EpiIn {
    static constexpr bool PERM = true, AFTER_DRAIN = false;
    bf16_t* O; const float* lb; const float* ropec; const float* ropes; bf16_t* KH; bf16_t* VH;
    __device__ __forceinline__ void operator()(const f32x4 (&acc)[2][2][4][2], const Unit& u, int wr, int wc, int fr, int fq) const {
        const int part = u.pn >> 2; const bool is_ctx = (u.pm == 0 || u.pm == 17);
        const int row0 = u.pm * BM + wr * 64 + fr, col0 = u.pn * BM + wc * 32 + 8 * fq;
        f32x4 lbv[2][2];
        if (part == 1 || part == 2) {
#pragma unroll
            for (int bj = 0; bj < 2; ++bj)
#pragma unroll
                for (int n = 0; n < 2; ++n) lbv[bj][n] = *(const f32x4*)(lb + (col0 + bj * HALF + 4 * n - 1024));
        }
        const int tb = (u.pm >= 17) ? (row0 - 4352 - 256) : (row0 - 256);
        const bool lowhalf = fq < 2;
#pragma unroll
        for (int ai = 0; ai < 2; ++ai)
#pragma unroll
            for (int m = 0; m < 4; ++m) {
                const int row = row0 + ai * HALF + m * 16;
                bf16_t* rowp = O + (size_t)row * 8192 + col0; size_t hstep = HALF;
                if (part >= 6) { const int bb = u.pm >= 17 ? 1 : 0, pos = row - bb * 4352;
                    rowp = (part == 6 ? KH : VH) + ((size_t)(bb * 8 + (u.pn & 3) * 2) * 4352 + pos) * 128 + wc * 32 + 8 * fq; hstep = (size_t)4352 * 128; }
                const bool rope = (part == 5 || part == 6) && !is_ctx;
                f32x4 cs[2], sn[2];
                if (rope) { const int t = tb + ai * HALF + m * 16; const int pos = (wc & 1) ? (t & 63) : (t >> 6);
#pragma unroll
                    for (int n = 0; n < 2; ++n) { cs[n] = *(const f32x4*)(ropec + pos * 16 + 8 * (fq & 1) + 4 * n); sn[n] = *(const f32x4*)(ropes + pos * 16 + 8 * (fq & 1) + 4 * n);
                        if (part == 5) { cs[n] *= QSC; sn[n] *= QSC; }
                        { const f32x4 c_ = cs[n], s_ = sn[n]; cs[n] = lowhalf ? c_ : s_; sn[n] = lowhalf ? -s_ : c_; } } }
#pragma unroll
                for (int bj = 0; bj < 2; ++bj) {
                    f32x4 v[2] = {acc[ai][bj][m][0], acc[ai][bj][m][1]};
                    if (part == 0 || part == 4) {
#pragma unroll
                        for (int n = 0; n < 2; ++n)
#pragma unroll
                            for (int j = 0; j < 4; j += 2) {
                                const f32x2 x2 = {v[n][j], v[n][j + 1]}; const f32x2 t2 = x2 * -1.4426950408889634f;
                                const f32x2 d2 = (f32x2){__builtin_amdgcn_exp2f(t2.x), __builtin_amdgcn_exp2f(t2.y)} + 1.f;
                                const f32x2 o2 = x2 * (f32x2){__builtin_amdgcn_rcpf(d2.x), __builtin_amdgcn_rcpf(d2.y)}; v[n][j] = o2.x; v[n][j + 1] = o2.y; }
                    } else if (part == 1 || part == 2) {
#pragma unroll
                        for (int n = 0; n < 2; ++n)
#pragma unroll
                            for (int j = 0; j < 4; j += 2) {
                                const f32x2 l2 = {lbv[bj][n][j], lbv[bj][n][j + 1]}; const f32x2 t2 = (f32x2){v[n][j], v[n][j + 1]} * -1.4426950408889634f;
                                const f32x2 d2 = (f32x2){__builtin_amdgcn_exp2f(t2.x), __builtin_amdgcn_exp2f(t2.y)} + 1.f;
                                const f32x2 w2 = (1.f - l2) * (f32x2){__builtin_amdgcn_rcpf(d2.x), __builtin_amdgcn_rcpf(d2.y)} + l2;
                                const f32x2 o2 = (f32x2){__builtin_amdgcn_logf(w2.x), __builtin_amdgcn_logf(w2.y)} * 0.6931471805599453f; v[n][j] = o2.x; v[n][j + 1] = o2.y; }
                    } else if (rope) {
#pragma unroll
                        for (int n = 0; n < 2; ++n)
#pragma unroll
                            for (int j = 0; j < 4; j += 2) {
                                auto r0 = __builtin_amdgcn_permlane32_swap(__float_as_uint(v[n][j]), __float_as_uint(v[n][j]), false, false);
                                auto r1 = __builtin_amdgcn_permlane32_swap(__float_as_uint(v[n][j + 1]), __float_as_uint(v[n][j + 1]), false, false);
                                const f32x2 t1 = {__uint_as_float(r0[0]), __uint_as_float(r1[0])}, t2 = {__uint_as_float(r0[1]), __uint_as_float(r1[1])};
                                const f32x2 o2 = t1 * (f32x2){cs[n][j], cs[n][j + 1]} + t2 * (f32x2){sn[n][j], sn[n][j + 1]}; v[n][j] = o2.x; v[n][j + 1] = o2.y;
                            }
                    }
                    u32x4 w; w.x = pk2(v[0][0], v[0][1]); w.y = pk2(v[0][2], v[0][3]); w.z = pk2(v[1][0], v[1][1]); w.w = pk2(v[1][2], v[1][3]);
                    *(u32x4*)(rowp + bj * hstep) = w;
                }
            }
    }
};
struct EpiOut {
    static constexpr bool PERM = true, AFTER_DRAIN = false;
    const float* x; bf16_t* out; const float* mod; const float* bada;
    __device__ __forceinline__ void operator()(const f32x4 (&acc)[2][2][4][2], const Unit& u, int wr, int wc, int fr, int fq) const {
        const int row0 = u.pm * BM + wr * 64 + fr, col0 = u.pn * BM + wc * 32 + 8 * fq;
        const int b = (u.pm * BM) / 4096;
        f32x4 gv[2][2];
#pragma unroll
        for (int bj = 0; bj < 2; ++bj)
#pragma unroll
            for (int n = 0; n < 2; ++n) { const int c = col0 + bj * HALF + 4 * n; gv[bj][n] = *(const f32x4*)(mod + b * 12288 + 4096 + c) + *(const f32x4*)(bada + 4096 + c); }
#pragma unroll
        for (int ai = 0; ai < 2; ++ai)
#pragma unroll
            for (int m = 0; m < 4; ++m) { const size_t off = (size_t)(row0 + ai * HALF + m * 16) * 2048 + col0;
#pragma unroll
                for (int bj = 0; bj < 2; ++bj) {
                    const f32x4 x0 = *(const f32x4*)(x + off + bj * HALF), x1 = *(const f32x4*)(x + off + bj * HALF + 4);
                    const f32x4 r0 = x0 + gv[bj][0] * acc[ai][bj][m][0], r1 = x1 + gv[bj][1] * acc[ai][bj][m][1];
                    u32x4 w; w.x = pk2(r0.x, r0.y); w.y = pk2(r0.z, r0.w); w.z = pk2(r1.x, r1.y); w.w = pk2(r1.z, r1.w);
                    *(u32x4*)(out + off + bj * HALF) = w; } }
    }
};
struct EpiOutNorm {
    static constexpr bool PERM = true, AFTER_DRAIN = true;
    const float* x; bf16_t* x1b; bf16_t* h2; const float* mod; const float* bada; const float* gain; unsigned* xs; unsigned* cnt;
    __device__ __forceinline__ void fused(f32x4 (&acc)[2][2][4][2], const Unit& u, int wr, int wc, int fr, int fq, PG8_LAS unsigned char* lds, int wid, int lane) const {
        const int row0 = u.pm * BM + wr * 64 + fr, col0 = u.pn * BM + wc * 32 + 8 * fq;
        const int b = (u.pm * BM) / 4096, tid = wid * 64 + lane;
        PG8_LAS float* P = (PG8_LAS float*)lds;
        PG8_LAS float* SR = (PG8_LAS float*)(lds + 4096);
        f32x4 gv[2][2];
#pragma unroll
        for (int bj = 0; bj < 2; ++bj)
#pragma unroll
            for (int n = 0; n < 2; ++n) { const int c = col0 + bj * HALF + 4 * n; gv[bj][n] = *(const f32x4*)(mod + b * 12288 + 4096 + c) + *(const f32x4*)(bada + 4096 + c); }
#pragma unroll
        for (int ai = 0; ai < 2; ++ai) {
            f32x4 xv[4][2][2];
#pragma unroll
            for (int m = 0; m < 4; ++m) { const size_t off = (size_t)(row0 + ai * HALF + m * 16) * 2048 + col0;
#pragma unroll
                for (int bj = 0; bj < 2; ++bj) { xv[m][bj][0] = __builtin_nontemporal_load((const f32x4*)(x + off + bj * HALF)); xv[m][bj][1] = __builtin_nontemporal_load((const f32x4*)(x + off + bj * HALF + 4)); } }
            __builtin_amdgcn_sched_barrier(0);
#pragma unroll
            for (int m = 0; m < 4; ++m) { const size_t off = (size_t)(row0 + ai * HALF + m * 16) * 2048 + col0; float ss = 0.f;
#pragma unroll
                for (int bj = 0; bj < 2; ++bj) {
                    const f32x4 x0 = xv[m][bj][0], x1 = xv[m][bj][1];
                    const f32x4 r0 = x0 + gv[bj][0] * acc[ai][bj][m][0], r1 = x1 + gv[bj][1] * acc[ai][bj][m][1];
                    acc[ai][bj][m][0] = r0; acc[ai][bj][m][1] = r1;
                    ss += ((r0.x * r0.x + r0.y * r0.y) + (r0.z * r0.z + r0.w * r0.w)) + ((r1.x * r1.x + r1.y * r1.y) + (r1.z * r1.z + r1.w * r1.w));
                    u32x4 w; w.x = pk2(r0.x, r0.y); w.y = pk2(r0.z, r0.w); w.z = pk2(r1.x, r1.y); w.w = pk2(r1.z, r1.w);
                    __builtin_nontemporal_store(w, (u32x4*)(x1b + off + bj * HALF)); }
                ss += __shfl_xor(ss, 16); ss += __shfl_xor(ss, 32);
                if (fq == 0) P[(ai * HALF + wr * 64 + m * 16 + fr) * 4 + wc] = ss; }
        }
        asm volatile("s_waitcnt lgkmcnt(0)" ::: "memory"); __builtin_amdgcn_s_barrier(); asm volatile("" ::: "memory");
        if (tid < 256) { const float s = (P[tid * 4] + P[tid * 4 + 1]) + (P[tid * 4 + 2] + P[tid * 4 + 3]);
            __hip_atomic_store(xs + (size_t)(u.pm * 256 + tid) * 8 + u.pn, __float_as_uint(s), __ATOMIC_RELAXED, __HIP_MEMORY_SCOPE_AGENT); }
        asm volatile("s_waitcnt vmcnt(0)" ::: "memory");
        __syncthreads();
        if (tid == 0) {
            __hip_atomic_fetch_add(cnt + 64 * u.pm, 1u, __ATOMIC_RELAXED, __HIP_MEMORY_SCOPE_AGENT);
            unsigned sp = 0;
            while (__hip_atomic_load(cnt + 64 * u.pm, __ATOMIC_RELAXED, __HIP_MEMORY_SCOPE_AGENT) < 8u) { __builtin_amdgcn_s_sleep(2); if (++sp > (1u << 22)) break; }
            __builtin_amdgcn_fence(__ATOMIC_ACQUIRE, "agent");
        }
        asm volatile("s_waitcnt vmcnt(0) lgkmcnt(0)" ::: "memory"); __builtin_amdgcn_s_barrier(); asm volatile("" ::: "memory");
        if (tid < 256) { float s = 0.f;
#pragma unroll
            for (int t = 0; t < 8; ++t) s += __uint_as_float(__hip_atomic_load(xs + (size_t)(u.pm * 256 + tid) * 8 + t, __ATOMIC_RELAXED, __HIP_MEMORY_SCOPE_AGENT));
            SR[tid] = rsqrtf(s * (1.f / 2048.f) + 1e-6f); }
        asm volatile("s_waitcnt lgkmcnt(0)" ::: "memory"); __builtin_amdgcn_s_barrier(); asm volatile("" ::: "memory");
        f32x4 ga[2][2], sb[2][2];
#pragma unroll
        for (int bj = 0; bj < 2; ++bj)
#pragma unroll
            for (int n = 0; n < 2; ++n) { const int c = col0 + bj * HALF + 4 * n;
                ga[bj][n] = *(const f32x4*)(gain + c) * ((*(const f32x4*)(mod + b * 12288 + 8192 + c) + *(const f32x4*)(bada + 8192 + c)) + 1.f);
                sb[bj][n] = *(const f32x4*)(mod + b * 12288 + 6144 + c) + *(const f32x4*)(bada + 6144 + c); }
#pragma unroll
        for (int ai = 0; ai < 2; ++ai)
#pragma unroll
            for (int m = 0; m < 4; ++m) { const int rl = ai * HALF + wr * 64 + m * 16 + fr; const float rs = SR[rl]; const size_t off = (size_t)(u.pm * BM + rl) * 2048 + col0;
#pragma unroll
                for (int bj = 0; bj < 2; ++bj) { const f32x4 y0 = acc[ai][bj][m][0] * rs * ga[bj][0] + sb[bj][0], y1 = acc[ai][bj][m][1] * rs * ga[bj][1] + sb[bj][1];
                    u32x4 w; w.x = pk2(y0.x, y0.y); w.y = pk2(y0.z, y0.w); w.z = pk2(y1.x, y1.y); w.w = pk2(y1.z, y1.w);
                    *(u32x4*)(h2 + off + bj * HALF) = w; } }
    }
};
struct EpiLds {
    static constexpr bool PERM = true, AFTER_DRAIN = true;
    static constexpr int PITCH = 264;
    __device__ __forceinline__ void fused(f32x4 (&acc)[2][2][4][2], const Unit&, int wr, int wc, int fr, int fq, PG8_LAS unsigned char* lds, int, int) const {
#pragma unroll
        for (int ai = 0; ai < 2; ++ai)
#pragma unroll
            for (int m = 0; m < 4; ++m) { const int rl = ai * HALF + wr * 64 + m * 16 + fr;
#pragma unroll
                for (int bj = 0; bj < 2; ++bj) { const f32x4 r0 = acc[ai][bj][m][0], r1 = acc[ai][bj][m][1];
                    u32x4 w; w.x = pk2(r0.x, r0.y); w.y = pk2(r0.z, r0.w); w.z = pk2(r1.x, r1.y); w.w = pk2(r1.z, r1.w);
                    *(PG8_LAS u32x4*)(lds + (size_t)rl * (PITCH * 2) + (bj * HALF + wc * 32 + 8 * fq) * 2) = w; } }
    }
};
}

namespace att {
constexpr int QBLK = 32, KVBLK = 64, NT = TPB / KVBLK;
constexpr float SCALE = 0.125f, THR = 8.f;
constexpr int SHM_V = 16384, SHM_K = 16384, OFF_WS = 65536, OFF_X = 67584, XROW = 132;
#define KSWZ(row, colB) ((row) * 256 + ((colB) ^ (((row) & 7) << 4)))
__device__ __forceinline__ unsigned cvtpk(float lo, float hi) { unsigned r; asm volatile("v_cvt_pk_bf16_f32 %0, %1, %2" : "=v"(r) : "v"(lo), "v"(hi)); return r; }
constexpr float THRL = THR * 1.4426950408889634f;
__device__ __forceinline__ void partialSM(f32x16& p0, f32x16& p1, float& negm, bf16x8& qxb, float& l_reg, float& alpha, bool first) {
  float pmax, pmb = fmaxf(p0[8], p0[9]), pmc = fmaxf(p1[0], p1[1]), pmd = fmaxf(p1[8], p1[9]); pmax = fmaxf(p0[0], p0[1]);
#pragma unroll
  for (int r = 2; r < 8; ++r) { pmax = fmaxf(pmax, p0[r]); pmb = fmaxf(pmb, p0[8 + r]); pmc = fmaxf(pmc, p1[r]); pmd = fmaxf(pmd, p1[8 + r]); }
  pmax = fmaxf(fmaxf(pmax, pmb), fmaxf(pmc, pmd));
  { auto rr = __builtin_amdgcn_permlane32_swap(__float_as_uint(pmax), __float_as_uint(pmax), false, false);
    pmax = fmaxf(__uint_as_float(rr[0]), __uint_as_float(rr[1])); }
  if (__builtin_expect(!first && __all(pmax <= THRL), 1)) { alpha = 1.f; }
  else {
    const float d0 = first ? pmax : fmaxf(0.f, pmax);
    const unsigned nb = cvtpk(negm - d0, 0.f) & 0xffffu; const float nn = __uint_as_float(nb << 16), d = negm - nn;
    alpha = __builtin_amdgcn_exp2f(-d); negm = nn; l_reg *= alpha; { u32x4 w = {nb, 0u, 0u, 0u}; qxb = *reinterpret_cast<bf16x8*>(&w); }
#pragma unroll
    for (int r = 0; r < 16; ++r) { float t = p0[r]; asm volatile("v_sub_f32 %0, %0, %1" : "+v"(t) : "v"(d)); p0[r] = t; }
#pragma unroll
    for (int r = 0; r < 16; ++r) { float t = p1[r]; asm volatile("v_sub_f32 %0, %0, %1" : "+v"(t) : "v"(d)); p1[r] = t; }
  }
#pragma unroll
  for (int r = 0; r < 16; ++r) p0[r] = __builtin_amdgcn_exp2f(p0[r]);
}
__device__ __forceinline__ void finishSM(f32x16& p0, f32x16& p1, float& l_reg, bf16x8& pa0, bf16x8& pa1, bf16x8& pa2, bf16x8& pa3) {
#pragma unroll
  for (int r = 0; r < 16; ++r) p1[r] = __builtin_amdgcn_exp2f(p1[r]);
  float ps = p0[0], psb = p0[8], psc = p1[0], psd = p1[8];
#pragma unroll
  for (int r = 1; r < 8; ++r) { ps += p0[r]; psb += p0[8 + r]; psc += p1[r]; psd += p1[8 + r]; }
  ps = (ps + psb) + (psc + psd);
  { auto rr = __builtin_amdgcn_permlane32_swap(__float_as_uint(ps), __float_as_uint(ps), false, false);
    ps = __uint_as_float(rr[0]) + __uint_as_float(rr[1]); }
  l_reg += ps;
#define PK4(P, BASE, OUT) do { unsigned a0 = cvtpk(P[BASE + 0], P[BASE + 1]), a1 = cvtpk(P[BASE + 2], P[BASE + 3]);   \
    unsigned b0 = cvtpk(P[BASE + 4], P[BASE + 5]), b1 = cvtpk(P[BASE + 6], P[BASE + 7]);                              \
    auto r0 = __builtin_amdgcn_permlane32_swap(a0, b0, false, false); auto r1 = __builtin_amdgcn_permlane32_swap(a1, b1, false, false); \
    u32x4 w = {r0[0], r1[0], r0[1], r1[1]}; OUT = *reinterpret_cast<bf16x8*>(&w); } while (0)
  PK4(p0, 0, pa0); PK4(p0, 8, pa1); PK4(p1, 0, pa2); PK4(p1, 8, pa3);
#undef PK4
}
__device__ __forceinline__ void qkt(f32x16& p0, f32x16& p1, const char* Ks, const bf16x8* qr, int r32, int hi, int stb, bf16x8 koneb, bf16x8 qxb) {
  p0 = __builtin_amdgcn_mfma_f32_32x32x16_bf16(koneb, qxb, f32x16{}, 0, 0, 0); p1 = p0;
#pragma unroll
  for (int d0 = 0; d0 < 4; ++d0) { int cb = stb + (d0 * 16 + hi * 8) * 2;
    bf16x8 b0 = *reinterpret_cast<const bf16x8*>(Ks + KSWZ(r32, cb));
    bf16x8 b1 = *reinterpret_cast<const bf16x8*>(Ks + KSWZ(32 + r32, cb));
    p0 = __builtin_amdgcn_mfma_f32_32x32x16_bf16(b0, qr[d0], p0, 0, 0, 0);
    p1 = __builtin_amdgcn_mfma_f32_32x32x16_bf16(b1, qr[d0], p1, 0, 0, 0); }
}
__device__ __forceinline__ void pv_d0(f32x16* o, int vb, bf16x8 pa0, bf16x8 pa1, bf16x8 pa2, bf16x8 pa3) {
  pv_one<0>(o[0], vb, pa0, pa1, pa2, pa3); pv_one<1>(o[1], vb, pa0, pa1, pa2, pa3); pv_one<2>(o[2], vb, pa0, pa1, pa2, pa3); pv_one<3>(o[3], vb, pa0, pa1, pa2, pa3);
}
struct VSet { s16x4 l0, h0, l1, h1, l2, h2, l3, h3; };
template <int J> __device__ __forceinline__ void rv(VSet& s, int vb) {
  s.l0 = tr_read<v_rd_off(0, J, 0)>(vb); s.h0 = tr_read<v_rd_off(0, J, 1)>(vb); s.l1 = tr_read<v_rd_off(1, J, 0)>(vb); s.h1 = tr_read<v_rd_off(1, J, 1)>(vb);
  s.l2 = tr_read<v_rd_off(2, J, 0)>(vb); s.h2 = tr_read<v_rd_off(2, J, 1)>(vb); s.l3 = tr_read<v_rd_off(3, J, 0)>(vb); s.h3 = tr_read<v_rd_off(3, J, 1)>(vb);
}
__device__ __forceinline__ void xstep(f32x16* o, int vb, const VSet& A, const VSet& B, bf16x8 pa0, bf16x8 pa1, bf16x8 pa2, bf16x8 pa3, f32x16& p0, f32x16& p1, const char* Ks, const bf16x8* qr, int r32, int hi, int stb, bf16x8 koneb, bf16x8 qxb) {
#define PK(L, H) (bf16x8){L[0], L[1], L[2], L[3], H[0], H[1], H[2], H[3]}
#define MF(PA, S) do { o[0] = __builtin_amdgcn_mfma_f32_32x32x16_bf16(PA, PK(S.l0, S.h0), o[0], 0, 0, 0); o[1] = __builtin_amdgcn_mfma_f32_32x32x16_bf16(PA, PK(S.l1, S.h1), o[1], 0, 0, 0); \
                       o[2] = __builtin_amdgcn_mfma_f32_32x32x16_bf16(PA, PK(S.l2, S.h2), o[2], 0, 0, 0); o[3] = __builtin_amdgcn_mfma_f32_32x32x16_bf16(PA, PK(S.l3, S.h3), o[3], 0, 0, 0); } while (0)
#define LW(n) do { asm volatile("s_waitcnt lgkmcnt(" #n ")" ::: "memory"); SBAR(); } while (0)
#define KF(d0, rowoff) (*reinterpret_cast<const bf16x8*>(Ks + KSWZ((rowoff) + r32, stb + ((d0) * 16 + hi * 8) * 2)))
  VSet C, D;
  LW(8); MF(pa0, A); SBAR();
  rv<2>(C, vb);
  LW(8); MF(pa1, B); SBAR();
  rv<3>(D, vb);
  LW(8); MF(pa2, C); SBAR();
  const bf16x8 k00 = KF(0, 0), k01 = KF(0, 32), k10 = KF(1, 0), k11 = KF(1, 32);
  LW(4); MF(pa3, D); SBAR();
  const bf16x8 k20 = KF(2, 0), k21 = KF(2, 32), k30 = KF(3, 0), k31 = KF(3, 32);
  p0 = __builtin_amdgcn_mfma_f32_32x32x16_bf16(koneb, qxb, f32x16{}, 0, 0, 0); p1 = p0;
  p0 = __builtin_amdgcn_mfma_f32_32x32x16_bf16(k00, qr[0], p0, 0, 0, 0); p1 = __builtin_amdgcn_mfma_f32_32x32x16_bf16(k01, qr[0], p1, 0, 0, 0);
  p0 = __builtin_amdgcn_mfma_f32_32x32x16_bf16(k10, qr[1], p0, 0, 0, 0); p1 = __builtin_amdgcn_mfma_f32_32x32x16_bf16(k11, qr[1], p1, 0, 0, 0);
  p0 = __builtin_amdgcn_mfma_f32_32x32x16_bf16(k20, qr[2], p0, 0, 0, 0); p1 = __builtin_amdgcn_mfma_f32_32x32x16_bf16(k21, qr[2], p1, 0, 0, 0);
  p0 = __builtin_amdgcn_mfma_f32_32x32x16_bf16(k30, qr[3], p0, 0, 0, 0); p1 = __builtin_amdgcn_mfma_f32_32x32x16_bf16(k31, qr[3], p1, 0, 0, 0);
#undef PK
#undef MF
#undef LW
#undef KF
}
__device__ __forceinline__ void attn_unit(const bf16_t* __restrict__ parts, const bf16_t* __restrict__ khp, const bf16_t* __restrict__ vhp, bf16_t* __restrict__ mix, const float* __restrict__ subg, float lam, int b, int h, int qb, char* lds) {
  const int tid = threadIdx.x, wid = tid >> 6, lane = tid & 63, r32 = lane & 31, hi = lane >> 5;
  const int st = __builtin_amdgcn_readfirstlane(wid >> 2), rb = wid & 3;
  char* V_lds = lds; char* K_lds = lds + 2 * SHM_V;
  float* ws = (float*)(lds + OFF_WS) + wid * 64; float* li_l = ws; float* al_l = ws + 32;
  float negm = 0.f, l_reg = 0; f32x16 o[4] = {}; bf16x8 qr[4];
  bf16x8 koneb, qxb; { u32x4 w = {hi == 0 ? 0x3F80u : 0u, 0u, 0u, 0u}; koneb = *reinterpret_cast<bf16x8*>(&w); u32x4 z = {0u, 0u, 0u, 0u}; qxb = *reinterpret_cast<bf16x8*>(&z); }
  const bf16_t* Kh = khp + (size_t)(b * 8 + h) * TPB * 128;
  const bf16_t* Vh = vhp + (size_t)(b * 8 + h) * TPB * 128;
  const bf16_t* Qw = parts + ((size_t)b * TPB + CTX + qb * 128 + rb * QBLK + r32) * NIN + C_DQ + h * 128 + st * 64 + hi * 8;
#pragma unroll
  for (int d0 = 0; d0 < 4; ++d0) qr[d0] = *reinterpret_cast<const bf16x8*>(Qw + d0 * 16);
  const int stb = st * 128;
  const int sr = tid >> 4, sc = (tid & 15) * 8, vst0 = v_st(sr, sc), vst1 = v_st(32 + sr, sc);
  const int vb0 = (int)(uintptr_t)V_lds + v_rd_base(lane);
  bf16x8 vs0, vs1, ks0, ks1;
#define LOADV(k0) do { vs0 = *reinterpret_cast<const bf16x8*>(&Vh[(size_t)((k0) + sr) * 128 + sc]); vs1 = *reinterpret_cast<const bf16x8*>(&Vh[(size_t)((k0) + 32 + sr) * 128 + sc]); } while (0)
#define LOADK(k0) do { ks0 = *reinterpret_cast<const bf16x8*>(&Kh[(size_t)((k0) + sr) * 128 + sc]); ks1 = *reinterpret_cast<const bf16x8*>(&Kh[(size_t)((k0) + 32 + sr) * 128 + sc]); } while (0)
#define WRITEV(bb) do { *(bf16x8*)(V_lds + (bb) * SHM_V + vst0) = vs0; *(bf16x8*)(V_lds + (bb) * SHM_V + vst1) = vs1; } while (0)
#define WRITEK(bb) do { int kc = sc * 2; *(bf16x8*)(K_lds + (bb) * SHM_K + KSWZ(sr, kc)) = ks0; *(bf16x8*)(K_lds + (bb) * SHM_K + KSWZ(32 + sr, kc)) = ks1; } while (0)
#define VMW() asm volatile("s_waitcnt vmcnt(0)" ::: "memory")
#define RESC(a) do { if (__any((a) < 1.f)) { if (hi == 0) al_l[r32] = (a); asm volatile("s_waitcnt lgkmcnt(0)" ::: "memory"); \
    _Pragma("unroll") for (int d = 0; d < 4; ++d) _Pragma("unroll") for (int r = 0; r < 16; ++r) o[d][r] *= al_l[crow(r, hi)]; } } while (0)
#define STAGE(k, VS) do { VMW(); WRITEV(1 - (VS)); WRITEK(VS);                                                                                  \
    const int tv = (k) + 2 < NT ? (k) + 2 : NT - 1, tk = (k) + 3 < NT ? (k) + 3 : NT - 1; LOADV(tv * KVBLK); LOADK(tk * KVBLK); } while (0)
#define BARR() do { SBAR(); __syncthreads(); SBAR(); } while (0)
#define PERIOD(k, VS, first) do {                                                                                                            \
    if (st == 1) STAGE(k, VS);                                                                                                               \
    { float al; partialSM(p0, p1, negm, qxb, l_reg, al, first); RESC(al); finishSM(p0, p1, l_reg, pa0, pa1, pa2, pa3); }                          \
    BARR();                                                                                                                                  \
    if (st == 0) STAGE(k, VS);                                                                                                               \
    VSet va, vb_; rv<0>(va, vb0 + (VS) * SHM_V); rv<1>(vb_, vb0 + (VS) * SHM_V); SBAR();                                                     \
    xstep(o, vb0 + (VS) * SHM_V, va, vb_, pa0, pa1, pa2, pa3, p0, p1, K_lds + (1 - (VS)) * SHM_K, qr, r32, hi, stb, koneb, qxb);    \
    BARR(); } while (0)
  f32x16 p0, p1; bf16x8 pa0, pa1, pa2, pa3;
  LOADV(0); LOADK(0); VMW(); WRITEV(0); WRITEK(0);
  LOADK(KVBLK); VMW(); WRITEK(1);
  LOADV(KVBLK); LOADK(2 * KVBLK);
  __syncthreads();
  if (st == 1) BARR();
  qkt(p0, p1, K_lds, qr, r32, hi, stb, koneb, qxb);
  BARR();
  PERIOD(0, 0, true); PERIOD(1, 1, false);
  for (int k = 2; k < NT; k += 2) { PERIOD(k, 0, false); PERIOD(k + 1, 1, false); }
  if (st == 0) BARR();
#undef PERIOD
#undef STAGE
#undef BARR
#undef LOADV
#undef LOADK
#undef WRITEV
#undef WRITEK
#undef VMW
  if (hi == 0) li_l[r32] = l_reg; asm volatile("s_waitcnt lgkmcnt(0)" ::: "memory");
  float rli[16];
#pragma unroll
  for (int r = 0; r < 16; ++r) rli[r] = __builtin_amdgcn_rcpf(li_l[crow(r, hi)]);
  float* X = (float*)(lds + OFF_X);
  if (st == 1) {
#pragma unroll
    for (int r = 0; r < 16; ++r)
#pragma unroll
      for (int d0 = 0; d0 < 4; ++d0) X[(32 * rb + crow(r, hi)) * XROW + 32 * d0 + r32] = o[d0][r] * rli[r] * lam;
  }
  __syncthreads();
  if (st == 0) {
    float ss[16];
#pragma unroll
    for (int r = 0; r < 16; ++r) { float acc = 0.f;
#pragma unroll
      for (int d0 = 0; d0 < 4; ++d0) { const float v = o[d0][r] * rli[r] - X[(32 * rb + crow(r, hi)) * XROW + 32 * d0 + r32]; o[d0][r] = v; acc += v * v; }
      ss[r] = acc; }
#pragma unroll
    for (int r = 0; r < 16; ++r) {
#pragma unroll
      for (int m = 1; m < 32; m <<= 1) ss[r] += __shfl_xor(ss[r], m); }
    float gsc[4];
#pragma unroll
    for (int d0 = 0; d0 < 4; ++d0) gsc[d0] = subg[h * 128 + 32 * d0 + r32] * 0.8f;
    bf16_t* mo = mix + ((size_t)b * SEQ + qb * 128 + rb * QBLK) * D + 1024 + h * 128 + r32;
#pragma unroll
    for (int r = 0; r < 16; ++r) { const float rs = rsqrtf(ss[r] * (1.f / 128.f) + RMS_EPS);
#pragma unroll
      for (int d0 = 0; d0 < 4; ++d0) mo[(size_t)crow(r, hi) * D + 32 * d0] = f2bf(o[d0][r] * rs * gsc[d0]); }
  }
  __syncthreads();
#undef RESC
}
}

namespace hg {
#define LBAR() do { asm volatile("s_waitcnt lgkmcnt(0)" ::: "memory"); __builtin_amdgcn_s_barrier(); asm volatile("" ::: "memory"); } while (0)
constexpr int O_V = 0, O_QR = 16384, O_KR = 33792, O_KT = 51200, O_PL = 69632, O_ST = 78848, O_TAB = 113664, O_RS = 119296;
constexpr int RQ = 272, RT = 144;

struct ChunkRaw { unsigned lf[8], q[8]; bf16x8 v0, v1; };
template <bool WITH_Q> __device__ __forceinline__ void elem_load(ChunkRaw& R, const bf16_t* __restrict__ parts, size_t r0, int h, int dir, int tid) {
    const int dkp = tid & 63, q8 = tid >> 6;
    const bf16_t* plf = parts + (r0 + 8 * q8) * NIN + (dir ? C_FB : C_FF) + h * 128 + 2 * dkp;
#pragma unroll
    for (int i = 0; i < 8; ++i) R.lf[i] = *(const unsigned*)(plf + (size_t)i * NIN);
    if (WITH_Q) { const bf16_t* pq = parts + (r0 + 8 * q8) * NIN + C_HQ + h * 128 + 2 * dkp;
#pragma unroll
        for (int i = 0; i < 8; ++i) R.q[i] = *(const unsigned*)(pq + (size_t)i * NIN); }
    const int sr = tid >> 4, scn = (tid & 15) * 8;
    R.v0 = *(const bf16x8*)(parts + (r0 + sr) * NIN + C_HI + h * 128 + scn); R.v1 = *(const bf16x8*)(parts + (r0 + 32 + sr) * NIN + C_HI + h * 128 + scn);
}
template <bool WITH_Q> __device__ __forceinline__ f32x2 elem_stage(const ChunkRaw& R, int dir, char* lds, int tid) {
    constexpr float L2E = 1.4426950408889634f;
    const int dkp = tid & 63, q8 = tid >> 6;
    f32x2 lfv[8], cum[8];
#pragma unroll
    for (int i = 0; i < 8; ++i) lfv[i] = (f32x2){__uint_as_float(R.lf[i] << 16), __uint_as_float(R.lf[i] & 0xffff0000u)};
    const int sr = tid >> 4, scn = (tid & 15) * 8;
    f32x2 run = {0.f, 0.f};
    if (dir == 0) {
#pragma unroll
        for (int i = 0; i < 8; ++i) { run += lfv[i]; cum[i] = run; }
    } else {
#pragma unroll
        for (int i = 7; i >= 0; --i) { run += lfv[i]; cum[i] = run; }
    }
    float* TAB = (float*)(lds + O_TAB);
    *(f32x2*)(TAB + q8 * 128 + 2 * dkp) = run;
    *(bf16x8*)(lds + O_V + v_st(sr, scn)) = R.v0; *(bf16x8*)(lds + O_V + v_st(32 + sr, scn)) = R.v1;
    LBAR();
    f32x2 sg[8];
#pragma unroll
    for (int j = 0; j < 8; ++j) sg[j] = *(const f32x2*)(TAB + j * 128 + 2 * dkp);
    const f32x2 lo4 = (sg[0] + sg[1]) + (sg[2] + sg[3]), hi4 = (sg[4] + sg[5]) + (sg[6] + sg[7]);
    const f32x2 total = lo4 + hi4;
    f32x2 off = {0.f, 0.f};
#pragma unroll
    for (int j = 0; j < 8; ++j) { const bool take = dir == 0 ? (j < q8) : (j > q8); if (take) off += sg[j]; }
    const f32x2 ref = dir == 0 ? lo4 : hi4;
    const f32x2 rmo = (ref - off) * L2E, omr = (off - ref) * L2E;
    unsigned kp[2][4];
#pragma unroll
    for (int i = 0; i < 8; i += 2) {
        f32x2 kk[2];
#pragma unroll
        for (int e = 0; e < 2; ++e) {
            const f32x2 a2 = lfv[i + e] * L2E, b2 = rmo - cum[i + e] * L2E;
            const f32x2 ea = {__builtin_amdgcn_exp2f(a2.x), __builtin_amdgcn_exp2f(a2.y)}, eb = {__builtin_amdgcn_exp2f(b2.x), __builtin_amdgcn_exp2f(b2.y)};
            kk[e] = (1.f - ea) * eb;
        }
        kp[0][i >> 1] = pk2(kk[0].x, kk[1].x); kp[1][i >> 1] = pk2(kk[0].y, kk[1].y);
        if (WITH_Q) {
#pragma unroll
            for (int e = 0; e < 2; ++e) { const int s = 8 * q8 + i + e;
                *(unsigned*)(lds + O_KR + s * RQ + dkp * 4) = pk2(kk[e].x, kk[e].y);
                const f32x2 c2 = cum[i + e] * L2E + omr;
                const f32x2 qv = (f32x2){__uint_as_float(R.q[i + e] << 16), __uint_as_float(R.q[i + e] & 0xffff0000u)} * (f32x2){__builtin_amdgcn_exp2f(c2.x), __builtin_amdgcn_exp2f(c2.y)};
                *(unsigned*)(lds + O_QR + s * RQ + dkp * 4) = pk2(qv.x, qv.y); }
        }
    }
    *(u32x4*)(lds + O_KT + (2 * dkp) * RT + q8 * 16) = (u32x4){kp[0][0], kp[0][1], kp[0][2], kp[0][3]};
    *(u32x4*)(lds + O_KT + (2 * dkp + 1) * RT + q8 * 16) = (u32x4){kp[1][0], kp[1][1], kp[1][2], kp[1][3]};
    if (q8 == 0) { *(f32x2*)(TAB + 1024 + 2 * dkp) = (f32x2){__expf(ref[0]), __expf(ref[1])}; *(f32x2*)(TAB + 1152 + 2 * dkp) = (f32x2){__expf(total[0]), __expf(total[1])};
                   *(f32x2*)(TAB + 1280 + 2 * dkp) = (f32x2){__expf(total[0] - ref[0]), __expf(total[1] - ref[1])}; }
    return total;
}
__device__ __forceinline__ void state_update(f32x16 (&S)[2], const char* lds, int mt, int nt0, int r32, int hi, int vb) {
    const float* TAB = (const float*)(lds + O_TAB);
    float el[16], er[16];
#pragma unroll
    for (int r = 0; r < 16; ++r) { const int d = 32 * mt + crow(r, hi); el[r] = TAB[1152 + d]; er[r] = TAB[1280 + d]; }
    bf16x8 kt[4];
#pragma unroll
    for (int ks = 0; ks < 4; ++ks) kt[ks] = *(const bf16x8*)(lds + O_KT + (32 * mt + r32) * RT + (16 * ks + 8 * hi) * 2);
#pragma unroll
    for (int t2 = 0; t2 < 2; ++t2) { f32x16 U = {}; pv_one<0>(U, vb + (nt0 + t2) * 512, kt[0], kt[1], kt[2], kt[3]);
#pragma unroll
        for (int r = 0; r < 16; ++r) S[t2][r] = el[r] * S[t2][r] + er[r] * U[r]; }
}
__device__ __forceinline__ void task_trans(const bf16_t* __restrict__ parts, float* __restrict__ hst, float* __restrict__ hd, int b, int h, int dir, int j, char* lds) {
    const int tid = threadIdx.x, wid = tid >> 6, lane = tid & 63, r32 = lane & 31, hi = lane >> 5, mt = wid >> 1, nt0 = 2 * (wid & 1);
    const int p0 = (j == 0) ? 0 : CTX + 256 * (dir == 0 ? j - 1 : 16 - j);
    const int vb = (int)(uintptr_t)(lds + O_V) + v_rd_base(lane);
    f32x16 S[2] = {}; f32x2 lsum = {0.f, 0.f};
    ChunkRaw R; elem_load<false>(R, parts, (size_t)b * TPB + p0 + 64 * (dir ? 3 : 0), h, dir, tid);
    for (int cc = 0; cc < 4; ++cc) {
        lsum += elem_stage<false>(R, dir, lds, tid);
        if (cc < 3) elem_load<false>(R, parts, (size_t)b * TPB + p0 + 64 * (dir ? 2 - cc : cc + 1), h, dir, tid);
        LBAR();
        state_update(S, lds, mt, nt0, r32, hi, vb);
        LBAR();
    }
    const int chain = (b * 8 + h) * 2 + dir;
    float* sp = hst + (size_t)(chain * 16 + j) * 16384;
#pragma unroll
    for (int t2 = 0; t2 < 2; ++t2)
#pragma unroll
        for (int r = 0; r < 16; ++r)
            __hip_atomic_store((unsigned*)&sp[(32 * mt + crow(r, hi)) * 128 + 32 * (nt0 + t2) + r32], __float_as_uint(S[t2][r]), __ATOMIC_RELAXED, __HIP_MEMORY_SCOPE_AGENT);
    if (tid < 64) { unsigned* hp = (unsigned*)(hd + (chain * 16 + j) * 128 + 2 * tid);
        __hip_atomic_store(hp, __float_as_uint(__expf(lsum[0])), __ATOMIC_RELAXED, __HIP_MEMORY_SCOPE_AGENT); __hip_atomic_store(hp + 1, __float_as_uint(__expf(lsum[1])), __ATOMIC_RELAXED, __HIP_MEMORY_SCOPE_AGENT); }
}
__device__ __forceinline__ void scan_phase(float* __restrict__ hst, const float* __restrict__ hd, int vcu, int G, int tid) {
    for (int idx = vcu * NTHR + tid; idx < 32 * 4096; idx += G * NTHR) {
        const int chain = idx >> 12, e4 = idx & 4095, dk = e4 >> 5;
        f32x4 S = {0.f, 0.f, 0.f, 0.f};
        float* p = hst + (size_t)chain * 16 * 16384 + e4 * 4;
        f32x4 u[16]; float d[16];
#pragma unroll
        for (int j = 0; j < 16; ++j) { u[j] = *(const f32x4*)(p + (size_t)j * 16384); d[j] = hd[(chain * 16 + j) * 128 + dk]; }
#pragma unroll
        for (int j = 0; j < 16; ++j) { S = S * d[j] + u[j]; *(f32x4*)(p + (size_t)j * 16384) = S; }
    }
}
__device__ __forceinline__ void task_out(const bf16_t* __restrict__ parts, bf16_t* __restrict__ mix, const float* __restrict__ hst, float* __restrict__ of, const float* __restrict__ ng,
                                         int b, int h, int sc, char* lds) {
    const int tid = threadIdx.x, wid = tid >> 6, lane = tid & 63, r32 = lane & 31, hi = lane >> 5;
    const int mt = wid >> 1, nt0 = 2 * (wid & 1), rt = wid >> 2, ct = wid & 3;
    const int vb = (int)(uintptr_t)(lds + O_V) + v_rd_base(lane);
    const float* TAB = (const float*)(lds + O_TAB);
    ChunkRaw R; elem_load<true>(R, parts, (size_t)b * TPB + CTX + 256 * sc, h, 0, tid);
    for (int dir = 0; dir < 2; ++dir) {
        const int chain = (b * 8 + h) * 2 + dir, jj = dir == 0 ? sc : 15 - sc;
        const float* sp = hst + (size_t)(chain * 16 + jj) * 16384;
        f32x16 S[2];
#pragma unroll
        for (int t2 = 0; t2 < 2; ++t2)
#pragma unroll
            for (int r = 0; r < 16; ++r) S[t2][r] = sp[(32 * mt + crow(r, hi)) * 128 + 32 * (nt0 + t2) + r32];
#pragma unroll
        for (int t2 = 0; t2 < 2; ++t2)
#pragma unroll
            for (int r = 0; r < 16; ++r) asm volatile("" : "+v"(S[t2][r]));
        for (int cc = 0; cc < 4; ++cc) {
            const int c = dir ? 3 - cc : cc;
            elem_stage<true>(R, dir, lds, tid);
            { const int step = dir * 4 + cc + 1;
              if (step < 8) { const int nd = step >> 2, nc = nd ? 3 - (step & 3) : (step & 3); elem_load<true>(R, parts, (size_t)b * TPB + CTX + 256 * sc + 64 * nc, h, nd, tid); } }
            float* ofp = of + ((((size_t)(b * 8 + h) * 16 + sc) * 4 + c) * 8 + wid) * 1024 + lane;
            LBAR();
            {
                float ef[16];
#pragma unroll
                for (int r = 0; r < 16; ++r) ef[r] = TAB[1024 + 32 * mt + crow(r, hi)];
#pragma unroll
                for (int t2 = 0; t2 < 2; ++t2)
#pragma unroll
                    for (int g = 0; g < 4; ++g) { u32x2 w; w.x = pk2(S[t2][4 * g] * ef[4 * g], S[t2][4 * g + 1] * ef[4 * g + 1]); w.y = pk2(S[t2][4 * g + 2] * ef[4 * g + 2], S[t2][4 * g + 3] * ef[4 * g + 3]);
                        *(u32x2*)(lds + O_ST + (32 * (nt0 + t2) + r32) * RQ + (32 * mt + 8 * g + 4 * hi) * 2) = w; }
            }
            if (wid < 4) {
                const int si = wid >> 1, ti = wid & 1;
                f32x16 P = {};
#pragma unroll
                for (int ks = 0; ks < 8; ++ks) {
                    const bf16x8 ka = *(const bf16x8*)(lds + O_KR + (32 * si + r32) * RQ + (16 * ks + 8 * hi) * 2);
                    const bf16x8 qb = *(const bf16x8*)(lds + O_QR + (32 * ti + r32) * RQ + (16 * ks + 8 * hi) * 2);
                    P = __builtin_amdgcn_mfma_f32_32x32x16_bf16(ka, qb, P, 0, 0, 0);
                }
                const int t = 32 * ti + r32;
#pragma unroll
                for (int g = 0; g < 4; ++g) {
                    float pv[4];
#pragma unroll
                    for (int e = 0; e < 4; ++e) { const int s = 32 * si + 8 * g + 4 * hi + e; const bool keep = dir == 0 ? (s <= t) : (s >= t); pv[e] = keep ? P[4 * g + e] : 0.f; }
                    u32x2 w; w.x = pk2(pv[0], pv[1]); w.y = pk2(pv[2], pv[3]);
                    *(u32x2*)(lds + O_PL + t * RT + (32 * si + 8 * g + 4 * hi) * 2) = w;
                }
            }
            LBAR();
            f32x16 o = {};
            {
                bf16x8 pa[4];
#pragma unroll
                for (int ks = 0; ks < 4; ++ks) pa[ks] = *(const bf16x8*)(lds + O_PL + (32 * rt + r32) * RT + (16 * ks + 8 * hi) * 2);
                pv_one<0>(o, vb + ct * 512, pa[0], pa[1], pa[2], pa[3]);
#pragma unroll
                for (int ks = 0; ks < 8; ++ks) {
                    const bf16x8 qa = *(const bf16x8*)(lds + O_QR + (32 * rt + r32) * RQ + (16 * ks + 8 * hi) * 2);
                    const bf16x8 sb = *(const bf16x8*)(lds + O_ST + (32 * ct + r32) * RQ + (16 * ks + 8 * hi) * 2);
                    o = __builtin_amdgcn_mfma_f32_32x32x16_bf16(qa, sb, o, 0, 0, 0);
                }
            }
            __builtin_amdgcn_sched_barrier(0);
            float ofv[16];
            if (dir == 1) {
#pragma unroll
                for (int r = 0; r < 16; ++r) ofv[r] = ofp[r * 64];
            }
            __builtin_amdgcn_sched_barrier(0);
            state_update(S, lds, mt, nt0, r32, hi, vb);
            if (dir == 0) {
#pragma unroll
                for (int r = 0; r < 16; ++r) ofp[r * 64] = o[r];
                LBAR();
            } else {
                float* OT = (float*)(lds + O_RS);
#pragma unroll
                for (int r = 0; r < 16; ++r) OT[(32 * rt + crow(r, hi)) * 132 + 32 * ct + r32] = o[r] + ofv[r];
                LBAR();
                const int row = tid >> 3, seg = tid & 7;
                f32x4 x[4]; float ss = 0.f;
#pragma unroll
                for (int q = 0; q < 4; ++q) { x[q] = *(const f32x4*)(OT + row * 132 + 16 * seg + 4 * q); ss += (x[q].x * x[q].x + x[q].y * x[q].y) + (x[q].z * x[q].z + x[q].w * x[q].w); }
                ss += __shfl_xor(ss, 1); ss += __shfl_xor(ss, 2); ss += __shfl_xor(ss, 4);
                const float rs = rsqrtf(ss * (1.f / 128.f) + RMS_EPS);
                const int trow = 256 * sc + 64 * c + row;
                const bf16_t* gp = parts + ((size_t)b * TPB + CTX + trow) * NIN + C_HG + h * 128 + 16 * seg;
                const u32x4 g0 = *(const u32x4*)gp, g1 = *(const u32x4*)(gp + 8);
                const float* ngp = ng + h * 128 + 16 * seg;
                const f32x4 n0 = *(const f32x4*)ngp * rs, n1 = *(const f32x4*)(ngp + 4) * rs, n2 = *(const f32x4*)(ngp + 8) * rs, n3 = *(const f32x4*)(ngp + 12) * rs;
                u32x4 w0, w1;
#define GLO(w) __uint_as_float((w) << 16)
#define GHI(w) __uint_as_float((w) & 0xffff0000u)
                w0.x = pk2(x[0].x * n0.x * GLO(g0.x), x[0].y * n0.y * GHI(g0.x)); w0.y = pk2(x[0].z * n0.z * GLO(g0.y), x[0].w * n0.w * GHI(g0.y));
                w0.z = pk2(x[1].x * n1.x * GLO(g0.z), x[1].y * n1.y * GHI(g0.z)); w0.w = pk2(x[1].z * n1.z * GLO(g0.w), x[1].w * n1.w * GHI(g0.w));
                w1.x = pk2(x[2].x * n2.x * GLO(g1.x), x[2].y * n2.y * GHI(g1.x)); w1.y = pk2(x[2].z * n2.z * GLO(g1.y), x[2].w * n2.w * GHI(g1.y));
                w1.z = pk2(x[3].x * n3.x * GLO(g1.z), x[3].y * n3.y * GHI(g1.z)); w1.w = pk2(x[3].z * n3.z * GLO(g1.w), x[3].w * n3.w * GHI(g1.w));
#undef GLO
#undef GHI
                bf16_t* mo = mix + ((size_t)(b * SEQ + trow)) * D + h * 128 + 16 * seg;
                *(u32x4*)mo = w0; *(u32x4*)(mo + 8) = w1;
            }
        }
    }
    LBAR();
}
#undef LBAR
}

namespace tk {
constexpr int LKP = 17;
__device__ __forceinline__ unsigned umax_(unsigned a, unsigned b) { return a > b ? a : b; }
__device__ __forceinline__ unsigned umin_(unsigned a, unsigned b) { return a < b ? a : b; }
__device__ __forceinline__ unsigned f2key(float s) { const unsigned b = __float_as_uint(s); return b ^ ((unsigned)((int)b >> 31) | 0x80000000u); }
__device__ __forceinline__ float key2f(unsigned k) { return __uint_as_float(k ^ (~(unsigned)((int)k >> 31) | 0x80000000u)); }
template <int N> __device__ __forceinline__ void sort_desc(unsigned (&a)[N]) {
#pragma unroll
    for (int k = 2; k <= N; k <<= 1)
#pragma unroll
        for (int j = k >> 1; j > 0; j >>= 1)
#pragma unroll
            for (int i = 0; i < N; ++i) { const int l = i ^ j; if (l > i) { const bool desc = ((i & k) == 0); const unsigned mx = umax_(a[i], a[l]), mn = umin_(a[i], a[l]); a[i] = desc ? mx : mn; a[l] = desc ? mn : mx; } }
}
__device__ __forceinline__ void merge16(unsigned (&a)[16], const unsigned (&b)[16]) {
#pragma unroll
    for (int i = 0; i < 16; ++i) a[i] = umax_(a[i], b[15 - i]);
#pragma unroll
    for (int j = 8; j > 0; j >>= 1)
#pragma unroll
        for (int i = 0; i < 16; ++i) { const int l = i ^ j; if (l > i) { const unsigned mx = umax_(a[i], a[l]), mn = umin_(a[i], a[l]); a[i] = mx; a[l] = mn; } }
}
__device__ __forceinline__ void task(const bf16_t* qbase  , int qpitch, const bf16_t* __restrict__ keys, int* __restrict__ idx, float* __restrict__ coef, int tb, int h, char* lds) {
    const int tid = threadIdx.x, wid = tid >> 6, lane = tid & 63, r32 = lane & 31, hi = lane >> 5;
    unsigned* LK = (unsigned*)lds;
    int* CT = (int*)(lds + 2 * 128 * LKP * 4);
    if (tid < 64) {
        const int cnt[16] = {16, 8, 5, 4, 3, 2, 2, 2, 1, 1, 1, 1, 1, 1, 1, 1};
        int a = 0, base = 0, found = 0, fa = 0, fb = 0;
#pragma unroll
        for (a = 0; a < 16; ++a) { const bool in = !found && tid < base + cnt[a]; fa = in ? a : fa; fb = in ? tid - base : fb; found |= in; base += cnt[a]; }
        CT[tid] = found ? (fa | (fb << 8) | 0x10000) : 0; }
    {
        const int tt = wid & 3, j = wid >> 2;
        bf16x8 qb[8];
        const bf16_t* qrow = qbase + (size_t)(32 * tt + r32) * qpitch + j * 128 + 8 * hi;
#pragma unroll
        for (int ks = 0; ks < 8; ++ks) qb[ks] = *(const bf16x8*)(qrow + 16 * ks);
        unsigned g[4][16];
        {
            bf16x8 ka[4][8];
#pragma unroll
            for (int kt = 0; kt < 4; ++kt) { const bf16_t* kp = keys + (size_t)((h * 2 + j) * 128 + 32 * kt + r32) * 128 + 8 * hi;
#pragma unroll
                for (int ks = 0; ks < 8; ++ks) ka[kt][ks] = *(const bf16x8*)(kp + 16 * ks); }
            __builtin_amdgcn_sched_barrier(0);
#pragma unroll
            for (int kt = 0; kt < 4; ++kt) {
                f32x16 acc = {};
#pragma unroll
                for (int ks = 0; ks < 8; ++ks) acc = __builtin_amdgcn_mfma_f32_32x32x16_bf16(ka[kt][ks], qb[ks], acc, 0, 0, 0);
#pragma unroll
                for (int r = 0; r < 16; ++r) g[kt][r] = (f2key(acc[r]) & ~127u) | (unsigned)(127 - 32 * kt - (r & 3) - 8 * (r >> 2) - 4 * hi);
            }
        }
#pragma unroll
        for (int kt = 0; kt < 4; ++kt) sort_desc<16>(g[kt]);
        merge16(g[0], g[1]); merge16(g[2], g[3]); merge16(g[0], g[2]);
        unsigned o[16];
#pragma unroll
        for (int i = 0; i < 16; ++i) o[i] = (unsigned)__shfl_xor((int)g[0][i], 32);
        merge16(g[0], o);
        if (hi == 0) {
#pragma unroll
            for (int i = 0; i < 16; ++i) LK[(j * 128 + 32 * tt + r32) * LKP + i] = g[0][i]; }
    }
    __syncthreads();
    {
        const int token = tid >> 2, q = tid & 3;
        const unsigned* k1 = LK + token * LKP; const unsigned* k2 = LK + (128 + token) * LKP;
        unsigned cand[16];
#pragma unroll
        for (int i = 0; i < 16; ++i) {
            const int ct = CT[16 * q + i]; const int a = ct & 255, b = (ct >> 8) & 255;
            const float v = key2f(k1[a] & ~127u) + key2f(k2[b] & ~127u);
            const unsigned ck_ = (f2key(v) & ~255u) | (unsigned)(255 - (a * 16 + b));
            cand[i] = (ct & 0x10000) ? ck_ : 0u;
        }
        sort_desc<16>(cand);
        unsigned o[16];
#pragma unroll
        for (int i = 0; i < 16; ++i) o[i] = (unsigned)__shfl_xor((int)cand[i], 1);
        merge16(cand, o);
#pragma unroll
        for (int i = 0; i < 16; ++i) o[i] = (unsigned)__shfl_xor((int)cand[i], 2);
        merge16(cand, o);
        float e[16], sum = 0.f; const float m = key2f(cand[0] & ~255u);
#pragma unroll
        for (int i = 0; i < 16; ++i) { e[i] = __expf(key2f(cand[i] & ~255u) - m); sum += e[i]; }
        const float inv = 1.f / sum;
        i32x4 oi; f32x4 oc;
#pragma unroll
        for (int kk = 0; kk < 4; ++kk) {
            const unsigned ck = q == 0 ? cand[kk] : q == 1 ? cand[4 + kk] : q == 2 ? cand[8 + kk] : cand[12 + kk];
            const float ek = q == 0 ? e[kk] : q == 1 ? e[4 + kk] : q == 2 ? e[8 + kk] : e[12 + kk];
            const int flat = 255 - (int)(ck & 255u);
            const int i1 = 127 - (int)(k1[flat >> 4] & 127u), i2 = 127 - (int)(k2[flat & 15] & 127u);
            oi[kk] = i1 * 128 + i2; oc[kk] = ek * inv;
        }
        const size_t ob = ((size_t)(tb * 128 + token) * 8 + h) * 16 + 4 * q;
        *(i32x4*)(idx + ob) = oi; *(f32x4*)(coef + ob) = oc;
    }
    __syncthreads();
}
}

namespace pe {
constexpr size_t CHB = (size_t)NEXP * 128;
static_assert(CHB == (1u << 21), "chunk stride");
constexpr size_t WS_UQ = WS_UBF, WS_VQ = WS_VBF, WS_SU = WS_SMALL + 65536, WS_SV = WS_SMALL + 131072;
__device__ __forceinline__ float gelu_erf(float v) {
    const float av = fabsf(v), t = __builtin_amdgcn_rcpf(av * 0.2316418882f + 1.0f);
    float q = t * 0.5307027145f + (-0.7265760135f); q = q * t + 0.7107068705f; q = q * t + (-0.142248368f); q = q * t + 0.127414796f; q = q * t;
    const float e = __builtin_amdgcn_exp2f((v * v) * (-0.72134752044f));
    const float m = v * (q * e);
    return v < 0.f ? m : v - m;
}
__device__ __forceinline__ float lo16(unsigned w) { return __uint_as_float(w << 16); }
__device__ __forceinline__ float hi16(unsigned w) { return __uint_as_float(w & 0xffff0000u); }
__device__ __forceinline__ void cvt_row(const float* __restrict__ src, unsigned char* __restrict__ q, float* __restrict__ scale, int row, int lane) {
    f32x4 x[8]; float am = 0.f;
#pragma unroll
    for (int j = 0; j < 8; ++j) { x[j] = __builtin_nontemporal_load((const f32x4*)(src + 256 * j + 4 * lane));        am = fmaxf(am, fmaxf(fmaxf(fabsf(x[j].x), fabsf(x[j].y)), fmaxf(fabsf(x[j].z), fabsf(x[j].w)))); }
#pragma unroll
    for (int o = 1; o < 64; o <<= 1) am = fmaxf(am, __shfl_xor(am, o));
    const float inv = am > 0.f ? 127.f / am : 0.f;
    if (lane == 0) scale[row] = am * (1.f / 127.f);
#pragma unroll
    for (int j = 0; j < 8; ++j) {
        const int q0 = (int)__builtin_rintf(x[j].x * inv), q1 = (int)__builtin_rintf(x[j].y * inv), q2 = (int)__builtin_rintf(x[j].z * inv), q3 = (int)__builtin_rintf(x[j].w * inv);
        const int w = (q0 & 255) | ((q1 & 255) << 8) | ((q2 & 255) << 16) | (int)((unsigned)q3 << 24);
        __builtin_nontemporal_store(w, (int*)(q + (size_t)(2 * j + (lane >> 5)) * CHB + (size_t)row * 128 + 4 * (lane & 31)));
    }
}
__device__ __forceinline__ void cvt_row4(const float* __restrict__ src, unsigned char* __restrict__ q, float* __restrict__ scale, int row, int lane) {
    f32x4 x[8]; float am = 0.f;
#pragma unroll
    for (int j = 0; j < 8; ++j) { x[j] = __builtin_nontemporal_load((const f32x4*)(src + 256 * j + 4 * lane));        am = fmaxf(am, fmaxf(fmaxf(fabsf(x[j].x), fabsf(x[j].y)), fmaxf(fabsf(x[j].z), fabsf(x[j].w)))); }
#pragma unroll
    for (int o = 1; o < 64; o <<= 1) am = fmaxf(am, __shfl_xor(am, o));
    const float inv = am > 0.f ? 6.f / am : 0.f;
    if (lane == 0) scale[row] = am * (1.f / 6.f);
#pragma unroll
    for (int j = 0; j < 8; ++j) {
        unsigned w = __builtin_amdgcn_cvt_scalef32_pk_fp4_f32(0u, x[j].x * inv, x[j].y * inv, 1.0f, 0);
        w = __builtin_amdgcn_cvt_scalef32_pk_fp4_f32(w, x[j].z * inv, x[j].w * inv, 1.0f, 1);
        __builtin_nontemporal_store((unsigned short)(w & 0xffffu), (unsigned short*)(q + (size_t)j * CHB + (size_t)row * 128 + 2 * lane));
    }
}
__device__ __forceinline__ void cvt_tables(const Args& a, int first, int stride, int lane) {
    for (int r = first; r < 2 * NEXP; r += stride) {
        if (r < NEXP) cvt_row(a.in[I_PU] + (size_t)r * D, a.ws + WS_UQ, (float*)(a.ws + WS_SU), r, lane);
        else cvt_row4(a.in[I_PV] + (size_t)(r - NEXP) * D, a.ws + WS_VQ, (float*)(a.ws + WS_SV), r - NEXP, lane);
    }
}
#define PE_DOT16(W, XQ, A) do { A = __builtin_amdgcn_sdot4((int)(W).x, (int)(XQ).x, A, false); A = __builtin_amdgcn_sdot4((int)(W).y, (int)(XQ).y, A, false); \
    A = __builtin_amdgcn_sdot4((int)(W).z, (int)(XQ).z, A, false); A = __builtin_amdgcn_sdot4((int)(W).w, (int)(XQ).w, A, false); } while (0)
#define PE_AX4(Wd, d, CF, Y) do { \
    Y[4 * (d) + 0] += __builtin_amdgcn_cvt_scalef32_pk_f32_fp4((Wd), 1.0f, 0) * CF; Y[4 * (d) + 1] += __builtin_amdgcn_cvt_scalef32_pk_f32_fp4((Wd), 1.0f, 1) * CF; \
    Y[4 * (d) + 2] += __builtin_amdgcn_cvt_scalef32_pk_f32_fp4((Wd), 1.0f, 2) * CF; Y[4 * (d) + 3] += __builtin_amdgcn_cvt_scalef32_pk_f32_fp4((Wd), 1.0f, 3) * CF; } while (0)
#define PE_AXPY32(W, CF, Y) do { PE_AX4((W).x, 0, CF, Y); PE_AX4((W).y, 1, CF, Y); PE_AX4((W).z, 2, CF, Y); PE_AX4((W).w, 3, CF, Y); } while (0)
#define PE_AX4I(Wd, d, CF, Y) do { \
    Y[4 * (d) + 0] = __builtin_amdgcn_cvt_scalef32_pk_f32_fp4((Wd), 1.0f, 0) * CF; Y[4 * (d) + 1] = __builtin_amdgcn_cvt_scalef32_pk_f32_fp4((Wd), 1.0f, 1) * CF; \
    Y[4 * (d) + 2] = __builtin_amdgcn_cvt_scalef32_pk_f32_fp4((Wd), 1.0f, 2) * CF; Y[4 * (d) + 3] = __builtin_amdgcn_cvt_scalef32_pk_f32_fp4((Wd), 1.0f, 3) * CF; } while (0)
#define PE_AXPY32I(W, CF, Y) do { PE_AX4I((W).x, 0, CF, Y); PE_AX4I((W).y, 1, CF, Y); PE_AX4I((W).z, 2, CF, Y); PE_AX4I((W).w, 3, CF, Y); } while (0)
__device__ __forceinline__ f32x2 shx2(f32x2 v, int m) { f32x2 r; r.x = __shfl_xor(v.x, m); r.y = __shfl_xor(v.y, m); return r; }
constexpr int TW = 4, PB = 4, PBU = 8;
__device__ __forceinline__ void wave_task(const Args& a, float* __restrict__ xbase, int t0, int lane, unsigned* __restrict__ ROW  , bf16_t* __restrict__ X2L  ) {
    const int g = lane >> 3, sub = lane & 7;
    const unsigned char* UQ = a.ws + WS_UQ; const unsigned char* VQ = a.ws + WS_VQ;
    const float* SU = (const float*)(a.ws + WS_SU); const float* SV = (const float*)(a.ws + WS_SV);
    const int* idx = (const int*)(a.ws + WS_IDX) + (size_t)t0 * 128; const float* coef = (const float*)(a.ws + WS_COEF) + (size_t)t0 * 128;
    const bf16_t* H2 = (const bf16_t*)(a.ws + WS_H) + (size_t)t0 * D;
    float acc[TW][16]; int iacc[TW][16]; u32x4 wv[PBU]; unsigned ro[PBU];
    const unsigned sub16 = 16u * sub;
#pragma unroll
    for (int tt = 0; tt < TW; ++tt) { ROW[tt * 128 + lane] = (unsigned)idx[tt * 128 + lane] * 128u; ROW[tt * 128 + 64 + lane] = (unsigned)idx[tt * 128 + 64 + lane] * 128u;
#pragma unroll
        for (int it = 0; it < 16; ++it) iacc[tt][it] = 0; }
#define ROFF(tt, e) (ROW[(tt) * 128 + 8 * (e) + g] + sub16)
    unsigned char* XQ = (unsigned char*)X2L; float sx[TW];
#pragma unroll
    for (int tt = 0; tt < TW; ++tt) {
        const bf16_t* hp = H2 + tt * D + 32 * lane; u32x4 r[4];
#pragma unroll
        for (int k = 0; k < 4; ++k) r[k] = *(const u32x4*)(hp + 8 * k);
        float v[32];
#pragma unroll
        for (int k = 0; k < 4; ++k) { v[8 * k] = lo16(r[k].x); v[8 * k + 1] = hi16(r[k].x); v[8 * k + 2] = lo16(r[k].y); v[8 * k + 3] = hi16(r[k].y); v[8 * k + 4] = lo16(r[k].z); v[8 * k + 5] = hi16(r[k].z); v[8 * k + 6] = lo16(r[k].w); v[8 * k + 7] = hi16(r[k].w); }
        float am = 0.f;
#pragma unroll
        for (int k = 0; k < 32; ++k) am = fmaxf(am, fabsf(v[k]));
#pragma unroll
        for (int o = 1; o < 64; o <<= 1) am = fmaxf(am, __shfl_xor(am, o));
        const float inv = am > 0.f ? 127.f / am : 0.f; sx[tt] = am * (1.f / 127.f);
        unsigned w[8];
#pragma unroll
        for (int k = 0; k < 8; ++k) { const int q0 = (int)__builtin_rintf(v[4 * k] * inv), q1 = (int)__builtin_rintf(v[4 * k + 1] * inv), q2 = (int)__builtin_rintf(v[4 * k + 2] * inv), q3 = (int)__builtin_rintf(v[4 * k + 3] * inv);
            w[k] = (unsigned)((q0 & 255) | ((q1 & 255) << 8) | ((q2 & 255) << 16)) | ((unsigned)q3 << 24); }
        *(u32x4*)(XQ + tt * 2048 + 32 * lane) = (u32x4){w[0], w[1], w[2], w[3]}; *(u32x4*)(XQ + tt * 2048 + 32 * lane + 16) = (u32x4){w[4], w[5], w[6], w[7]};
    }
    u32x4 wb[PBU];
#define UB_LOAD(W, tt, hb, coff) do { _Pragma("unroll") for (int i = 0; i < PBU; ++i) ro[i] = ROFF(tt, PBU * (hb) + i) + (coff);          \
        _Pragma("unroll") for (int i = 0; i < PBU; ++i) W[i] = *(const u32x4*)(UQ + (size_t)ro[i]); } while (0)
#define UB_DOT(W, tt, hb, XQV) do { _Pragma("unroll") for (int i = 0; i < PBU; ++i) PE_DOT16(W[i], XQV, iacc[tt][PBU * (hb) + i]); } while (0)
#define X_LOAD(XA, tt, c) do { XA = *(const u32x4*)(XQ + (tt) * 2048 + 128 * (c) + 16 * sub); } while (0)
#define U_TOKEN(tt, XA, XNA, ntt, nc, ncoff) do {                                                                                          \
        UB_LOAD(wb, tt, 1, coff); __builtin_amdgcn_sched_barrier(0); UB_DOT(wv, tt, 0, XA); __builtin_amdgcn_sched_barrier(0);                \
        UB_LOAD(wv, ntt, 0, ncoff); X_LOAD(XNA, ntt, nc); __builtin_amdgcn_sched_barrier(0); UB_DOT(wb, tt, 1, XA); __builtin_amdgcn_sched_barrier(0); } while (0)
    static_assert(PBU == 8 && TW == 4, "the pipelined U phase is written for 2 batches per token and 4 tokens per wave");
    { u32x4 xa0, xa1;
      UB_LOAD(wv, 0, 0, 0u); X_LOAD(xa0, 0, 0);
#pragma nounroll
      for (int c = 0; c < 16; ++c) {
        const unsigned coff = (unsigned)c << 21;
        const int cn = c < 15 ? c + 1 : 15; const unsigned coffn = (unsigned)cn << 21;
        U_TOKEN(0, xa0, xa1, 1, c, coff);
        U_TOKEN(1, xa1, xa0, 2, c, coff);
        U_TOKEN(2, xa0, xa1, 3, c, coff);
        U_TOKEN(3, xa1, xa0, 0, cn, coffn);
      } }
#undef U_TOKEN
#undef X_LOAD
#undef UB_DOT
#undef UB_LOAD
#pragma unroll
    for (int tt = 0; tt < TW; ++tt)
#pragma unroll
        for (int it = 0; it < 16; ++it) {
            int di = iacc[tt][it]; di += __shfl_xor(di, 1); di += __shfl_xor(di, 2); di += __shfl_xor(di, 4);
            const unsigned row = ROW[tt * 128 + 8 * it + g] >> 7;
            acc[tt][it] = coef[tt * 128 + 8 * it + g] * gelu_erf((float)di * (SU[row] * sx[tt])) * SV[row];
        }
    const int b = t0 / SEQ;
    const float* mod = (const float*)(a.ws + WS_MOD) + b * NMOD + 5 * D; const float* bada = a.in[I_BADA] + 5 * D; const float* fg = a.in[I_FNG];
    float* xo = xbase + (size_t)t0 * D; const bf16_t* X1 = (const bf16_t*)(a.ws + WS_X1B) + (size_t)t0 * D;
    const int cown = 32 * sub + ((lane >> 5) & 1) * 16 + ((lane >> 4) & 1) * 8 + ((lane >> 3) & 1) * 4;
    float ssq[TW];
#pragma unroll
    for (int tt = 0; tt < TW; ++tt) ssq[tt] = 0.f;
#define VB_LOAD(W, tt, hb, coff) do { _Pragma("unroll") for (int i = 0; i < PB; ++i) ro[i] = ROFF(tt, PB * (hb) + i) + (coff);             \
        _Pragma("unroll") for (int i = 0; i < PB; ++i) W[i] = *(const u32x4*)(VQ + (size_t)ro[i]); } while (0)
#define VB_AXPY(W, tt, hb) do { _Pragma("unroll") for (int i = 0; i < PB; ++i) { const float cf = acc[tt][PB * (hb) + i]; if ((hb) == 0 && i == 0) PE_AXPY32I(W[i], cf, y); else PE_AXPY32(W[i], cf, y); } } while (0)
    static_assert(PB == 4, "the pipelined V phase is written for 4 batches of 4 row pieces per token");
    VB_LOAD(wv, 0, 0, 0u);
#pragma nounroll
    for (int c = 0; c < 8; ++c) {
        const unsigned coff = (unsigned)c << 21;
        const unsigned coffn = (unsigned)(c < 7 ? c + 1 : 7) << 21;
        const int col = 256 * c + cown;
        u32x2 x1w[TW];
#pragma unroll
        for (int tt = 0; tt < TW; ++tt) x1w[tt] = *(const u32x2*)(X1 + tt * D + col);
        const f32x4 g2 = *(const f32x4*)(mod + col) + *(const f32x4*)(bada + col);
#pragma unroll
        for (int tt = 0; tt < TW; ++tt) {
            f32x2 y[16];
            VB_LOAD(wb, tt, 1, coff); __builtin_amdgcn_sched_barrier(0); VB_AXPY(wv, tt, 0); __builtin_amdgcn_sched_barrier(0);
            VB_LOAD(wv, tt, 2, coff); __builtin_amdgcn_sched_barrier(0); VB_AXPY(wb, tt, 1); __builtin_amdgcn_sched_barrier(0);
            VB_LOAD(wb, tt, 3, coff); __builtin_amdgcn_sched_barrier(0); VB_AXPY(wv, tt, 2); __builtin_amdgcn_sched_barrier(0);
            if (tt + 1 < TW) VB_LOAD(wv, tt + 1, 0, coff); else VB_LOAD(wv, 0, 0, coffn);
            __builtin_amdgcn_sched_barrier(0); VB_AXPY(wb, tt, 3); __builtin_amdgcn_sched_barrier(0);
#pragma unroll
            for (int i = 0; i < 8; ++i) {
                auto sx_ = __builtin_amdgcn_permlane32_swap(__float_as_uint(y[i].x), __float_as_uint(y[i + 8].x), false, false); auto sy_ = __builtin_amdgcn_permlane32_swap(__float_as_uint(y[i].y), __float_as_uint(y[i + 8].y), false, false);
                y[i] = (f32x2){__uint_as_float(sx_[0]), __uint_as_float(sy_[0])} + (f32x2){__uint_as_float(sx_[1]), __uint_as_float(sy_[1])}; }
#pragma unroll
            for (int i = 0; i < 4; ++i) {
                auto sx_ = __builtin_amdgcn_permlane16_swap(__float_as_uint(y[i].x), __float_as_uint(y[i + 4].x), false, false); auto sy_ = __builtin_amdgcn_permlane16_swap(__float_as_uint(y[i].y), __float_as_uint(y[i + 4].y), false, false);
                y[i] = (f32x2){__uint_as_float(sx_[0]), __uint_as_float(sy_[0])} + (f32x2){__uint_as_float(sx_[1]), __uint_as_float(sy_[1])}; }
#pragma unroll
            for (int i = 0; i < 2; ++i) { const f32x2 snd = (lane & 8) ? y[i] : y[i + 2]; const f32x2 kp = (lane & 8) ? y[i + 2] : y[i]; y[i] = kp + shx2(snd, 8); }
            const f32x4 x1 = {__uint_as_float(x1w[tt].x << 16), __uint_as_float(x1w[tt].x & 0xffff0000u), __uint_as_float(x1w[tt].y << 16), __uint_as_float(x1w[tt].y & 0xffff0000u)};
            const f32x4 v = x1 + g2 * (f32x4){y[0].x, y[0].y, y[1].x, y[1].y};
            ssq[tt] += (v.x * v.x + v.y * v.y) + (v.z * v.z + v.w * v.w);
            { u32x2 w; w.x = pk2(v.x, v.y); w.y = pk2(v.z, v.w); *(u32x2*)(X2L + tt * D + col) = w; }
        }
    }
#undef VB_AXPY
#undef VB_LOAD
    float rstd[TW];
#pragma unroll
    for (int tt = 0; tt < TW; ++tt) rstd[tt] = rsqrtf(wave_sum(ssq[tt]) * (1.f / D) + RMS_EPS);
#pragma nounroll
    for (int c = 0; c < 8; ++c) {
        const int col = 256 * c + cown; const f32x4 gg = *(const f32x4*)(fg + col);
#pragma unroll
        for (int tt = 0; tt < TW; ++tt) { const u32x2 w = *(const u32x2*)(X2L + tt * D + col);
            const f32x4 v = {__uint_as_float(w.x << 16), __uint_as_float(w.x & 0xffff0000u), __uint_as_float(w.y << 16), __uint_as_float(w.y & 0xffff0000u)};
            __builtin_nontemporal_store(v * rstd[tt] * gg, (f32x4*)(xo + tt * D + col)); }
    }
#undef ROFF
}
}

__global__ void __launch_bounds__(NTHR, 2) fwd_kernel(Args a) {
    extern __shared__ __attribute__((aligned(16))) unsigned char lds[];
    const int tid = threadIdx.x, lane = tid & 63, wave = __builtin_amdgcn_readfirstlane(tid >> 6);
    const int G = gridDim.x, bx = blockIdx.x, vcu = (G % 8 == 0) ? (bx % 8) * (G / 8) + bx / 8 : bx;
    unsigned char* ws = a.ws;
    const int lo = a.ph_lo, hi_ = a.ph_hi;
#if ONE_LAUNCH && SYNC_XCD
    volatile LAS unsigned* bst = (volatile LAS unsigned*)((LAS unsigned char*)lds + LDS_BYTES - 16);
    if (tid < 4) bst[tid] = 0u;
    __syncthreads();
    const XcdBarrier bar = xcd_barrier_post((unsigned*)(ws + WS_CTL) + 1024, bst);
#define SEAM(k) do { if (lo <= (k) && (k) + 1 < hi_) xcd_barrier(bar); } while (0)
#define SEAM_ALWAYS() xcd_barrier(bar)
#elif ONE_LAUNCH
    cg::grid_group grid = cg::this_grid();
#define SEAM(k) do { if (lo <= (k) && (k) + 1 < hi_) grid.sync(); } while (0)
#define SEAM_ALWAYS() grid.sync()
#else
#define SEAM(k) do { } while (0)
#define SEAM_ALWAYS() do { } while (0)
#endif
#ifndef PHASE_MASK
#define PHASE_MASK 0x7ff
#endif
#define IN(k) ((((PHASE_MASK) >> (k)) & 1) && lo <= (k) && (k) < hi_)
    bf16_t* PARTS = (bf16_t*)(ws + WS_PARTS); bf16_t* MIX = (bf16_t*)(ws + WS_MIX);
    const float* sm = (const float*)(ws + WS_SMALL);
#ifndef REPEAT_MASK
#define REPEAT_MASK 0
#endif
#define NREP(k) ((((REPEAT_MASK) >> (k)) & 1) ? 2 : 1)
#define RSEAM(k, rep) do { if ((rep) + 1 < NREP(k)) { SEAM_ALWAYS(); } else { SEAM(k); } } while (0)
    if (IN(0)) {
        p0_prologue(a, lds, vcu, G, tid, lane, wave);
        if (tid == 0) { unsigned* mc = (unsigned*)(ws + WS_CTL) + 12288; unsigned sp = 0;
            while (__hip_atomic_load(mc, __ATOMIC_RELAXED, __HIP_MEMORY_SCOPE_AGENT) < (G < 192 ? (unsigned)G : 192u)) { __builtin_amdgcn_s_sleep(2); if (++sp > (1u << 22)) break; }
            __builtin_amdgcn_fence(__ATOMIC_ACQUIRE, "agent"); }
        asm volatile("s_waitcnt vmcnt(0)" ::: "memory"); __syncthreads();
        norm_phase<0>(a, vcu, G, lane, wave);
        SEAM(0);
    }
    if (IN(2)) for (int rep = 0; rep < NREP(2); ++rep) {
        pg8::Gemm g{(const bf16_t*)(ws + WS_H), (const bf16_t*)(ws + WS_WIN), M1, NIN, D};
        pg8::OrderIn S{G, bx};
        pg8::EpiIn E{PARTS, sm, sm + 4096, sm + 5120, (bf16_t*)(ws + WS_KH), (bf16_t*)(ws + WS_VH)};
        pg8::gemm_phase<pg8::EpiIn, pg8::OrderIn, true, true>((LAS unsigned char*)lds, g, S, E);
        if (G == 256) { if (bx >= 40) pe::cvt_tables(a, (bx - 40) * NWAVES + wave, 216 * NWAVES, lane); }
        else pe::cvt_tables(a, bx * NWAVES + wave, G * NWAVES, lane);
        RSEAM(2, rep);
    }
#define MERGED345 (ONE_LAUNCH && ((REPEAT_MASK) & 0x38) == 0 && (PHASE_MASK) == 0x7ff)
#if MERGED345
    if (lo <= 3 && 5 < hi_) {
        unsigned* const c1 = (unsigned*)(ws + WS_CTL) + 12352; unsigned* const c2 = (unsigned*)(ws + WS_CTL) + 12416;
        const float lam = sm[2048];
        for (int u = vcu; u < 512; u += G) { const int chain = u >> 4, j = u & 15; hg::task_trans(PARTS, (float*)(ws + WS_HST), (float*)(ws + WS_HD), chain >> 4, (chain >> 1) & 7, chain & 1, j, (char*)lds); }
        asm volatile("s_waitcnt vmcnt(0)" ::: "memory"); __syncthreads();
        if (tid == 0) __hip_atomic_fetch_add(c1, 1u, __ATOMIC_RELAXED, __HIP_MEMORY_SCOPE_AGENT);
        for (int u = vcu; u < 256; u += G) { const int bh = (u >> 5); att::attn_unit(PARTS, (const bf16_t*)(ws + WS_KH), (const bf16_t*)(ws + WS_VH), MIX, a.in[I_SUBG], lam, bh >> 3, bh & 7, u & 31, (char*)lds); }
        if (tid == 0) { unsigned sp = 0;
            while (__hip_atomic_load(c1, __ATOMIC_RELAXED, __HIP_MEMORY_SCOPE_AGENT) < (unsigned)G) { __builtin_amdgcn_s_sleep(2); if (++sp > (1u << 22)) break; }
            __builtin_amdgcn_fence(__ATOMIC_ACQUIRE, "agent"); }
        asm volatile("s_waitcnt vmcnt(0) lgkmcnt(0)" ::: "memory"); __syncthreads();
        hg::scan_phase((float*)(ws + WS_HST), (const float*)(ws + WS_HD), vcu, G, tid);
        asm volatile("s_waitcnt vmcnt(0)" ::: "memory"); __syncthreads();
#if SYNC_XCD
        if (tid == 0) {
            const unsigned nloc = bst[0] ? bst[0] : 1u;
            const unsigned old = __hip_atomic_fetch_add((unsigned*)(ws + WS_CTL) + 16704 + 64 * bar.x, 1u, __ATOMIC_RELAXED, __HIP_MEMORY_SCOPE_AGENT);
            if (old + 1u == nloc) { __builtin_amdgcn_fence(__ATOMIC_RELEASE, "agent"); asm volatile("s_waitcnt vmcnt(0)" ::: "memory");
                __hip_atomic_fetch_add(c2, nloc, __ATOMIC_RELAXED, __HIP_MEMORY_SCOPE_AGENT); } }
#else
        if (tid == 0) { __builtin_amdgcn_fence(__ATOMIC_RELEASE, "agent"); asm volatile("s_waitcnt vmcnt(0)" ::: "memory");
            __hip_atomic_fetch_add(c2, 1u, __ATOMIC_RELAXED, __HIP_MEMORY_SCOPE_AGENT); }
#endif
        for (int u = vcu; u < 256; u += G) { const int bh = (u >> 5) + 8; att::attn_unit(PARTS, (const bf16_t*)(ws + WS_KH), (const bf16_t*)(ws + WS_VH), MIX, a.in[I_SUBG], lam, bh >> 3, bh & 7, u & 31, (char*)lds); }
        if (tid == 0) { unsigned sp = 0;
            while (__hip_atomic_load(c2, __ATOMIC_RELAXED, __HIP_MEMORY_SCOPE_AGENT) < (unsigned)G) { __builtin_amdgcn_s_sleep(2); if (++sp > (1u << 22)) break; }
            __builtin_amdgcn_fence(__ATOMIC_ACQUIRE, "agent"); }
        asm volatile("s_waitcnt vmcnt(0) lgkmcnt(0)" ::: "memory"); __syncthreads();
        for (int u = vcu; u < 256; u += G) hg::task_out(PARTS, MIX, (const float*)(ws + WS_HST), (float*)(ws + WS_OF), a.in[I_HGNG], u >> 7, (u >> 4) & 7, u & 15, (char*)lds);
        SEAM(5);
    }
#else
    if (IN(3)) for (int rep = 0; rep < NREP(3); ++rep) {
        { const float lam = sm[2048];
          for (int u = vcu; u < 256; u += G) { const int bh = (u >> 5); att::attn_unit(PARTS, (const bf16_t*)(ws + WS_KH), (const bf16_t*)(ws + WS_VH), MIX, a.in[I_SUBG], lam, bh >> 3, bh & 7, u & 31, (char*)lds); } }
        for (int u = vcu; u < 512; u += G) { const int chain = u >> 4, j = u & 15; hg::task_trans(PARTS, (float*)(ws + WS_HST), (float*)(ws + WS_HD), chain >> 4, (chain >> 1) & 7, chain & 1, j, (char*)lds); }
#if ONE_LAUNCH
        if (rep + 1 < NREP(3)) { SEAM_ALWAYS(); }
        else if (lo <= 3 && 4 < hi_) {
            asm volatile("s_waitcnt vmcnt(0)" ::: "memory"); __syncthreads();
            if (tid == 0) __hip_atomic_fetch_add((unsigned*)(ws + WS_CTL) + 12352, 1u, __ATOMIC_RELAXED, __HIP_MEMORY_SCOPE_AGENT);
        }
#else
        RSEAM(3, rep);
#endif
    }
    if (IN(4)) for (int rep = 0; rep < NREP(4); ++rep) {
        { const float lam = sm[2048];
          for (int u = vcu; u < 256; u += G) { const int bh = (u >> 5) + 8; att::attn_unit(PARTS, (const bf16_t*)(ws + WS_KH), (const bf16_t*)(ws + WS_VH), MIX, a.in[I_SUBG], lam, bh >> 3, bh & 7, u & 31, (char*)lds); } }
#if ONE_LAUNCH
        if (rep == 0 && lo <= 3) {
            if (tid == 0) { unsigned* tc = (unsigned*)(ws + WS_CTL) + 12352; unsigned sp = 0;
                while (__hip_atomic_load(tc, __ATOMIC_RELAXED, __HIP_MEMORY_SCOPE_AGENT) < (unsigned)G) { __builtin_amdgcn_s_sleep(2); if (++sp > (1u << 22)) break; }
                __builtin_amdgcn_fence(__ATOMIC_ACQUIRE, "agent"); }
            asm volatile("s_waitcnt vmcnt(0) lgkmcnt(0)" ::: "memory"); __syncthreads();
        }
#endif
        if (rep == 0) hg::scan_phase((float*)(ws + WS_HST), (const float*)(ws + WS_HD), vcu, G, tid);
        RSEAM(4, rep);
    }
    if (IN(5)) for (int rep = 0; rep < NREP(5); ++rep) {
        for (int u = vcu; u < 256; u += G) hg::task_out(PARTS, MIX, (const float*)(ws + WS_HST), (float*)(ws + WS_OF), a.in[I_HGNG], u >> 7, (u >> 4) & 7, u & 15, (char*)lds);
        RSEAM(5, rep);
    }
#endif
    if (IN(6)) for (int rep = 0; rep < NREP(6); ++rep) {
        pg8::Gemm g{MIX, (const bf16_t*)(ws + WS_WOUT), ML, D, D};
        pg8::StaticOrder S; S.init(ML, D, G, bx);
        if (G == 256) {
            pg8::EpiOutNorm E{a.in[I_X], (bf16_t*)(ws + WS_X1B), (bf16_t*)(ws + WS_H), (const float*)(ws + WS_MOD), a.in[I_BADA], a.in[I_N2G], (unsigned*)(ws + WS_HD + 512 * 1024), (unsigned*)(ws + WS_CTL) + 8192};
            pg8::gemm_phase<pg8::EpiOutNorm, pg8::StaticOrder, false, true>((LAS unsigned char*)lds, g, S, E);
        } else {
            pg8::EpiOut E{a.in[I_X], (bf16_t*)(ws + WS_X1B), (const float*)(ws + WS_MOD), a.in[I_BADA]};
            pg8::gemm_phase<pg8::EpiOut, pg8::StaticOrder, true, true>((LAS unsigned char*)lds, g, S, E);
        }
        RSEAM(6, rep);
    }
    if (IN(7) && G != 256) for (int rep = 0; rep < NREP(7); ++rep) { norm_phase<1>(a, vcu, G, lane, wave); RSEAM(7, rep); }
    if (IN(8)) for (int rep = 0; rep < NREP(8); ++rep) {
        pg8::Gemm g{(const bf16_t*)(ws + WS_H), (const bf16_t*)(ws + WS_WQ), ML, D, D};
        pg8::StaticOrder S; S.init(ML, D, G, bx);
        if (G == 256) {
            pg8::EpiLds E{};
            pg8::gemm_phase<pg8::EpiLds, pg8::StaticOrder, false, true>((LAS unsigned char*)lds, g, S, E);
            asm volatile("s_waitcnt lgkmcnt(0)" ::: "memory"); __syncthreads();
            pg8::Unit uu; S.next(0, uu);
            for (int hb = 0; hb < 2; ++hb)
                tk::task((const bf16_t*)lds + hb * 128 * pg8::EpiLds::PITCH, pg8::EpiLds::PITCH, (const bf16_t*)(ws + WS_SMALL + 512 * 1024), (int*)(ws + WS_IDX), (float*)(ws + WS_COEF), 2 * uu.pm + hb, uu.pn, (char*)lds + 256 * pg8::EpiLds::PITCH * 2);
        } else {
            pg8::EpiBf16<0> E{(bf16_t*)(ws + WS_QP), D, nullptr, 0, 0, 1.f};
            pg8::gemm_phase<pg8::EpiBf16<0>, pg8::StaticOrder, true, true>((LAS unsigned char*)lds, g, S, E);
            asm volatile("s_waitcnt vmcnt(0)" ::: "memory"); __syncthreads();
            pg8::Unit uu; for (int i = 0; S.next(i, uu); ++i) for (int hb = 0; hb < 2; ++hb)
                tk::task((const bf16_t*)(ws + WS_QP) + (size_t)((2 * uu.pm + hb) * 128) * D + uu.pn * 256, D, (const bf16_t*)(ws + WS_SMALL + 512 * 1024), (int*)(ws + WS_IDX), (float*)(ws + WS_COEF), 2 * uu.pm + hb, uu.pn, (char*)lds);
        }
        RSEAM(8, rep);
    }
    if (IN(10)) for (int rep = 0; rep < NREP(10); ++rep) {
        const int gw = vcu * NWAVES + wave, NGW = G * NWAVES;
        float* xb = (rep + 1 < NREP(10)) ? (float*)(ws + WS_PARTS + 32 * MiB) : a.out;
        for (int t4 = gw; t4 < ML / pe::TW; t4 += NGW) pe::wave_task(a, xb, pe::TW * t4, lane, (unsigned*)lds + wave * (pe::TW * 128), (bf16_t*)(lds + 16384) + wave * (pe::TW * D));
        if (rep + 1 < NREP(10)) SEAM_ALWAYS();
    }
#undef IN
#undef SEAM
#undef SEAM_ALWAYS
}

constexpr int N_PHASES = 11;
extern "C" void kernel_launch(void* const* d_in, const int* in_sizes, int n_in, void* d_out, int out_size, void* d_ws, size_t ws_size, hipStream_t stream) {
    static int grid = 0;
    if (grid == 0) {
        if (n_in != 22 || out_size != ML * D || ws_size < WS_END) { fprintf(stderr, "kernel_launch: unexpected shapes (n_in %d out %d ws %zu, need ws >= %zu); nothing launched\n", n_in, out_size, ws_size, (size_t)WS_END); grid = -1; return; }
        int dev = 0, cus = 0, per_cu = 0;
        if (hipGetDevice(&dev) != hipSuccess || hipDeviceGetAttribute(&cus, hipDeviceAttributeMultiprocessorCount, dev) != hipSuccess) { fprintf(stderr, "kernel_launch: device query failed\n"); grid = -1; return; }
        if (hipFuncSetAttribute((const void*)fwd_kernel, hipFuncAttributeMaxDynamicSharedMemorySize, LDS_BYTES) != hipSuccess) { fprintf(stderr, "kernel_launch: hipFuncSetAttribute failed\n"); grid = -1; return; }
        if (hipOccupancyMaxActiveBlocksPerMultiprocessor(&per_cu, (const void*)fwd_kernel, NTHR, LDS_BYTES) != hipSuccess || per_cu < 1) { fprintf(stderr, "kernel_launch: occupancy query says %d blocks per CU\n", per_cu); (void)hipGetLastError(); grid = -1; return; }
        grid = cus;
        if (grid > 256) grid = 256;
    }
    if (grid < 0) return;
    (void)hipMemsetAsync((char*)d_ws + WS_CTL, 0, CTL_BYTES, stream);
    Args a{};
    for (int i = 0; i < 22; ++i) a.in[i] = (const float*)d_in[i];
    a.out = (float*)d_out; a.ws = (unsigned char*)d_ws;
#if ONE_LAUNCH
    a.ph_lo = 0; a.ph_hi = N_PHASES;
    void* args[] = {&a};
    hipError_t e = hipLaunchCooperativeKernel((const void*)fwd_kernel, dim3(grid), dim3(NTHR), args, LDS_BYTES, stream);
    if (e != hipSuccess) fprintf(stderr, "kernel_launch: cooperative launch failed: %s (grid %d)\n", hipGetErrorString(e), grid);
#else
    for (int k = 0; k < N_PHASES; ++k) { a.ph_lo = k; a.ph_hi = k + 1; hipLaunchKernelGGL(fwd_kernel, dim3(grid), dim3(NTHR), LDS_BYTES, stream, a); }
    const hipError_t le = hipPeekAtLastError();
    if (le != hipSuccess) fprintf(stderr, "kernel_launch: launch failed: %s\n", hipGetErrorName(le));
#endif
}
```

```cpp
#include <hip/hip_runtime.h>
#include <hip/hip_cooperative_groups.h>
#include <cstdio>
#include <cstdint>
namespace cg = cooperative_groups;
#ifndef ONE_LAUNCH
#define ONE_LAUNCH 1
#endif
namespace pg8 {
#define PG8_LAS __attribute__((address_space(3)))
typedef unsigned short bf16_t;
typedef short bf16x8 __attribute__((ext_vector_type(8)));
typedef float f32x4 __attribute__((ext_vector_type(4)));
typedef unsigned u32x4 __attribute__((ext_vector_type(4)));
constexpr int BM = 256, BK = 64, HALF = 128, HTB = HALF * BK * 2  , STAGE_BYTES = 8 * HTB, NXCD = 8, WGM = 8;

__host__ __device__ __forceinline__ int lds_byte(int r, int c) { const int st = (r >> 4) * 2 + (c >> 5), rr = r & 15, cc = c & 31, ob = rr * 64 + cc * 2; return st * 1024 + (ob ^ (((ob >> 9) & 1) << 5)); }
__host__ __device__ __forceinline__ void stage_rc(int b, int& R, int& C) { const int st = b / 1024, sb = b % 1024, swz = sb ^ (((sb >> 9) & 1) << 5); R = (st >> 1) * 16 + swz / 64; C = (st & 1) * 32 + (swz % 64) / 2; }
__host__ __device__ __forceinline__ int perm32(int rho) { const int n = rho >> 4, i = rho & 15; return 8 * (i >> 2) + 4 * n + (i & 3); }

struct Unit { int pm, pn; };
struct Gemm { const bf16_t* A; const bf16_t* Bt; int M, N, K; };

struct StaticOrder {
    int nM, nN, nwg, G, c;
    __host__ __device__ void init(int M, int N, int G_, int c_) { nM = M / BM; nN = N / BM; nwg = nM * nN; G = G_; c = c_; }
    __host__ __device__ bool next(int i, Unit& u) const {
        const long L = (long)i * G + c; if (L >= nwg) return false;
        int wgid = (int)L; { const int q = nwg / NXCD, r = nwg % NXCD, xcd = wgid % NXCD, off = wgid / NXCD; wgid = (xcd < r ? xcd * (q + 1) : r * (q + 1) + (xcd - r) * q) + off; }
        const int nig = WGM * nN, gid = wgid / nig, fm = gid * WGM, gsz = (nM - fm) < WGM ? (nM - fm) : WGM;
        u.pm = fm + ((wgid % nig) % gsz); u.pn = (wgid % nig) / gsz; return true;
    }
    __device__ __forceinline__ void a_ready(const Unit&) const {}
    __device__ __forceinline__ void done(const Unit&) const {}
};

__device__ __forceinline__ unsigned cvt_pk_bf16(float lo, float hi) { unsigned r; asm volatile("v_cvt_pk_bf16_f32 %0, %1, %2" : "=v"(r) : "v"(lo), "v"(hi)); return r; }
typedef float f32x2 __attribute__((ext_vector_type(2)));
__device__ __forceinline__ f32x2 gelu_pk(f32x2 v) {
    const f32x2 av = __builtin_elementwise_abs(v), d = av * 0.2316418882f + 1.0f;
    f32x2 t; t.x = __builtin_amdgcn_rcpf(d.x); t.y = __builtin_amdgcn_rcpf(d.y);
    f32x2 q = t * 0.5307027145f + (-0.7265760135f); q = q * t + 0.7107068705f; q = q * t + (-0.142248368f); q = q * t + 0.127414796f; q = q * t;
    const f32x2 s = (v * v) * (-0.72134752044f);
    f32x2 e; e.x = __builtin_amdgcn_exp2f(s.x); e.y = __builtin_amdgcn_exp2f(s.y);
    const f32x2 m = v * (q * e), r = v - m;
    f32x2 o; o.x = v.x < 0.f ? m.x : r.x; o.y = v.y < 0.f ? m.y : r.y; return o;
}

template <int ACT  > struct EpiBf16 {
    static constexpr bool PERM = true, AFTER_DRAIN = false; static_assert(ACT == 0 || ACT == 1, "EpiBf16: ACT is 0 (none) or 1 (gelu_pk)");
    bf16_t* O; int ldc; const float* bias; int split_cols; size_t split_stride; float scale0;
    __device__ __forceinline__ void operator()(const f32x4 (&acc)[2][2][4][2], const Unit& u, int wr, int wc, int fr, int fq) const {
        const int row0 = u.pm * BM + wr * 64 + fr; int colt = u.pn * BM; bf16_t* base = O;
        float sc = 1.f; if (split_cols) { const int t = colt / split_cols; base += (size_t)t * split_stride; colt -= t * split_cols; if (t == 0) sc = scale0; }
        const int col0 = colt + wc * 32 + 8 * fq, bcol0 = u.pn * BM + wc * 32 + 8 * fq;
        f32x4 bv[2][2];
#pragma unroll
        for (int bj = 0; bj < 2; ++bj)
#pragma unroll
            for (int n = 0; n < 2; ++n) bv[bj][n] = bias ? *(const f32x4*)(bias + bcol0 + bj * HALF + 4 * n) : (f32x4){0.f, 0.f, 0.f, 0.f};
#pragma unroll
        for (int ai = 0; ai < 2; ++ai)
#pragma unroll
            for (int m = 0; m < 4; ++m) { bf16_t* rowp = base + (size_t)(row0 + ai * HALF + m * 16) * ldc + col0;
#pragma unroll
                for (int bj = 0; bj < 2; ++bj) { f32x4 v0 = acc[ai][bj][m][0] + bv[bj][0], v1 = acc[ai][bj][m][1] + bv[bj][1];
                    if (ACT == 1) { f32x2 a = gelu_pk((f32x2){v0[0], v0[1]}), b = gelu_pk((f32x2){v0[2], v0[3]}), c = gelu_pk((f32x2){v1[0], v1[1]}), d = gelu_pk((f32x2){v1[2], v1[3]});
                        v0 = (f32x4){a.x, a.y, b.x, b.y}; v1 = (f32x4){c.x, c.y, d.x, d.y}; }
                    v0 = v0 * sc; v1 = v1 * sc; u32x4 w; w.x = cvt_pk_bf16(v0[0], v0[1]); w.y = cvt_pk_bf16(v0[2], v0[3]); w.z = cvt_pk_bf16(v1[0], v1[1]); w.w = cvt_pk_bf16(v1[2], v1[3]);
                    *(u32x4*)(rowp + bj * HALF) = w; } }
    }
};

struct PanelStats {
    unsigned* xbuf;
    unsigned* cnt;
    unsigned* tmo;
    int ntn; float eps;
    unsigned code;
    __device__ __forceinline__ bool run(const f32x4 (&v)[2][2][4][2], const Unit& u, int wr, int wc, int fr, int fq, PG8_LAS unsigned char* lds, int wid, int lane) const {
        typedef float f32x2v __attribute__((ext_vector_type(2)));
        PG8_LAS f32x2v* P = (PG8_LAS f32x2v*)lds;
        PG8_LAS f32x2v* S = (PG8_LAS f32x2v*)(lds + 8192);
        PG8_LAS unsigned* flag = (PG8_LAS unsigned*)(lds + 8192 + 2048);
#pragma unroll
        for (int ai = 0; ai < 2; ++ai)
#pragma unroll
            for (int m = 0; m < 4; ++m) {
                float s = 0.f;
#pragma unroll
                for (int bj = 0; bj < 2; ++bj)
#pragma unroll
                    for (int n = 0; n < 2; ++n) { const f32x4 x = v[ai][bj][m][n]; s += (x[0] + x[1]) + (x[2] + x[3]); }
                s += __shfl_xor(s, 16); s += __shfl_xor(s, 32);
                const float mw = s * (1.0f / 64.0f); float q = 0.f;
#pragma unroll
                for (int bj = 0; bj < 2; ++bj)
#pragma unroll
                    for (int n = 0; n < 2; ++n) { const f32x4 d = v[ai][bj][m][n] - mw; q += (d[0] * d[0] + d[1] * d[1]) + (d[2] * d[2] + d[3] * d[3]); }
                q += __shfl_xor(q, 16); q += __shfl_xor(q, 32);
                if (fq == 0) P[(ai * HALF + wr * 64 + m * 16 + fr) * 4 + wc] = (f32x2v){mw, q};
            }
        asm volatile("s_waitcnt lgkmcnt(0)" ::: "memory"); __builtin_amdgcn_s_barrier(); asm volatile("" ::: "memory");
#if defined(BROKEN_EXCHANGE_NO_WAIT)
#warning BROKEN CONTROL BUILD: the row-statistics exchange does not wait; results are wrong by design
        if (blockIdx.x >= 64) { const long long t0_ = clock64(); while (clock64() - t0_ < 60000) __builtin_amdgcn_s_sleep(8); }
#endif
        const int row = wid * 32 + (lane & 31);
        if (lane < 32) {
            const f32x2v a = P[row * 4 + 0], b = P[row * 4 + 1], c = P[row * 4 + 2], d = P[row * 4 + 3];
            const float mt = (a.x + b.x + c.x + d.x) * 0.25f;
            const float da = a.x - mt, db = b.x - mt, dc = c.x - mt, dd = d.x - mt;
            const float m2 = (a.y + b.y) + (c.y + d.y) + 64.0f * ((da * da + db * db) + (dc * dc + dd * dd));
            unsigned long long* slot = (unsigned long long*)xbuf + ((size_t)(u.pm * BM + row) * 4 + u.pn);
            __hip_atomic_store(slot, ((unsigned long long)__float_as_uint(m2) << 32) | __float_as_uint(mt), __ATOMIC_RELAXED, __HIP_MEMORY_SCOPE_AGENT);
        }
        asm volatile("s_waitcnt vmcnt(0)" ::: "memory");
        if (lane == 0) __hip_atomic_fetch_add(cnt + 64 * u.pm, 1u, __ATOMIC_RELAXED, __HIP_MEMORY_SCOPE_AGENT);
        if (wid == 0) {
            bool dead = false; const unsigned long long t0 = __builtin_amdgcn_s_memrealtime(); const unsigned want = 8u * (unsigned)ntn;
            for (;;) {
#if defined(BROKEN_EXCHANGE_NO_WAIT)
                break;
#endif
                if ((unsigned)__builtin_amdgcn_readfirstlane(__hip_atomic_load(cnt + 64 * u.pm, __ATOMIC_RELAXED, __HIP_MEMORY_SCOPE_AGENT)) >= want) break;
                if (__builtin_amdgcn_s_memrealtime() - t0 > 2000000ull) {
                    if (lane == 0) { unsigned expect = 0u; __hip_atomic_compare_exchange_strong(tmo + 1, &expect, code | (unsigned)(u.pm & 0xff), __ATOMIC_RELAXED, __ATOMIC_RELAXED, __HIP_MEMORY_SCOPE_AGENT);
                                     __hip_atomic_store(tmo, 1u, __ATOMIC_RELAXED, __HIP_MEMORY_SCOPE_AGENT); }
                    dead = true; break; }
                __builtin_amdgcn_s_sleep(2);
            }
            __builtin_amdgcn_fence(__ATOMIC_ACQUIRE, "agent");
            if (lane == 0) flag[0] = dead ? 1u : 0u;
        }
        asm volatile("s_waitcnt vmcnt(0) lgkmcnt(0)" ::: "memory"); __builtin_amdgcn_s_barrier(); asm volatile("" ::: "memory");
        const bool bad = flag[0] != 0u;
        if (lane < 32) {
            const unsigned long long* slot = (const unsigned long long*)xbuf + (size_t)(u.pm * BM + row) * 4; float mt[4], m2[4]; float ms = 0.f;
#pragma unroll
            for (int t = 0; t < 4; ++t) { if (t < ntn) { const unsigned long long w = __hip_atomic_load(slot + t, __ATOMIC_RELAXED, __HIP_MEMORY_SCOPE_AGENT); mt[t] = __uint_as_float((unsigned)w); m2[t] = __uint_as_float((unsigned)(w >> 32)); } else { mt[t] = 0.f; m2[t] = 0.f; } ms += mt[t]; }
            const float mean = ms / (float)ntn; float q = 0.f;
#pragma unroll
            for (int t = 0; t < 4; ++t) if (t < ntn) { const float dm = mt[t] - mean; q += m2[t] + 256.0f * dm * dm; }
            S[row] = (f32x2v){mean, 1.0f / sqrtf(q / (256.0f * (float)ntn) + eps)};
        }
        asm volatile("s_waitcnt lgkmcnt(0)" ::: "memory"); __builtin_amdgcn_s_barrier(); asm volatile("" ::: "memory");
        return bad;
    }
};
struct EpiLnRes {
    static constexpr bool PERM = false, AFTER_DRAIN = true;
    const float* base; float* out; int ldc; const float* bias; PanelStats st; unsigned poison;
    __device__ __forceinline__ void fused(f32x4 (&acc)[2][2][4][2], const Unit& u, int wr, int wc, int fr, int fq, PG8_LAS unsigned char* lds, int wid, int lane) const {
        typedef float f32x2v __attribute__((ext_vector_type(2)));
        const PG8_LAS f32x2v* S = (const PG8_LAS f32x2v*)(lds + 8192);
        const int col0 = u.pn * BM + wc * 32 + 4 * fq;
#pragma unroll
        for (int bj = 0; bj < 2; ++bj)
#pragma unroll
            for (int n = 0; n < 2; ++n) { const f32x4 bv = bias ? *(const f32x4*)(bias + col0 + bj * HALF + n * 16) : (f32x4){0.f, 0.f, 0.f, 0.f};
#pragma unroll
                for (int ai = 0; ai < 2; ++ai)
#pragma unroll
                    for (int m = 0; m < 4; ++m) acc[ai][bj][m][n] += bv; }
        f32x4 pre[4][2][2];
#pragma unroll
        for (int m = 0; m < 4; ++m) { const size_t off = (size_t)(u.pm * BM + wr * 64 + m * 16 + fr) * ldc + col0;
#pragma unroll
            for (int bj = 0; bj < 2; ++bj)
#pragma unroll
                for (int n = 0; n < 2; ++n) pre[m][bj][n] = *(const f32x4*)(base + off + bj * HALF + n * 16); }
        const bool bad = st.run(acc, u, wr, wc, fr, fq, lds, wid, lane) || poison != 0u;
        const float qnan = __builtin_nanf("");
#pragma unroll
        for (int ai = 0; ai < 2; ++ai)
#pragma unroll
            for (int m = 0; m < 4; ++m) { const int r = ai * HALF + wr * 64 + m * 16 + fr; const f32x2v sr = S[r]; const size_t off = (size_t)(u.pm * BM + r) * ldc + col0;
#pragma unroll
                for (int bj = 0; bj < 2; ++bj)
#pragma unroll
                    for (int n = 0; n < 2; ++n) { const f32x4 bs = ai == 0 ? pre[m][bj][n] : *(const f32x4*)(base + off + bj * HALF + n * 16); f32x4 o = bs + (acc[ai][bj][m][n] - sr.x) * sr.y;
                        if (bad) o = (f32x4){qnan, qnan, qnan, qnan}; *(f32x4*)(out + off + bj * HALF + n * 16) = o; }
                if (m & 1) asm volatile("" ::: "memory"); }
    }
};
struct EpiLnResLn {
    static constexpr bool PERM = false, AFTER_DRAIN = true;
    const float* base; float* out; bf16_t* xn; int ldc; const float* bias; PanelStats st1, st2; unsigned poison;
    __device__ __forceinline__ void fused(f32x4 (&acc)[2][2][4][2], const Unit& u, int wr, int wc, int fr, int fq, PG8_LAS unsigned char* lds, int wid, int lane) const {
        typedef float f32x2v __attribute__((ext_vector_type(2))); typedef unsigned u32x2v __attribute__((ext_vector_type(2)));
        const PG8_LAS f32x2v* S = (const PG8_LAS f32x2v*)(lds + 8192);
        const int col0 = u.pn * BM + wc * 32 + 4 * fq;
#pragma unroll
        for (int bj = 0; bj < 2; ++bj)
#pragma unroll
            for (int n = 0; n < 2; ++n) { const f32x4 bv = bias ? *(const f32x4*)(bias + col0 + bj * HALF + n * 16) : (f32x4){0.f, 0.f, 0.f, 0.f};
#pragma unroll
                for (int ai = 0; ai < 2; ++ai)
#pragma unroll
                    for (int m = 0; m < 4; ++m) acc[ai][bj][m][n] += bv; }
        bool bad = st1.run(acc, u, wr, wc, fr, fq, lds, wid, lane) || poison != 0u;
        const float qnan = __builtin_nanf("");
#pragma unroll
        for (int ai = 0; ai < 2; ++ai)
#pragma unroll
            for (int m = 0; m < 4; ++m) { const int r = ai * HALF + wr * 64 + m * 16 + fr; const f32x2v sr = S[r]; const size_t off = (size_t)(u.pm * BM + r) * ldc + col0;
#pragma unroll
                for (int bj = 0; bj < 2; ++bj)
#pragma unroll
                    for (int n = 0; n < 2; ++n) { const f32x4 bs = *(const f32x4*)(base + off + bj * HALF + n * 16); acc[ai][bj][m][n] = bs + (acc[ai][bj][m][n] - sr.x) * sr.y; }
                asm volatile("" : "+v"(acc[ai][0][m][0]), "+v"(acc[ai][0][m][1]), "+v"(acc[ai][1][m][0]), "+v"(acc[ai][1][m][1]));
                if (m & 1) asm volatile("" ::: "memory"); }
        const bool bad1 = bad;
        bad = st2.run(acc, u, wr, wc, fr, fq, lds, wid, lane) || bad;
#pragma unroll
        for (int ai = 0; ai < 2; ++ai)
#pragma unroll
            for (int m = 0; m < 4; ++m) { const int r = ai * HALF + wr * 64 + m * 16 + fr; const f32x2v sr = S[r]; const size_t off = (size_t)(u.pm * BM + r) * ldc + col0;
#pragma unroll
                for (int bj = 0; bj < 2; ++bj)
#pragma unroll
                    for (int n = 0; n < 2; ++n) { const f32x4 x1 = acc[ai][bj][m][n]; *(f32x4*)(out + off + bj * HALF + n * 16) = bad1 ? (f32x4){qnan, qnan, qnan, qnan} : x1;
                        const f32x4 o = (x1 - sr.x) * sr.y; u32x2v w; w.x = cvt_pk_bf16(o[0], o[1]); w.y = cvt_pk_bf16(o[2], o[3]);
                        if (bad) { w.x = 0x7fc07fc0u; w.y = 0x7fc07fc0u; } *(u32x2v*)(xn + off + bj * HALF + n * 16) = w; }
                asm volatile("" ::: "memory"); }
    }
};

template <class Epi, class Sched, bool ALIGN_EPI = false, bool SP2 = false>
__device__ __forceinline__ void gemm_phase(PG8_LAS unsigned char* lds, const Gemm g, const Sched& S, const Epi& E) {
    const int tid = threadIdx.x, wid = __builtin_amdgcn_readfirstlane(tid >> 6), lane = tid & 63, wr = wid >> 2, wc = wid & 3, fr = lane & 15, fq = lane >> 4;
    const int K = g.K, nt = K / BK;
    unsigned voffA[2], voffB[2];
#pragma unroll
    for (int i = 0; i < 2; ++i) { int R, C; stage_rc(tid * 16 + i * 8192, R, C); const int Rb = Epi::PERM ? ((R & ~31) + perm32(R & 31)) : R;
        voffA[i] = (unsigned)(R * K + C) * 2u; voffB[i] = (unsigned)(Rb * K + C) * 2u; }
    const size_t kstep = (size_t)(BK * 2);
    const size_t hstep = (size_t)HALF * K * 2;
    const size_t tstep = 2 * hstep;
    const unsigned ldsw = (unsigned)wid * 1024u;
    const int aoff = lds_byte(wr * 64 + fr, fq * 8), boff = lds_byte(wc * 32 + fr, fq * 8);
#define PG8_SA(b, h) (((b) * 2 + (h)) * HTB)
#define PG8_SB(b, h) ((4 + (b) * 2 + (h)) * HTB)
#define PG8_STAGE(bufoff, gbase, voff) do { _Pragma("unroll") for (int _i = 0; _i < 2; ++_i) \
        __builtin_amdgcn_global_load_lds((const unsigned*)((const char*)(gbase) + (voff)[_i]), (PG8_LAS unsigned*)(lds + (bufoff) + ldsw + _i * 8192), 16, 0, 0); } while (0)
#define PG8_LDA(dst, b, h) do { _Pragma("unroll") for (int m = 0; m < 4; ++m) _Pragma("unroll") for (int k = 0; k < 2; ++k) dst[m][k] = *(const PG8_LAS bf16x8*)(lds + PG8_SA(b, h) + aoff + m * 2048 + k * 1024); } while (0)
#define PG8_LDB(dst, b, h) do { _Pragma("unroll") for (int n = 0; n < 2; ++n) _Pragma("unroll") for (int k = 0; k < 2; ++k) dst[n][k] = *(const PG8_LAS bf16x8*)(lds + PG8_SB(b, h) + boff + n * 2048 + k * 1024); } while (0)
#define PG8_MMA(ai, bj, At, Bt) do { __builtin_amdgcn_s_setprio(1); _Pragma("unroll") for (int m = 0; m < 4; ++m) _Pragma("unroll") for (int n = 0; n < 2; ++n) _Pragma("unroll") for (int k = 0; k < 2; ++k) \
        acc[ai][bj][m][n] = __builtin_amdgcn_mfma_f32_16x16x32_bf16(Bt[n][k], At[m][k], acc[ai][bj][m][n], 0, 0, 0); __builtin_amdgcn_s_setprio(0); } while (0)
#define PG8_WAIT_V(n) asm volatile("s_waitcnt vmcnt(" #n ")" ::: "memory")
#define PG8_WAIT_L(n) asm volatile("s_waitcnt lgkmcnt(" #n ")" ::: "memory")
#define PG8_BAR __builtin_amdgcn_s_barrier()
#define PG8_SCHED __builtin_amdgcn_sched_barrier(0)
    Unit cur, nxt; int ui = 0;
    if (!S.next(0, cur)) return;
    f32x4 acc[2][2][4][2];
#pragma unroll
    for (int a = 0; a < 2; ++a)
#pragma unroll
        for (int b = 0; b < 2; ++b)
#pragma unroll
            for (int m = 0; m < 4; ++m)
#pragma unroll
                for (int n = 0; n < 2; ++n) acc[a][b][m][n] = (f32x4){0.f, 0.f, 0.f, 0.f};
    bf16x8 At[4][2], B0[2][2], B1[2][2];
    const char* cA = (const char*)g.A + (size_t)cur.pm * tstep; const char* cB = (const char*)g.Bt + (size_t)cur.pn * tstep;
    S.a_ready(cur);
    if constexpr (SP2) {
        PG8_STAGE(PG8_SB(0, 0), cB, voffB); PG8_STAGE(PG8_SB(0, 1), cB + hstep, voffB); PG8_STAGE(PG8_SA(0, 0), cA, voffA); PG8_STAGE(PG8_SA(0, 1), cA + hstep, voffA);
        if (wr == 1) PG8_BAR;
        PG8_WAIT_V(2); PG8_BAR;
        PG8_STAGE(PG8_SB(1, 0), cB + kstep, voffB); PG8_STAGE(PG8_SA(1, 0), cA + kstep, voffA); PG8_STAGE(PG8_SB(1, 1), cB + hstep + kstep, voffB);
        PG8_WAIT_V(6); PG8_BAR;
    } else {
        PG8_STAGE(PG8_SB(0, 0), cB, voffB); PG8_STAGE(PG8_SA(0, 0), cA, voffA); PG8_STAGE(PG8_SB(0, 1), cB + hstep, voffB); PG8_STAGE(PG8_SA(0, 1), cA + hstep, voffA);
        if (wr == 1) PG8_BAR;
        PG8_WAIT_V(4); PG8_BAR;
        PG8_STAGE(PG8_SB(1, 0), cB + kstep, voffB); PG8_STAGE(PG8_SA(1, 0), cA + kstep, voffA); PG8_STAGE(PG8_SB(1, 1), cB + hstep + kstep, voffB);
        PG8_WAIT_V(6); PG8_BAR;
    }
    for (;;) {
        const bool has_next = S.next(ui + 1, nxt);
        const char* nA = has_next ? (const char*)g.A + (size_t)nxt.pm * tstep : cA; const char* nB = has_next ? (const char*)g.Bt + (size_t)nxt.pn * tstep : cB;
        for (int t = 0; t < nt; t += 2) {
            const bool last = (t == nt - 2);
            const char* a1 = cA + (size_t)(t + 1) * kstep;
            const char* a2 = last ? nA : cA + (size_t)(t + 2) * kstep; const char* b2 = last ? nB : cB + (size_t)(t + 2) * kstep;
            const char* a3 = a2 + kstep; const char* b3 = b2 + kstep;
            if (last && has_next) S.a_ready(nxt);
            if constexpr (SP2) {
            PG8_LDB(B0, 0, 0); PG8_LDB(B1, 0, 1); PG8_SCHED; PG8_LDA(At, 0, 0); PG8_STAGE(PG8_SA(1, 1), a1 + hstep, voffA);
            PG8_WAIT_V(8); PG8_WAIT_L(0); PG8_BAR; PG8_MMA(0, 0, At, B0); PG8_MMA(0, 1, At, B1); PG8_BAR; PG8_SCHED;
            PG8_LDA(At, 0, 1); PG8_STAGE(PG8_SB(0, 0), b2, voffB); PG8_STAGE(PG8_SB(0, 1), b2 + hstep, voffB); PG8_STAGE(PG8_SA(0, 0), a2, voffA);
            PG8_WAIT_V(8); PG8_WAIT_L(0); PG8_BAR; PG8_MMA(1, 0, At, B0); PG8_MMA(1, 1, At, B1); PG8_BAR; PG8_SCHED;
            PG8_LDB(B0, 1, 0); PG8_LDB(B1, 1, 1); PG8_SCHED; PG8_LDA(At, 1, 0); PG8_STAGE(PG8_SA(0, 1), a2 + hstep, voffA);
            PG8_WAIT_V(8); PG8_WAIT_L(0); PG8_BAR; PG8_MMA(0, 0, At, B0); PG8_MMA(0, 1, At, B1); PG8_BAR; PG8_SCHED;
            PG8_LDA(At, 1, 1); PG8_STAGE(PG8_SB(1, 0), b3, voffB); PG8_STAGE(PG8_SB(1, 1), b3 + hstep, voffB); PG8_STAGE(PG8_SA(1, 0), a3, voffA);
            PG8_WAIT_V(8); PG8_WAIT_L(0); PG8_BAR; PG8_MMA(1, 0, At, B0); PG8_MMA(1, 1, At, B1); PG8_BAR; PG8_SCHED;
            } else {
            PG8_LDB(B0, 0, 0); PG8_SCHED; PG8_LDA(At, 0, 0); PG8_STAGE(PG8_SA(1, 1), a1 + hstep, voffA);
            PG8_WAIT_L(8); PG8_BAR; PG8_WAIT_L(0); PG8_MMA(0, 0, At, B0); PG8_BAR; PG8_SCHED;
            PG8_LDB(B1, 0, 1); PG8_STAGE(PG8_SB(0, 0), b2, voffB);
            PG8_BAR; PG8_WAIT_L(0); PG8_MMA(0, 1, At, B1); PG8_BAR;
            PG8_LDA(At, 0, 1); PG8_STAGE(PG8_SA(0, 0), a2, voffA);
            PG8_BAR; PG8_WAIT_L(0); PG8_MMA(1, 0, At, B0); PG8_BAR; PG8_SCHED;
            PG8_STAGE(PG8_SB(0, 1), b2 + hstep, voffB);
            PG8_WAIT_V(6); PG8_BAR; PG8_MMA(1, 1, At, B1); PG8_BAR;
            PG8_LDB(B0, 1, 0); PG8_SCHED; PG8_LDA(At, 1, 0); PG8_STAGE(PG8_SA(0, 1), a2 + hstep, voffA);
            PG8_WAIT_L(8); PG8_BAR; PG8_WAIT_L(0); PG8_MMA(0, 0, At, B0); PG8_BAR; PG8_SCHED;
            PG8_LDB(B1, 1, 1); PG8_STAGE(PG8_SB(1, 0), b3, voffB);
            PG8_BAR; PG8_WAIT_L(0); PG8_MMA(0, 1, At, B1); PG8_BAR;
            PG8_LDA(At, 1, 1); PG8_STAGE(PG8_SA(1, 0), a3, voffA);
            PG8_BAR; PG8_WAIT_L(0); PG8_MMA(1, 0, At, B0); PG8_BAR; PG8_SCHED;
            PG8_STAGE(PG8_SB(1, 1), b3 + hstep, voffB);
            PG8_WAIT_V(6); PG8_BAR; PG8_MMA(1, 1, At, B1); PG8_BAR;
            }
        }
        if constexpr (ALIGN_EPI) { if (wr == 0) PG8_BAR; }
        if constexpr (!Epi::AFTER_DRAIN) { E(acc, cur, wr, wc, fr, fq); S.done(cur); }
        if (!has_next) break;
#pragma unroll
        for (int a = 0; a < 2; ++a)
#pragma unroll
            for (int b = 0; b < 2; ++b)
#pragma unroll
                for (int m = 0; m < 4; ++m)
#pragma unroll
                    for (int n = 0; n < 2; ++n) acc[a][b][m][n] = (f32x4){0.f, 0.f, 0.f, 0.f};
        cur = nxt; cA = nA; cB = nB; ++ui;
        if constexpr (ALIGN_EPI) { if (wr == 1) PG8_BAR; }
    }
    PG8_WAIT_V(0);
    if constexpr (!ALIGN_EPI) { if (wr == 0) PG8_BAR; }
    PG8_BAR;
    if constexpr (Epi::AFTER_DRAIN) { E.fused(acc, cur, wr, wc, fr, fq, lds, wid, lane); S.done(cur); }
#undef PG8_SA
#undef PG8_SB
#undef PG8_STAGE
#undef PG8_LDA
#undef PG8_LDB
#undef PG8_MMA
#undef PG8_WAIT_V
#undef PG8_WAIT_L
#undef PG8_BAR
#undef PG8_SCHED
}
}

#define LAS __attribute__((address_space(3)))
typedef unsigned short bf16_t;
typedef short bf16x8 __attribute__((ext_vector_type(8)));
typedef short s16x4 __attribute__((ext_vector_type(4)));
typedef float f32x2 __attribute__((ext_vector_type(2)));
typedef float f32x4 __attribute__((ext_vector_type(4)));
typedef float f32x16 __attribute__((ext_vector_type(16)));
typedef unsigned u32x2 __attribute__((ext_vector_type(2)));
typedef unsigned u32x4 __attribute__((ext_vector_type(4)));
typedef int i32x4 __attribute__((ext_vector_type(4)));
typedef __bf16 bf16x2_t __attribute__((ext_vector_type(2)));

constexpr int NWAVES = 8, NTHR = 512;
constexpr int D = 2048, BATCH = 2, SEQ = 4096, CTX = 256, TPB = SEQ + CTX, M1 = BATCH * TPB, ML = BATCH * SEQ, NIN = 8192;
constexpr int C_HQ = 0, C_FF = 1024, C_FB = 2048, C_HI = 3072, C_HG = 4096, C_DQ = 5120, C_DK = 6144, C_DV = 7168;
constexpr float RMS_EPS = 1e-6f;
constexpr int NEXP = 16384, NMOD = 6 * D;
constexpr int LDS_BYTES = 155648;

constexpr size_t MiB = 1u << 20;
constexpr size_t WS_CTL = 0, CTL_BYTES = 1 * MiB;
constexpr size_t WS_MOD = 512 * 1024;
constexpr size_t WS_SMALL = 1 * MiB;
constexpr size_t WS_WIN = 2 * MiB, WS_WOUT = 34 * MiB, WS_WQ = 42 * MiB, WS_UBF = 50 * MiB, WS_VBF = 114 * MiB, WS_H = 178 * MiB, WS_PARTS = 212 * MiB,
                 WS_MIX = 348 * MiB, WS_HST = 380 * MiB, WS_HD = 412 * MiB, WS_IDX = 413 * MiB, WS_COEF = 417 * MiB, WS_OF = 421 * MiB, WS_KH = 453 * MiB, WS_VH = 471 * MiB, WS_END = 489 * MiB;
constexpr size_t WS_QP = WS_PARTS, WS_X1B = WS_PARTS + 96 * MiB;

struct Args { const float* in[22]; float* out; unsigned char* ws; int ph_lo, ph_hi; };
enum { I_X = 0, I_C, I_CTX, I_CCTX, I_WADA, I_BADA, I_N1G, I_WIN, I_HGG, I_HGNG, I_LQ1, I_LK1, I_LQ2, I_LK2, I_SUBG, I_WOUT, I_N2G, I_WQ, I_KEYS, I_PU, I_PV, I_FNG };

__device__ __forceinline__ float bf2f(unsigned short h) { return __uint_as_float((unsigned)h << 16); }
__device__ __forceinline__ unsigned pk2(float lo, float hi) { f32x2 v = {lo, hi}; bf16x2_t b = __builtin_convertvector(v, bf16x2_t); return __builtin_bit_cast(unsigned, b); }
__device__ __forceinline__ unsigned short f2bf(float f) { return (unsigned short)(pk2(f, 0.f) & 0xffffu); }
__device__ __forceinline__ float wave_sum(float v) {
#pragma unroll
    for (int o = 1; o < 64; o <<= 1) v += __shfl_xor(v, o);
    return v;
}
__device__ __forceinline__ int crow(int r, int hi) { return (r & 3) + 8 * (r >> 2) + 4 * hi; }
__device__ __forceinline__ float silu_f(float x) { return x / (1.f + __expf(-x)); }
#define SBAR() __builtin_amdgcn_sched_barrier(0)

__device__ __forceinline__ int v_st(int k, int c) { const int kk = (k & ~0xC) | ((k & 4) << 1) | ((k & 8) >> 1); return ((kk >> 3) * 4 + (c >> 5)) * 512 + ((kk & 7) * 32 + (c & 31)) * 2; }
__device__ __forceinline__ int v_rd_base(int lane) { return ((lane & 3) << 3) | (((lane >> 2) & 3) << 6) | (((lane >> 4) & 1) << 5) | (((lane >> 5) & 1) << 8); }
constexpr int v_rd_off(int d0, int ks, int half) { return d0 * 512 + ks * 4096 + half * 2048; }
template <int OFF> __device__ __forceinline__ s16x4 tr_read(int vb) {
  s16x4 r; asm volatile("ds_read_b64_tr_b16 %0, %1 offset:%2" : "=&v"(r) : "v"(vb), "i"(OFF) : "memory"); return r;
}
template <int D0> __device__ __forceinline__ void pv_one(f32x16& od, int vb, bf16x8 pa0, bf16x8 pa1, bf16x8 pa2, bf16x8 pa3) {
  const s16x4 l0 = tr_read<v_rd_off(D0, 0, 0)>(vb), h0 = tr_read<v_rd_off(D0, 0, 1)>(vb), l1 = tr_read<v_rd_off(D0, 1, 0)>(vb), h1 = tr_read<v_rd_off(D0, 1, 1)>(vb);
  const s16x4 l2 = tr_read<v_rd_off(D0, 2, 0)>(vb), h2 = tr_read<v_rd_off(D0, 2, 1)>(vb), l3 = tr_read<v_rd_off(D0, 3, 0)>(vb), h3 = tr_read<v_rd_off(D0, 3, 1)>(vb);
  asm volatile("s_waitcnt lgkmcnt(0)" ::: "memory"); SBAR();
#define PK(L, H) (bf16x8){L[0], L[1], L[2], L[3], H[0], H[1], H[2], H[3]}
  od = __builtin_amdgcn_mfma_f32_32x32x16_bf16(pa0, PK(l0, h0), od, 0, 0, 0);
  od = __builtin_amdgcn_mfma_f32_32x32x16_bf16(pa1, PK(l1, h1), od, 0, 0, 0);
  od = __builtin_amdgcn_mfma_f32_32x32x16_bf16(pa2, PK(l2, h2), od, 0, 0, 0);
  od = __builtin_amdgcn_mfma_f32_32x32x16_bf16(pa3, PK(l3, h3), od, 0, 0, 0);
#undef PK
}

__device__ __forceinline__ void p0_transpose_item(const float* W, int K, int N, bf16_t* WT, LAS float* scr, int item, int lane) {
    const int nblk = N / 32, kb = item / nblk, nb = item % nblk, k0 = 64 * kb, n0 = 32 * nb;
    float wv_[32];
#pragma unroll
    for (int i = 0; i < 32; ++i) wv_[i] = __builtin_nontemporal_load(W + (size_t)(k0 + 2 * i + (lane >> 5)) * N + n0 + (lane & 31));
#pragma unroll
    for (int i = 0; i < 32; ++i) scr[(2 * i + (lane >> 5)) * 33 + (lane & 31)] = wv_[i];
    asm volatile("s_waitcnt lgkmcnt(0)" ::: "memory");
    const int c = lane & 7;
#pragma unroll
    for (int j = 0; j < 4; ++j) { const int n = (lane >> 3) + 8 * j; const LAS float* s = scr + (8 * c) * 33 + n;
        u32x4 o; o.x = pk2(s[0 * 33], s[1 * 33]); o.y = pk2(s[2 * 33], s[3 * 33]); o.z = pk2(s[4 * 33], s[5 * 33]); o.w = pk2(s[6 * 33], s[7 * 33]);
        *(u32x4*)(WT + (size_t)(n0 + n) * K + k0 + 8 * c) = o; }
    asm volatile("s_waitcnt lgkmcnt(0)" ::: "memory");
}
__device__ __forceinline__ void cvt8(const float* src, bf16_t* dst) {
    const f32x4 a = *(const f32x4*)src, b = *(const f32x4*)(src + 4);
    u32x4 o; o.x = pk2(a.x, a.y); o.y = pk2(a.z, a.w); o.z = pk2(b.x, b.y); o.w = pk2(b.z, b.w); *(u32x4*)dst = o;
}
__device__ __forceinline__ void p0_prologue(const Args& a, unsigned char* lds, int vcu, int G, int tid, int lane, int wave) {
    unsigned char* ws = a.ws;
    LAS float* scr = (LAS float*)lds + wave * 4096;
    const int gw = vcu * NWAVES + wave, NGW = G * NWAVES;
    float* mod = (float*)(ws + WS_MOD);
    if (vcu < 192) {
        LAS float* sl = (LAS float*)lds;
        for (int i = tid; i < 3 * D; i += NTHR) { const int v = i >> 11, k = i & 2047; const float cv = v < 2 ? a.in[I_C][v * D + k] : a.in[I_CCTX][k]; sl[i] = silu_f(cv); }
        __syncthreads();
        const int rs = lane >> 4, c4 = lane & 15;
        const float* wp = a.in[I_WADA] + (size_t)(wave * 256 + rs) * NMOD + vcu * 64 + 4 * c4;
        f32x4 acc0 = {0.f, 0.f, 0.f, 0.f}, acc1 = acc0, acc2 = acc0;
#pragma unroll 8
        for (int i = 0; i < 64; ++i) { const int k = wave * 256 + 4 * i + rs; const f32x4 w = __builtin_nontemporal_load((const f32x4*)(wp + (size_t)(4 * i) * NMOD));
            acc0 += w * sl[k]; acc1 += w * sl[D + k]; acc2 += w * sl[2 * D + k]; }
        LAS float* pr = sl + 3 * D;
#pragma unroll
        for (int e = 0; e < 4; ++e) {
            float x0 = acc0[e], x1 = acc1[e], x2 = acc2[e];
            x0 += __shfl_xor(x0, 16); x0 += __shfl_xor(x0, 32); x1 += __shfl_xor(x1, 16); x1 += __shfl_xor(x1, 32); x2 += __shfl_xor(x2, 16); x2 += __shfl_xor(x2, 32);
            if (rs == 0) { pr[(wave * 3 + 0) * 64 + 4 * c4 + e] = x0; pr[(wave * 3 + 1) * 64 + 4 * c4 + e] = x1; pr[(wave * 3 + 2) * 64 + 4 * c4 + e] = x2; }
        }
        __syncthreads();
        if (tid < 192) { const int v = tid >> 6, c = tid & 63; float s = 0.f;
#pragma unroll
            for (int w = 0; w < 8; ++w) s += pr[(w * 3 + v) * 64 + c];
            __hip_atomic_store((unsigned*)mod + v * NMOD + vcu * 64 + c, __float_as_uint(s), __ATOMIC_RELAXED, __HIP_MEMORY_SCOPE_AGENT); }
        asm volatile("s_waitcnt vmcnt(0)" ::: "memory");
        __syncthreads();
        if (tid == 0) __hip_atomic_fetch_add((unsigned*)(ws + WS_CTL) + 12288, 1u, __ATOMIC_RELAXED, __HIP_MEMORY_SCOPE_AGENT);
    }
    constexpr int I_IN = (D / 64) * (NIN / 32), I_O = (D / 64) * (D / 32);
    for (int it = gw; it < I_IN + 2 * I_O; it += NGW) {
        int r = it;
        if (r < I_IN) { p0_transpose_item(a.in[I_WIN], D, NIN, (bf16_t*)(ws + WS_WIN), scr, r, lane); continue; } r -= I_IN;
        if (r < I_O) { p0_transpose_item(a.in[I_WOUT], D, D, (bf16_t*)(ws + WS_WOUT), scr, r, lane); continue; } r -= I_O;
        p0_transpose_item(a.in[I_WQ], D, D, (bf16_t*)(ws + WS_WQ), scr, r, lane);
    }
    {
        const long NK8 = 8 * 2 * 128 * 128 / 8, gt = (long)vcu * NTHR + tid, NT = (long)G * NTHR;
        for (long i = gt; i < NK8; i += NT) cvt8(a.in[I_KEYS] + i * 8, (bf16_t*)(ws + WS_SMALL + 512 * 1024) + i * 8);
    }
    if (vcu == (G > 192 ? G - 1 : 0)) {
        float* sm = (float*)(ws + WS_SMALL);
        for (int i = tid; i < 2048; i += NTHR) { const float g0 = a.in[I_HGG][i], g1 = a.in[I_HGG][2048 + i]; sm[i] = 1.f / (1.f + expf(g1 - g0)); }
        if (tid < 16) {
            const float invf = expf(-(float)tid * (1.f / 16.f) * 9.210340371976184f);
            const double w = (double)invf, w2 = w * w;
            double cs = 1.0, sn = w, tc = 1.0, tsn = w;
#pragma unroll
            for (int n = 1; n < 12; ++n) { tc = -tc * w2 * (1.0 / (double)((2 * n - 1) * (2 * n))); tsn = -tsn * w2 * (1.0 / (double)((2 * n) * (2 * n + 1))); cs += tc; sn += tsn; }
            double c = 1.0, s = 0.0;
            for (int pos = 0; pos < 64; ++pos) {
                sm[4096 + pos * 16 + tid] = (float)c; sm[5120 + pos * 16 + tid] = (float)s;
                const double c2 = c * cs - s * sn, s2 = s * cs + c * sn; c = c2; s = s2;
            }
        }
        if (tid == 64) {
            float d1 = 0.f, d2 = 0.f;
            for (int i = 0; i < 64; ++i) { d1 += a.in[I_LQ1][i] * a.in[I_LK1][i]; d2 += a.in[I_LQ2][i] * a.in[I_LK2][i]; }
            sm[2048] = expf(d1) - expf(d2) + 0.2f;
        }
    }
}

template <int WHICH> __device__ __forceinline__ void norm_phase(const Args& a, int vcu, int G, int lane, int wave) {
    const int gw = vcu * NWAVES + wave, NGW = G * NWAVES;
    const float* mod = (const float*)(a.ws + WS_MOD);
    const float* bada = a.in[I_BADA];
    const float* gain = a.in[WHICH == 0 ? I_N1G : I_N2G];
    bf16_t* H = (bf16_t*)(a.ws + WS_H);
    constexpr int NR = WHICH == 0 ? M1 : ML, CSH = WHICH == 0 ? 0 : 3 * D, CSC = WHICH == 0 ? D : 4 * D;
    for (int R = gw; R < NR; R += NGW) {
        const float* src; int v;
        if (WHICH == 0) { const int b = R / TPB, p = R % TPB; if (p < CTX) { src = a.in[I_CTX] + (size_t)(b * CTX + p) * D; v = 2; } else { src = a.in[I_X] + (size_t)(b * SEQ + p - CTX) * D; v = b; } }
        else { src = nullptr; v = R / SEQ; }
        f32x4 x[8]; float ss = 0.f;
#pragma unroll
        for (int j = 0; j < 8; ++j) {
            if (WHICH == 0) x[j] = __builtin_nontemporal_load((const f32x4*)(src + 256 * j + 4 * lane));
            else { const u32x2 w = *(const u32x2*)((const bf16_t*)(a.ws + WS_X1B) + (size_t)R * D + 256 * j + 4 * lane);
                   x[j] = (f32x4){__uint_as_float(w.x << 16), __uint_as_float(w.x & 0xffff0000u), __uint_as_float(w.y << 16), __uint_as_float(w.y & 0xffff0000u)}; }
            ss += (x[j].x * x[j].x + x[j].y * x[j].y) + (x[j].z * x[j].z + x[j].w * x[j].w); }
        const float rstd = rsqrtf(wave_sum(ss) * (1.f / D) + RMS_EPS);
#pragma unroll
        for (int j = 0; j < 8; ++j) {
            const int col = 256 * j + 4 * lane;
            const f32x4 g = *(const f32x4*)(gain + col);
            const f32x4 sh = *(const f32x4*)(mod + v * NMOD + CSH + col) + *(const f32x4*)(bada + CSH + col);
            const f32x4 sc = *(const f32x4*)(mod + v * NMOD + CSC + col) + *(const f32x4*)(bada + CSC + col);
            const f32x4 y = x[j] * rstd * g * (sc + 1.f) + sh;
            u32x2 o; o.x = pk2(y.x, y.y); o.y = pk2(y.z, y.w);
            *(u32x2*)(H + (size_t)R * D + col) = o;
        }
    }
}

#define GAS __attribute__((address_space(1)))
#ifndef SYNC_XCD
#define SYNC_XCD 1
#endif
#define XB_TMO      128
#define XB_XCNT(j)  (256  + 64 * (j))
#define XB_XSUB(j)  (1280 + 64 * (j))
#define XB_XGEN(j)  (2304 + 64 * (j))
#define XB_TOP      3328
#define XB_TOPGEN   3392
#define XCD_BAR_WORDS 3456
#define XB_SPIN_CAP (1u << 18)

__device__ __forceinline__ unsigned xb_ld(unsigned* p)              { return __hip_atomic_load(p, __ATOMIC_RELAXED, __HIP_MEMORY_SCOPE_AGENT); }
__device__ __forceinline__ unsigned xb_add(unsigned* p, unsigned v) { return __hip_atomic_fetch_add(p, v, __ATOMIC_RELAXED, __HIP_MEMORY_SCOPE_AGENT); }
__device__ __forceinline__ unsigned xb_xcc_id() { return (unsigned)__builtin_amdgcn_s_getreg((3 << 11) | 20) & 0xFu; }
#define XB_SPIN(cond, bar) do { unsigned _sp = 0; while (cond) { __builtin_amdgcn_s_sleep(1); \
    if ((++_sp & 255u) == 0u) { if (xb_ld(&(bar)[XB_TMO])) break; if (_sp > XB_SPIN_CAP) { atomicAdd(&(bar)[XB_TMO], 1u); break; } } } } while (0)

struct XcdBarrier {
    unsigned* bar; unsigned x;
    volatile LAS unsigned* st;
};

__device__ __forceinline__ XcdBarrier xcd_barrier_post(unsigned* bar, volatile LAS unsigned* st) {
    XcdBarrier b; b.bar = bar; b.x = xb_xcc_id(); b.st = st;
    if (threadIdx.x == 0) (void)xb_add(&bar[XB_XCNT(b.x)], 1u);
    return b;
}
__device__ __forceinline__ void xcd_barrier_complete(unsigned* bar, unsigned x, unsigned& nloc, unsigned& nx) {
    const unsigned G = gridDim.x * gridDim.y * gridDim.z;
    unsigned sum, cnt, mine, sp = 0u;
    for (;;) {
        sum = 0u; cnt = 0u; mine = 0u;
#pragma unroll
        for (unsigned j = 0; j < 16; ++j) { const unsigned c = xb_ld(&bar[XB_XCNT(j)]); sum += c; cnt += (c > 0u) ? 1u : 0u; mine = (j == x) ? c : mine; }
        if (sum == G) break;
        __builtin_amdgcn_s_sleep(1);
        if ((++sp & 255u) == 0u) { if (xb_ld(&bar[XB_TMO])) break; if (sp > XB_SPIN_CAP) { atomicAdd(&bar[XB_TMO], 1u); break; } }
    }
    nloc = mine > 0u ? mine : 1u; nx = cnt > 0u ? cnt : 1u;
}

__device__ __forceinline__ void xcd_barrier(const XcdBarrier& b) {
    asm volatile("s_waitcnt vmcnt(0)" ::: "memory");
    __syncthreads();
    if (threadIdx.x == 0) {
        unsigned* bar = b.bar;
        __builtin_amdgcn_s_waitcnt(0);
        unsigned nloc = b.st[0], nx = b.st[1];
        if (nloc == 0u) { xcd_barrier_complete(bar, b.x, nloc, nx); b.st[0] = nloc; b.st[1] = nx; }
        const unsigned old = xb_add(&bar[XB_XSUB(b.x)], 1u);
        const unsigned gen = old / nloc;
        if (old + 1u == (gen + 1u) * nloc) {
            __builtin_amdgcn_fence(__ATOMIC_RELEASE, "agent");
            asm volatile("s_waitcnt vmcnt(0)" ::: "memory");
            const unsigned og = xb_add(&bar[XB_TOP], 1u);
            const unsigned tg = og / nx;
            if (og + 1u == (tg + 1u) * nx) xb_add(&bar[XB_TOPGEN], 1u);
            else XB_SPIN(xb_ld(&bar[XB_TOPGEN]) == tg, bar);
            __builtin_amdgcn_fence(__ATOMIC_ACQUIRE, "agent");
            xb_add(&bar[XB_XGEN(b.x)], 1u);
            asm volatile("s_waitcnt vmcnt(0)" ::: "memory");
        } else {
            XB_SPIN(xb_ld(&bar[XB_XGEN(b.x)]) == gen, bar);
            __builtin_amdgcn_fence(__ATOMIC_ACQUIRE, "agent");
            asm volatile("s_waitcnt vmcnt(0)" ::: "memory");
        }
    }
    __syncthreads();
}

namespace pg8 {
struct OrderIn {
    int G, c;
    __device__ bool next(int i, Unit& u) const {
        const long L = (long)i * G + c; if (L >= 1064) return false;
        if (L < 1024) {
            int wgid = (int)L; wgid = (wgid & 7) * 128 + (wgid >> 3);
            const int pml = (wgid >> 8) * 8 + (wgid & 7);
            u.pm = pml < 16 ? pml + 1 : pml + 2; u.pn = (wgid & 255) >> 3;
        } else {
            const int e = (int)L - 1024, k = e % 20, g = k >> 2;
            u.pm = (e / 20) * 17; u.pn = (g < 3 ? g + 1 : g + 3) * 4 + (k & 3);
        }
        return true;
    }
    __device__ __forceinline__ void a_ready(const Unit&) const {}
    __device__ __forceinline__ void done(const Unit&) const {}
};
constexpr float QSC = 0.125f * 1.4426950408889634f;
struct EpiIn {
    static constexpr bool PERM = true, AFTER_DRAIN = false;
    bf16_t* O; const float* lb; const float* ropec; const float* ropes; bf16_t* KH; bf16_t* VH;
    __device__ __forceinline__ void operator()(const f32x4 (&acc)[2][2][4][2], const Unit& u, int wr, int wc, int fr, int fq) const {
        const int part = u.pn >> 2; const bool is_ctx = (u.pm == 0 || u.pm == 17);
        const int row0 = u.pm * BM + wr * 64 + fr, col0 = u.pn * BM + wc * 32 + 8 * fq;
        f32x4 lbv[2][2];
        if (part == 1 || part == 2) {
#pragma unroll
            for (int bj = 0; bj < 2; ++bj)
#pragma unroll
                for (int n = 0; n < 2; ++n) lbv[bj][n] = *(const f32x4*)(lb + (col0 + bj * HALF + 4 * n - 1024));
        }
        const int tb = (u.pm >= 17) ? (row0 - 4352 - 256) : (row0 - 256);
        const bool lowhalf = fq < 2;
#pragma unroll
        for (int ai = 0; ai < 2; ++ai)
#pragma unroll
            for (int m = 0; m < 4; ++m) {
                const int row = row0 + ai * HALF + m * 16;
                bf16_t* rowp = O + (size_t)row * 8192 + col0; size_t hstep = HALF;
                if (part >= 6) { const int bb = u.pm >= 17 ? 1 : 0, pos = row - bb * 4352;
                    rowp = (part == 6 ? KH : VH) + ((size_t)(bb * 8 + (u.pn & 3) * 2) * 4352 + pos) * 128 + wc * 32 + 8 * fq; hstep = (size_t)4352 * 128; }
                const bool rope = (part == 5 || part == 6) && !is_ctx;
                f32x4 cs[2], sn[2];
                if (rope) { const int t = tb + ai * HALF + m * 16; const int pos = (wc & 1) ? (t & 63) : (t >> 6);
#pragma unroll
                    for (int n = 0; n < 2; ++n) { cs[n] = *(const f32x4*)(ropec + pos * 16 + 8 * (fq & 1) + 4 * n); sn[n] = *(const f32x4*)(ropes + pos * 16 + 8 * (fq & 1) + 4 * n);
                        if (part == 5) { cs[n] *= QSC; sn[n] *= QSC; }
                        { const f32x4 c_ = cs[n], s_ = sn[n]; cs[n] = lowhalf ? c_ : s_; sn[n] = lowhalf ? -s_ : c_; } } }
#pragma unroll
                for (int bj = 0; bj < 2; ++bj) {
                    f32x4 v[2] = {acc[ai][bj][m][0], acc[ai][bj][m][1]};
                    if (part == 0 || part == 4) {
#pragma unroll
                        for (int n = 0; n < 2; ++n)
#pragma unroll
                            for (int j = 0; j < 4; j += 2) {
                                const f32x2 x2 = {v[n][j], v[n][j + 1]}; const f32x2 t2 = x2 * -1.4426950408889634f;
                                const f32x2 d2 = (f32x2){__builtin_amdgcn_exp2f(t2.x), __builtin_amdgcn_exp2f(t2.y)} + 1.f;
                                const f32x2 o2 = x2 * (f32x2){__builtin_amdgcn_rcpf(d2.x), __builtin_amdgcn_rcpf(d2.y)}; v[n][j] = o2.x; v[n][j + 1] = o2.y; }
                    } else if (part == 1 || part == 2) {
#pragma unroll
                        for (int n = 0; n < 2; ++n)
#pragma unroll
                            for (int j = 0; j < 4; j += 2) {
                                const f32x2 l2 = {lbv[bj][n][j], lbv[bj][n][j + 1]}; const f32x2 t2 = (f32x2){v[n][j], v[n][j + 1]} * -1.4426950408889634f;
                                const f32x2 d2 = (f32x2){__builtin_amdgcn_exp2f(t2.x), __builtin_amdgcn_exp2f(t2.y)} + 1.f;
                                const f32x2 w2 = (1.f - l2) * (f32x2){__builtin_amdgcn_rcpf(d2.x), __builtin_amdgcn_rcpf(d2.y)} + l2;
                                const f32x2 o2 = (f32x2){__builtin_amdgcn_logf(w2.x), __builtin_amdgcn_logf(w2.y)} * 0.6931471805599453f; v[n][j] = o2.x; v[n][j + 1] = o2.y; }
                    } else if (rope) {
#pragma unroll
                        for (int n = 0; n < 2; ++n)
#pragma unroll
                            for (int j = 0; j < 4; j += 2) {
                                auto r0 = __builtin_amdgcn_permlane32_swap(__float_as_uint(v[n][j]), __float_as_uint(v[n][j]), false, false);
                                auto r1 = __builtin_amdgcn_permlane32_swap(__float_as_uint(v[n][j + 1]), __float_as_uint(v[n][j + 1]), false, false);
                                const f32x2 t1 = {__uint_as_float(r0[0]), __uint_as_float(r1[0])}, t2 = {__uint_as_float(r0[1]), __uint_as_float(r1[1])};
                                const f32x2 o2 = t1 * (f32x2){cs[n][j], cs[n][j + 1]} + t2 * (f32x2){sn[n][j], sn[n][j + 1]}; v[n][j] = o2.x; v[n][j + 1] = o2.y;
                            }
                    }
                    u32x4 w; w.x = pk2(v[0][0], v[0][1]); w.y = pk2(v[0][2], v[0][3]); w.z = pk2(v[1][0], v[1][1]); w.w = pk2(v[1][2], v[1][3]);
                    *(u32x4*)(rowp + bj * hstep) = w;
                }
            }
    }
};
struct EpiOut {
    static constexpr bool PERM = true, AFTER_DRAIN = false;
    const float* x; bf16_t* out; const float* mod; const float* bada;
    __device__ __forceinline__ void operator()(const f32x4 (&acc)[2][2][4][2], const Unit& u, int wr, int wc, int fr, int fq) const {
        const int row0 = u.pm * BM + wr * 64 + fr, col0 = u.pn * BM + wc * 32 + 8 * fq;
        const int b = (u.pm * BM) / 4096;
        f32x4 gv[2][2];
#pragma unroll
        for (int bj = 0; bj < 2; ++bj)
#pragma unroll
            for (int n = 0; n < 2; ++n) { const int c = col0 + bj * HALF + 4 * n; gv[bj][n] = *(const f32x4*)(mod + b * 12288 + 4096 + c) + *(const f32x4*)(bada + 4096 + c); }
#pragma unroll
        for (int ai = 0; ai < 2; ++ai)
#pragma unroll
            for (int m = 0; m < 4; ++m) { const size_t off = (size_t)(row0 + ai * HALF + m * 16) * 2048 + col0;
#pragma unroll
                for (int bj = 0; bj < 2; ++bj) {
                    const f32x4 x0 = *(const f32x4*)(x + off + bj * HALF), x1 = *(const f32x4*)(x + off + bj * HALF + 4);
                    const f32x4 r0 = x0 + gv[bj][0] * acc[ai][bj][m][0], r1 = x1 + gv[bj][1] * acc[ai][bj][m][1];
                    u32x4 w; w.x = pk2(r0.x, r0.y); w.y = pk2(r0.z, r0.w); w.z = pk2(r1.x, r1.y); w.w = pk2(r1.z, r1.w);
                    *(u32x4*)(out + off + bj * HALF) = w; } }
    }
};
struct EpiOutNorm {
    static constexpr bool PERM = true, AFTER_DRAIN = true;
    const float* x; bf16_t* x1b; bf16_t* h2; const float* mod; const float* bada; const float* gain; unsigned* xs; unsigned* cnt;
    __device__ __forceinline__ void fused(f32x4 (&acc)[2][2][4][2], const Unit& u, int wr, int wc, int fr, int fq, PG8_LAS unsigned char* lds, int wid, int lane) const {
        const int row0 = u.pm * BM + wr * 64 + fr, col0 = u.pn * BM + wc * 32 + 8 * fq;
        const int b = (u.pm * BM) / 4096, tid = wid * 64 + lane;
        PG8_LAS float* P = (PG8_LAS float*)lds;
        PG8_LAS float* SR = (PG8_LAS float*)(lds + 4096);
        f32x4 gv[2][2];
#pragma unroll
        for (int bj = 0; bj < 2; ++bj)
#pragma unroll
            for (int n = 0; n < 2; ++n) { const int c = col0 + bj * HALF + 4 * n; gv[bj][n] = *(const f32x4*)(mod + b * 12288 + 4096 + c) + *(const f32x4*)(bada + 4096 + c); }
#pragma unroll
        for (int ai = 0; ai < 2; ++ai) {
            f32x4 xv[4][2][2];
#pragma unroll
            for (int m = 0; m < 4; ++m) { const size_t off = (size_t)(row0 + ai * HALF + m * 16) * 2048 + col0;
#pragma unroll
                for (int bj = 0; bj < 2; ++bj) { xv[m][bj][0] = __builtin_nontemporal_load((const f32x4*)(x + off + bj * HALF)); xv[m][bj][1] = __builtin_nontemporal_load((const f32x4*)(x + off + bj * HALF + 4)); } }
            __builtin_amdgcn_sched_barrier(0);
#pragma unroll
            for (int m = 0; m < 4; ++m) { const size_t off = (size_t)(row0 + ai * HALF + m * 16) * 2048 + col0; float ss = 0.f;
#pragma unroll
                for (int bj = 0; bj < 2; ++bj) {
                    const f32x4 x0 = xv[m][bj][0], x1 = xv[m][bj][1];
                    const f32x4 r0 = x0 + gv[bj][0] * acc[ai][bj][m][0], r1 = x1 + gv[bj][1] * acc[ai][bj][m][1];
                    acc[ai][bj][m][0] = r0; acc[ai][bj][m][1] = r1;
                    ss += ((r0.x * r0.x + r0.y * r0.y) + (r0.z * r0.z + r0.w * r0.w)) + ((r1.x * r1.x + r1.y * r1.y) + (r1.z * r1.z + r1.w * r1.w));
                    u32x4 w; w.x = pk2(r0.x, r0.y); w.y = pk2(r0.z, r0.w); w.z = pk2(r1.x, r1.y); w.w = pk2(r1.z, r1.w);
                    __builtin_nontemporal_store(w, (u32x4*)(x1b + off + bj * HALF)); }
                ss += __shfl_xor(ss, 16); ss += __shfl_xor(ss, 32);
                if (fq == 0) P[(ai * HALF + wr * 64 + m * 16 + fr) * 4 + wc] = ss; }
        }
        asm volatile("s_waitcnt lgkmcnt(0)" ::: "memory"); __builtin_amdgcn_s_barrier(); asm volatile("" ::: "memory");
        if (tid < 256) { const float s = (P[tid * 4] + P[tid * 4 + 1]) + (P[tid * 4 + 2] + P[tid * 4 + 3]);
            __hip_atomic_store(xs + (size_t)(u.pm * 256 + tid) * 8 + u.pn, __float_as_uint(s), __ATOMIC_RELAXED, __HIP_MEMORY_SCOPE_AGENT); }
        asm volatile("s_waitcnt vmcnt(0)" ::: "memory");
        __syncthreads();
        if (tid == 0) {
            __hip_atomic_fetch_add(cnt + 64 * u.pm, 1u, __ATOMIC_RELAXED, __HIP_MEMORY_SCOPE_AGENT);
            unsigned sp = 0;
            while (__hip_atomic_load(cnt + 64 * u.pm, __ATOMIC_RELAXED, __HIP_MEMORY_SCOPE_AGENT) < 8u) { __builtin_amdgcn_s_sleep(2); if (++sp > (1u << 22)) break; }
            __builtin_amdgcn_fence(__ATOMIC_ACQUIRE, "agent");
        }
        asm volatile("s_waitcnt vmcnt(0) lgkmcnt(0)" ::: "memory"); __builtin_amdgcn_s_barrier(); asm volatile("" ::: "memory");
        if (tid < 256) { float s = 0.f;
#pragma unroll
            for (int t = 0; t < 8; ++t) s += __uint_as_float(__hip_atomic_load(xs + (size_t)(u.pm * 256 + tid) * 8 + t, __ATOMIC_RELAXED, __HIP_MEMORY_SCOPE_AGENT));
            SR[tid] = rsqrtf(s * (1.f / 2048.f) + 1e-6f); }
        asm volatile("s_waitcnt lgkmcnt(0)" ::: "memory"); __builtin_amdgcn_s_barrier(); asm volatile("" ::: "memory");
        f32x4 ga[2][2], sb[2][2];
#pragma unroll
        for (int bj = 0; bj < 2; ++bj)
#pragma unroll
            for (int n = 0; n < 2; ++n) { const int c = col0 + bj * HALF + 4 * n;
                ga[bj][n] = *(const f32x4*)(gain + c) * ((*(const f32x4*)(mod + b * 12288 + 8192 + c) + *(const f32x4*)(bada + 8192 + c)) + 1.f);
                sb[bj][n] = *(const f32x4*)(mod + b * 12288 + 6144 + c) + *(const f32x4*)(bada + 6144 + c); }
#pragma unroll
        for (int ai = 0; ai < 2; ++ai)
#pragma unroll
            for (int m = 0; m < 4; ++m) { const int rl = ai * HALF + wr * 64 + m * 16 + fr; const float rs = SR[rl]; const size_t off = (size_t)(u.pm * BM + rl) * 2048 + col0;
#pragma unroll
                for (int bj = 0; bj < 2; ++bj) { const f32x4 y0 = acc[ai][bj][m][0] * rs * ga[bj][0] + sb[bj][0], y1 = acc[ai][bj][m][1] * rs * ga[bj][1] + sb[bj][1];
                    u32x4 w; w.x = pk2(y0.x, y0.y); w.y = pk2(y0.z, y0.w); w.z = pk2(y1.x, y1.y); w.w = pk2(y1.z, y1.w);
                    *(u32x4*)(h2 + off + bj * HALF) = w; } }
    }
};
struct EpiLds {
    static constexpr bool PERM = true, AFTER_DRAIN = true;
    static constexpr int PITCH = 264;
    __device__ __forceinline__ void fused(f32x4 (&acc)[2][2][4][2], const Unit&, int wr, int wc, int fr, int fq, PG8_LAS unsigned char* lds, int, int) const {
#pragma unroll
        for (int ai = 0; ai < 2; ++ai)
#pragma unroll
            for (int m = 0; m < 4; ++m) { const int rl = ai * HALF + wr * 64 + m * 16 + fr;
#pragma unroll
                for (int bj = 0; bj < 2; ++bj) { const f32x4 r0 = acc[ai][bj][m][0], r1 = acc[ai][bj][m][1];
                    u32x4 w; w.x = pk2(r0.x, r0.y); w.y = pk2(r0.z, r0.w); w.z = pk2(r1.x, r1.y); w.w = pk2(r1.z, r1.w);
                    *(PG8_LAS u32x4*)(lds + (size_t)rl * (PITCH * 2) + (bj * HALF + wc * 32 + 8 * fq) * 2) = w; } }
    }
};
}

namespace att {
constexpr int QBLK = 32, KVBLK = 64, NT = TPB / KVBLK;
constexpr float SCALE = 0.125f, THR = 8.f;
constexpr int SHM_V = 16384, SHM_K = 16384, OFF_WS = 65536, OFF_X = 67584, XROW = 132;
#define KSWZ(row, colB) ((row) * 256 + ((colB) ^ (((row) & 7) << 4)))
__device__ __forceinline__ unsigned cvtpk(float lo, float hi) { unsigned r; asm volatile("v_cvt_pk_bf16_f32 %0, %1, %2" : "=v"(r) : "v"(lo), "v"(hi)); return r; }
constexpr float THRL = THR * 1.4426950408889634f;
__device__ __forceinline__ void partialSM(f32x16& p0, f32x16& p1, float& negm, bf16x8& qxb, float& l_reg, float& alpha, bool first) {
  float pmax, pmb = fmaxf(p0[8], p0[9]), pmc = fmaxf(p1[0], p1[1]), pmd = fmaxf(p1[8], p1[9]); pmax = fmaxf(p0[0], p0[1]);
#pragma unroll
  for (int r = 2; r < 8; ++r) { pmax = fmaxf(pmax, p0[r]); pmb = fmaxf(pmb, p0[8 + r]); pmc = fmaxf(pmc, p1[r]); pmd = fmaxf(pmd, p1[8 + r]); }
  pmax = fmaxf(fmaxf(pmax, pmb), fmaxf(pmc, pmd));
  { auto rr = __builtin_amdgcn_permlane32_swap(__float_as_uint(pmax), __float_as_uint(pmax), false, false);
    pmax = fmaxf(__uint_as_float(rr[0]), __uint_as_float(rr[1])); }
  if (__builtin_expect(!first && __all(pmax <= THRL), 1)) { alpha = 1.f; }
  else {
    const float d0 = first ? pmax : fmaxf(0.f, pmax);
    const unsigned nb = cvtpk(negm - d0, 0.f) & 0xffffu; const float nn = __uint_as_float(nb << 16), d = negm - nn;
    alpha = __builtin_amdgcn_exp2f(-d); negm = nn; l_reg *= alpha; { u32x4 w = {nb, 0u, 0u, 0u}; qxb = *reinterpret_cast<bf16x8*>(&w); }
#pragma unroll
    for (int r = 0; r < 16; ++r) { float t = p0[r]; asm volatile("v_sub_f32 %0, %0, %1" : "+v"(t) : "v"(d)); p0[r] = t; }
#pragma unroll
    for (int r = 0; r < 16; ++r) { float t = p1[r]; asm volatile("v_sub_f32 %0, %0, %1" : "+v"(t) : "v"(d)); p1[r] = t; }
  }
#pragma unroll
  for (int r = 0; r < 16; ++r) p0[r] = __builtin_amdgcn_exp2f(p0[r]);
}
__device__ __forceinline__ void finishSM(f32x16& p0, f32x16& p1, float& l_reg, bf16x8& pa0, bf16x8& pa1, bf16x8& pa2, bf16x8& pa3) {
#pragma unroll
  for (int r = 0; r < 16; ++r) p1[r] = __builtin_amdgcn_exp2f(p1[r]);
  float ps = p0[0], psb = p0[8], psc = p1[0], psd = p1[8];
#pragma unroll
  for (int r = 1; r < 8; ++r) { ps += p0[r]; psb += p0[8 + r]; psc += p1[r]; psd += p1[8 + r]; }
  ps = (ps + psb) + (psc + psd);
  { auto rr = __builtin_amdgcn_permlane32_swap(__float_as_uint(ps), __float_as_uint(ps), false, false);
    ps = __uint_as_float(rr[0]) + __uint_as_float(rr[1]); }
  l_reg += ps;
#define PK4(P, BASE, OUT) do { unsigned a0 = cvtpk(P[BASE + 0], P[BASE + 1]), a1 = cvtpk(P[BASE + 2], P[BASE + 3]);   \
    unsigned b0 = cvtpk(P[BASE + 4], P[BASE + 5]), b1 = cvtpk(P[BASE + 6], P[BASE + 7]);                              \
    auto r0 = __builtin_amdgcn_permlane32_swap(a0, b0, false, false); auto r1 = __builtin_amdgcn_permlane32_swap(a1, b1, false, false); \
    u32x4 w = {r0[0], r1[0], r0[1], r1[1]}; OUT = *reinterpret_cast<bf16x8*>(&w); } while (0)
  PK4(p0, 0, pa0); PK4(p0, 8, pa1); PK4(p1, 0, pa2); PK4(p1, 8, pa3);
#undef PK4
}
__device__ __forceinline__ void qkt(f32x16& p0, f32x16& p1, const char* Ks, const bf16x8* qr, int r32, int hi, int stb, bf16x8 koneb, bf16x8 qxb) {
  p0 = __builtin_amdgcn_mfma_f32_32x32x16_bf16(koneb, qxb, f32x16{}, 0, 0, 0); p1 = p0;
#pragma unroll
  for (int d0 = 0; d0 < 4; ++d0) { int cb = stb + (d0 * 16 + hi * 8) * 2;
    bf16x8 b0 = *reinterpret_cast<const bf16x8*>(Ks + KSWZ(r32, cb));
    bf16x8 b1 = *reinterpret_cast<const bf16x8*>(Ks + KSWZ(32 + r32, cb));
    p0 = __builtin_amdgcn_mfma_f32_32x32x16_bf16(b0, qr[d0], p0, 0, 0, 0);
    p1 = __builtin_amdgcn_mfma_f32_32x32x16_bf16(b1, qr[d0], p1, 0, 0, 0); }
}
__device__ __forceinline__ void pv_d0(f32x16* o, int vb, bf16x8 pa0, bf16x8 pa1, bf16x8 pa2, bf16x8 pa3) {
  pv_one<0>(o[0], vb, pa0, pa1, pa2, pa3); pv_one<1>(o[1], vb, pa0, pa1, pa2, pa3); pv_one<2>(o[2], vb, pa0, pa1, pa2, pa3); pv_one<3>(o[3], vb, pa0, pa1, pa2, pa3);
}
struct VSet { s16x4 l0, h0, l1, h1, l2, h2, l3, h3; };
template <int J> __device__ __forceinline__ void rv(VSet& s, int vb) {
  s.l0 = tr_read<v_rd_off(0, J, 0)>(vb); s.h0 = tr_read<v_rd_off(0, J, 1)>(vb); s.l1 = tr_read<v_rd_off(1, J, 0)>(vb); s.h1 = tr_read<v_rd_off(1, J, 1)>(vb);
  s.l2 = tr_read<v_rd_off(2, J, 0)>(vb); s.h2 = tr_read<v_rd_off(2, J, 1)>(vb); s.l3 = tr_read<v_rd_off(3, J, 0)>(vb); s.h3 = tr_read<v_rd_off(3, J, 1)>(vb);
}
__device__ __forceinline__ void xstep(f32x16* o, int vb, const VSet& A, const VSet& B, bf16x8 pa0, bf16x8 pa1, bf16x8 pa2, bf16x8 pa3, f32x16& p0, f32x16& p1, const char* Ks, const bf16x8* qr, int r32, int hi, int stb, bf16x8 koneb, bf16x8 qxb) {
#define PK(L, H) (bf16x8){L[0], L[1], L[2], L[3], H[0], H[1], H[2], H[3]}
#define MF(PA, S) do { o[0] = __builtin_amdgcn_mfma_f32_32x32x16_bf16(PK(S.l0, S.h0), PA, o[0], 0, 0, 0); o[1] = __builtin_amdgcn_mfma_f32_32x32x16_bf16(PK(S.l1, S.h1), PA, o[1], 0, 0, 0); \
                       o[2] = __builtin_amdgcn_mfma_f32_32x32x16_bf16(PK(S.l2, S.h2), PA, o[2], 0, 0, 0); o[3] = __builtin_amdgcn_mfma_f32_32x32x16_bf16(PK(S.l3, S.h3), PA, o[3], 0, 0, 0); } while (0)
#define LW(n) do { asm volatile("s_waitcnt lgkmcnt(" #n ")" ::: "memory"); SBAR(); } while (0)
#define KF(d0, rowoff) (*reinterpret_cast<const bf16x8*>(Ks + KSWZ((rowoff) + r32, stb + ((d0) * 16 + hi * 8) * 2)))
  VSet C, D;
  LW(8); MF(pa0, A); SBAR();
  rv<2>(C, vb);
  LW(8); MF(pa1, B); SBAR();
  rv<3>(D, vb);
  LW(8); MF(pa2, C); SBAR();
  const bf16x8 k00 = KF(0, 0), k01 = KF(0, 32), k10 = KF(1, 0), k11 = KF(1, 32);
  LW(4); MF(pa3, D); SBAR();
  const bf16x8 k20 = KF(2, 0), k21 = KF(2, 32), k30 = KF(3, 0), k31 = KF(3, 32);
  p0 = __builtin_amdgcn_mfma_f32_32x32x16_bf16(koneb, qxb, f32x16{}, 0, 0, 0); p1 = p0;
  p0 = __builtin_amdgcn_mfma_f32_32x32x16_bf16(k00, qr[0], p0, 0, 0, 0); p1 = __builtin_amdgcn_mfma_f32_32x32x16_bf16(k01, qr[0], p1, 0, 0, 0);
  p0 = __builtin_amdgcn_mfma_f32_32x32x16_bf16(k10, qr[1], p0, 0, 0, 0); p1 = __builtin_amdgcn_mfma_f32_32x32x16_bf16(k11, qr[1], p1, 0, 0, 0);
  p0 = __builtin_amdgcn_mfma_f32_32x32x16_bf16(k20, qr[2], p0, 0, 0, 0); p1 = __builtin_amdgcn_mfma_f32_32x32x16_bf16(k21, qr[2], p1, 0, 0, 0);
  p0 = __builtin_amdgcn_mfma_f32_32x32x16_bf16(k30, qr[3], p0, 0, 0, 0); p1 = __builtin_amdgcn_mfma_f32_32x32x16_bf16(k31, qr[3], p1, 0, 0, 0);
#undef PK
#undef MF
#undef LW
#undef KF
}
__device__ __forceinline__ void attn_unit(const bf16_t* __restrict__ parts, const bf16_t* __restrict__ khp, const bf16_t* __restrict__ vhp, bf16_t* __restrict__ mix, const float* __restrict__ subg, float lam, int b, int h, int qb, char* lds) {
  const int tid = threadIdx.x, wid = tid >> 6, lane = tid & 63, r32 = lane & 31, hi = lane >> 5;
  const int st = __builtin_amdgcn_readfirstlane(wid >> 2), rb = wid & 3;
  char* V_lds = lds; char* K_lds = lds + 2 * SHM_V;
  float* ws = (float*)(lds + OFF_WS) + wid * 64; float* li_l = ws; float* al_l = ws + 32;
  float negm = 0.f, l_reg = 0; f32x16 o[4] = {}; bf16x8 qr[4];
  bf16x8 koneb, qxb; { u32x4 w = {hi == 0 ? 0x3F80u : 0u, 0u, 0u, 0u}; koneb = *reinterpret_cast<bf16x8*>(&w); u32x4 z = {0u, 0u, 0u, 0u}; qxb = *reinterpret_cast<bf16x8*>(&z); }
  const bf16_t* Kh = khp + (size_t)(b * 8 + h) * TPB * 128;
  const bf16_t* Vh = vhp + (size_t)(b * 8 + h) * TPB * 128;
  const bf16_t* Qw = parts + ((size_t)b * TPB + CTX + qb * 128 + rb * QBLK + r32) * NIN + C_DQ + h * 128 + st * 64 + hi * 8;
#pragma unroll
  for (int d0 = 0; d0 < 4; ++d0) qr[d0] = *reinterpret_cast<const bf16x8*>(Qw + d0 * 16);
  const int stb = st * 128;
  const int sr = tid >> 4, sc = (tid & 15) * 8, vst0 = v_st(sr, sc), vst1 = v_st(32 + sr, sc);
  const int vb0 = (int)(uintptr_t)V_lds + v_rd_base(lane);
  bf16x8 vs0, vs1, ks0, ks1;
#define LOADV(k0) do { vs0 = *reinterpret_cast<const bf16x8*>(&Vh[(size_t)((k0) + sr) * 128 + sc]); vs1 = *reinterpret_cast<const bf16x8*>(&Vh[(size_t)((k0) + 32 + sr) * 128 + sc]); } while (0)
#define LOADK(k0) do { ks0 = *reinterpret_cast<const bf16x8*>(&Kh[(size_t)((k0) + sr) * 128 + sc]); ks1 = *reinterpret_cast<const bf16x8*>(&Kh[(size_t)((k0) + 32 + sr) * 128 + sc]); } while (0)
#define WRITEV(bb) do { *(bf16x8*)(V_lds + (bb) * SHM_V + vst0) = vs0; *(bf16x8*)(V_lds + (bb) * SHM_V + vst1) = vs1; } while (0)
#define WRITEK(bb) do { int kc = sc * 2; *(bf16x8*)(K_lds + (bb) * SHM_K + KSWZ(sr, kc)) = ks0; *(bf16x8*)(K_lds + (bb) * SHM_K + KSWZ(32 + sr, kc)) = ks1; } while (0)
#define VMW() asm volatile("s_waitcnt vmcnt(0)" ::: "memory")
#define RESC(a) do { if (__any((a) < 1.f)) { _Pragma("unroll") for (int d = 0; d < 4; ++d) _Pragma("unroll") for (int r = 0; r < 16; ++r) o[d][r] *= (a); } } while (0)
#define STAGE(k, VS) do { VMW(); WRITEV(1 - (VS)); WRITEK(VS);                                                                                  \
    const int tv = (k) + 2 < NT ? (k) + 2 : NT - 1, tk = (k) + 3 < NT ? (k) + 3 : NT - 1; LOADV(tv * KVBLK); LOADK(tk * KVBLK); } while (0)
#define BARR() do { SBAR(); __syncthreads(); SBAR(); } while (0)
#define PERIOD(k, VS, first) do {                                                                                                            \
    if (st == 1) STAGE(k, VS);                                                                                                               \
    { float al; partialSM(p0, p1, negm, qxb, l_reg, al, first); RESC(al); finishSM(p0, p1, l_reg, pa0, pa1, pa2, pa3); }                          \
    BARR();                                                                                                                                  \
    if (st == 0) STAGE(k, VS);                                                                                                               \
    VSet va, vb_; rv<0>(va, vb0 + (VS) * SHM_V); rv<1>(vb_, vb0 + (VS) * SHM_V); SBAR();                                                     \
    xstep(o, vb0 + (VS) * SHM_V, va, vb_, pa0, pa1, pa2, pa3, p0, p1, K_lds + (1 - (VS)) * SHM_K, qr, r32, hi, stb, koneb, qxb);    \
    BARR(); } while (0)
  f32x16 p0, p1; bf16x8 pa0, pa1, pa2, pa3;
  LOADV(0); LOADK(0); VMW(); WRITEV(0); WRITEK(0);
  LOADK(KVBLK); VMW(); WRITEK(1);
  LOADV(KVBLK); LOADK(2 * KVBLK);
  __syncthreads();
  if (st == 1) BARR();
  qkt(p0, p1, K_lds, qr, r32, hi, stb, koneb, qxb);
  BARR();
  PERIOD(0, 0, true); PERIOD(1, 1, false);
  for (int k = 2; k < NT; k += 2) { PERIOD(k, 0, false); PERIOD(k + 1, 1, false); }
  if (st == 0) BARR();
#undef PERIOD
#undef STAGE
#undef BARR
#undef LOADV
#undef LOADK
#undef WRITEV
#undef WRITEK
#undef VMW
  const float rl = __builtin_amdgcn_rcpf(l_reg);
  float* X = (float*)(lds + OFF_X) + (32 * rb + r32) * XROW + 4 * hi;
  if (st == 1) { const float sc2 = rl * lam;
#pragma unroll
    for (int d0 = 0; d0 < 4; ++d0)
#pragma unroll
      for (int g = 0; g < 4; ++g) *(f32x4*)(X + 32 * d0 + 8 * g) = (f32x4){o[d0][4 * g] * sc2, o[d0][4 * g + 1] * sc2, o[d0][4 * g + 2] * sc2, o[d0][4 * g + 3] * sc2};
  }
  __syncthreads();
  if (st == 0) {
    float ss = 0.f;
#pragma unroll
    for (int d0 = 0; d0 < 4; ++d0)
#pragma unroll
      for (int g = 0; g < 4; ++g) { const f32x4 x = *(const f32x4*)(X + 32 * d0 + 8 * g);
#pragma unroll
        for (int e = 0; e < 4; ++e) { const float v = o[d0][4 * g + e] * rl - x[e]; o[d0][4 * g + e] = v; ss += v * v; } }
    { auto rr = __builtin_amdgcn_permlane32_swap(__float_as_uint(ss), __float_as_uint(ss), false, false); ss = __uint_as_float(rr[0]) + __uint_as_float(rr[1]); }
    const float rs = rsqrtf(ss * (1.f / 128.f) + RMS_EPS) * 0.8f;
    const float* gp = subg + h * 128 + 4 * hi;
    bf16_t* mo = mix + ((size_t)b * SEQ + qb * 128 + rb * QBLK + r32) * D + 1024 + h * 128 + 8 * hi;
#pragma unroll
    for (int d0 = 0; d0 < 4; ++d0)
#pragma unroll
      for (int g = 0; g < 4; g += 2) {
        const f32x4 ga = *(const f32x4*)(gp + 32 * d0 + 8 * g) * rs, gb = *(const f32x4*)(gp + 32 * d0 + 8 * g + 8) * rs;
        unsigned a0 = pk2(o[d0][4 * g] * ga.x, o[d0][4 * g + 1] * ga.y), a1 = pk2(o[d0][4 * g + 2] * ga.z, o[d0][4 * g + 3] * ga.w);
        unsigned b0 = pk2(o[d0][4 * g + 4] * gb.x, o[d0][4 * g + 5] * gb.y), b1 = pk2(o[d0][4 * g + 6] * gb.z, o[d0][4 * g + 7] * gb.w);
        auto r0 = __builtin_amdgcn_permlane32_swap(a0, b0, false, false); auto r1 = __builtin_amdgcn_permlane32_swap(a1, b1, false, false);
        *(u32x4*)(mo + 32 * d0 + 8 * g) = (u32x4){r0[0], r1[0], r0[1], r1[1]};
      }
  }
  __syncthreads();
#undef RESC
}
}

namespace hg {
#define LBAR() do { asm volatile("s_waitcnt lgkmcnt(0)" ::: "memory"); __builtin_amdgcn_s_barrier(); asm volatile("" ::: "memory"); } while (0)
constexpr int O_V = 0, O_QR = 16384, O_KR = 33792, O_KT = 51200, O_PL = 69632, O_ST = 78848, O_TAB = 113664, O_RS = 119296;
constexpr int RQ = 272, RT = 144;

struct ChunkRaw { unsigned lf[8], q[8]; bf16x8 v0, v1; };
template <bool WITH_Q> __device__ __forceinline__ void elem_load(ChunkRaw& R, const bf16_t* __restrict__ parts, size_t r0, int h, int dir, int tid) {
    const int dkp = tid & 63, q8 = tid >> 6;
    const bf16_t* plf = parts + (r0 + 8 * q8) * NIN + (dir ? C_FB : C_FF) + h * 128 + 2 * dkp;
#pragma unroll
    for (int i = 0; i < 8; ++i) R.lf[i] = *(const unsigned*)(plf + (size_t)i * NIN);
    if (WITH_Q) { const bf16_t* pq = parts + (r0 + 8 * q8) * NIN + C_HQ + h * 128 + 2 * dkp;
#pragma unroll
        for (int i = 0; i < 8; ++i) R.q[i] = *(const unsigned*)(pq + (size_t)i * NIN); }
    const int sr = tid >> 4, scn = (tid & 15) * 8;
    R.v0 = *(const bf16x8*)(parts + (r0 + sr) * NIN + C_HI + h * 128 + scn); R.v1 = *(const bf16x8*)(parts + (r0 + 32 + sr) * NIN + C_HI + h * 128 + scn);
}
template <bool WITH_Q> __device__ __forceinline__ f32x2 elem_stage(const ChunkRaw& R, int dir, char* lds, int tid) {
    constexpr float L2E = 1.4426950408889634f;
    const int dkp = tid & 63, q8 = tid >> 6;
    f32x2 lfv[8], cum[8];
#pragma unroll
    for (int i = 0; i < 8; ++i) lfv[i] = (f32x2){__uint_as_float(R.lf[i] << 16), __uint_as_float(R.lf[i] & 0xffff0000u)};
    const int sr = tid >> 4, scn = (tid & 15) * 8;
    f32x2 run = {0.f, 0.f};
    if (dir == 0) {
#pragma unroll
        for (int i = 0; i < 8; ++i) { run += lfv[i]; cum[i] = run; }
    } else {
#pragma unroll
        for (int i = 7; i >= 0; --i) { run += lfv[i]; cum[i] = run; }
    }
    float* TAB = (float*)(lds + O_TAB);
    *(f32x2*)(TAB + q8 * 128 + 2 * dkp) = run;
    *(bf16x8*)(lds + O_V + v_st(sr, scn)) = R.v0; *(bf16x8*)(lds + O_V + v_st(32 + sr, scn)) = R.v1;
    LBAR();
    f32x2 sg[8];
#pragma unroll
    for (int j = 0; j < 8; ++j) sg[j] = *(const f32x2*)(TAB + j * 128 + 2 * dkp);
    const f32x2 lo4 = (sg[0] + sg[1]) + (sg[2] + sg[3]), hi4 = (sg[4] + sg[5]) + (sg[6] + sg[7]);
    const f32x2 total = lo4 + hi4;
    f32x2 off = {0.f, 0.f};
#pragma unroll
    for (int j = 0; j < 8; ++j) { const bool take = dir == 0 ? (j < q8) : (j > q8); if (take) off += sg[j]; }
    const f32x2 ref = dir == 0 ? lo4 : hi4;
    const f32x2 rmo = (ref - off) * L2E, omr = (off - ref) * L2E;
    unsigned kp[2][4];
#pragma unroll
    for (int i = 0; i < 8; i += 2) {
        f32x2 kk[2];
#pragma unroll
        for (int e = 0; e < 2; ++e) {
            const f32x2 a2 = lfv[i + e] * L2E, b2 = rmo - cum[i + e] * L2E;
            const f32x2 ea = {__builtin_amdgcn_exp2f(a2.x), __builtin_amdgcn_exp2f(a2.y)}, eb = {__builtin_amdgcn_exp2f(b2.x), __builtin_amdgcn_exp2f(b2.y)};
            kk[e] = (1.f - ea) * eb;
        }
        kp[0][i >> 1] = pk2(kk[0].x, kk[1].x); kp[1][i >> 1] = pk2(kk[0].y, kk[1].y);
        if (WITH_Q) {
#pragma unroll
            for (int e = 0; e < 2; ++e) { const int s = 8 * q8 + i + e;
                *(unsigned*)(lds + O_KR + s * RQ + dkp * 4) = pk2(kk[e].x, kk[e].y);
                const f32x2 c2 = cum[i + e] * L2E + omr;
                const f32x2 qv = (f32x2){__uint_as_float(R.q[i + e] << 16), __uint_as_float(R.q[i + e] & 0xffff0000u)} * (f32x2){__builtin_amdgcn_exp2f(c2.x), __builtin_amdgcn_exp2f(c2.y)};
                *(unsigned*)(lds + O_QR + s * RQ + dkp * 4) = pk2(qv.x, qv.y); }
        }
    }
    *(u32x4*)(lds + O_KT + (2 * dkp) * RT + q8 * 16) = (u32x4){kp[0][0], kp[0][1], kp[0][2], kp[0][3]};
    *(u32x4*)(lds + O_KT + (2 * dkp + 1) * RT + q8 * 16) = (u32x4){kp[1][0], kp[1][1], kp[1][2], kp[1][3]};
    if (q8 == 0) { *(f32x2*)(TAB + 1024 + 2 * dkp) = (f32x2){__expf(ref[0]), __expf(ref[1])}; *(f32x2*)(TAB + 1152 + 2 * dkp) = (f32x2){__expf(total[0]), __expf(total[1])};
                   *(f32x2*)(TAB + 1280 + 2 * dkp) = (f32x2){__expf(total[0] - ref[0]), __expf(total[1] - ref[1])}; }
    return total;
}
__device__ __forceinline__ void state_update(f32x16 (&S)[2], const char* lds, int mt, int nt0, int r32, int hi, int vb) {
    const float* TAB = (const float*)(lds + O_TAB);
    float el[16], er[16];
#pragma unroll
    for (int r = 0; r < 16; ++r) { const int d = 32 * mt + crow(r, hi); el[r] = TAB[1152 + d]; er[r] = TAB[1280 + d]; }
    bf16x8 kt[4];
#pragma unroll
    for (int ks = 0; ks < 4; ++ks) kt[ks] = *(const bf16x8*)(lds + O_KT + (32 * mt + r32) * RT + (16 * ks + 8 * hi) * 2);
#pragma unroll
    for (int t2 = 0; t2 < 2; ++t2) { f32x16 U = {}; pv_one<0>(U, vb + (nt0 + t2) * 512, kt[0], kt[1], kt[2], kt[3]);
#pragma unroll
        for (int r = 0; r < 16; ++r) S[t2][r] = el[r] * S[t2][r] + er[r] * U[r]; }
}
__device__ __forceinline__ void task_trans(const bf16_t* __restrict__ parts, float* __restrict__ hst, float* __restrict__ hd, int b, int h, int dir, int j, char* lds) {
    const int tid = threadIdx.x, wid = tid >> 6, lane = tid & 63, r32 = lane & 31, hi = lane >> 5, mt = wid >> 1, nt0 = 2 * (wid & 1);
    const int p0 = (j == 0) ? 0 : CTX + 256 * (dir == 0 ? j - 1 : 16 - j);
    const int vb = (int)(uintptr_t)(lds + O_V) + v_rd_base(lane);
    f32x16 S[2] = {}; f32x2 lsum = {0.f, 0.f};
    ChunkRaw R; elem_load<false>(R, parts, (size_t)b * TPB + p0 + 64 * (dir ? 3 : 0), h, dir, tid);
    for (int cc = 0; cc < 4; ++cc) {
        lsum += elem_stage<false>(R, dir, lds, tid);
        if (cc < 3) elem_load<false>(R, parts, (size_t)b * TPB + p0 + 64 * (dir ? 2 - cc : cc + 1), h, dir, tid);
        LBAR();
        state_update(S, lds, mt, nt0, r32, hi, vb);
        LBAR();
    }
    const int chain = (b * 8 + h) * 2 + dir;
    float* sp = hst + (size_t)(chain * 16 + j) * 16384;
#pragma unroll
    for (int t2 = 0; t2 < 2; ++t2)
#pragma unroll
        for (int r = 0; r < 16; ++r)
            __hip_atomic_store((unsigned*)&sp[(32 * mt + crow(r, hi)) * 128 + 32 * (nt0 + t2) + r32], __float_as_uint(S[t2][r]), __ATOMIC_RELAXED, __HIP_MEMORY_SCOPE_AGENT);
    if (tid < 64) { unsigned* hp = (unsigned*)(hd + (chain * 16 + j) * 128 + 2 * tid);
        __hip_atomic_store(hp, __float_as_uint(__expf(lsum[0])), __ATOMIC_RELAXED, __HIP_MEMORY_SCOPE_AGENT); __hip_atomic_store(hp + 1, __float_as_uint(__expf(lsum[1])), __ATOMIC_RELAXED, __HIP_MEMORY_SCOPE_AGENT); }
}
__device__ __forceinline__ void scan_phase(float* __restrict__ hst, const float* __restrict__ hd, int vcu, int G, int tid) {
    for (int idx = vcu * NTHR + tid; idx < 32 * 4096; idx += G * NTHR) {
        const int chain = idx >> 12, e4 = idx & 4095, dk = e4 >> 5;
        f32x4 S = {0.f, 0.f, 0.f, 0.f};
        float* p = hst + (size_t)chain * 16 * 16384 + e4 * 4;
        f32x4 u[16]; float d[16];
#pragma unroll
        for (int j = 0; j < 16; ++j) { u[j] = *(const f32x4*)(p + (size_t)j * 16384); d[j] = hd[(chain * 16 + j) * 128 + dk]; }
#pragma unroll
        for (int j = 0; j < 16; ++j) { S = S * d[j] + u[j]; *(f32x4*)(p + (size_t)j * 16384) = S; }
    }
}
__device__ __forceinline__ void task_out(const bf16_t* __restrict__ parts, bf16_t* __restrict__ mix, const float* __restrict__ hst, float* __restrict__ of, const float* __restrict__ ng,
                                         int b, int h, int sc, char* lds) {
    const int tid = threadIdx.x, wid = tid >> 6, lane = tid & 63, r32 = lane & 31, hi = lane >> 5;
    const int mt = wid >> 1, nt0 = 2 * (wid & 1), rt = wid >> 2, ct = wid & 3;
    const int vb = (int)(uintptr_t)(lds + O_V) + v_rd_base(lane);
    const float* TAB = (const float*)(lds + O_TAB);
    ChunkRaw R; elem_load<true>(R, parts, (size_t)b * TPB + CTX + 256 * sc, h, 0, tid);
    for (int dir = 0; dir < 2; ++dir) {
        const int chain = (b * 8 + h) * 2 + dir, jj = dir == 0 ? sc : 15 - sc;
        const float* sp = hst + (size_t)(chain * 16 + jj) * 16384;
        f32x16 S[2];
#pragma unroll
        for (int t2 = 0; t2 < 2; ++t2)
#pragma unroll
            for (int r = 0; r < 16; ++r) S[t2][r] = sp[(32 * mt + crow(r, hi)) * 128 + 32 * (nt0 + t2) + r32];
#pragma unroll
        for (int t2 = 0; t2 < 2; ++t2)
#pragma unroll
            for (int r = 0; r < 16; ++r) asm volatile("" : "+v"(S[t2][r]));
        for (int cc = 0; cc < 4; ++cc) {
            const int c = dir ? 3 - cc : cc;
            elem_stage<true>(R, dir, lds, tid);
            { const int step = dir * 4 + cc + 1;
              if (step < 8) { const int nd = step >> 2, nc = nd ? 3 - (step & 3) : (step & 3); elem_load<true>(R, parts, (size_t)b * TPB + CTX + 256 * sc + 64 * nc, h, nd, tid); } }
            float* ofp = of + ((((size_t)(b * 8 + h) * 16 + sc) * 4 + c) * 8 + wid) * 1024 + lane;
            LBAR();
            {
                float ef[16];
#pragma unroll
                for (int r = 0; r < 16; ++r) ef[r] = TAB[1024 + 32 * mt + crow(r, hi)];
#pragma unroll
                for (int t2 = 0; t2 < 2; ++t2)
#pragma unroll
                    for (int g = 0; g < 4; ++g) { u32x2 w; w.x = pk2(S[t2][4 * g] * ef[4 * g], S[t2][4 * g + 1] * ef[4 * g + 1]); w.y = pk2(S[t2][4 * g + 2] * ef[4 * g + 2], S[t2][4 * g + 3] * ef[4 * g + 3]);
                        *(u32x2*)(lds + O_ST + (32 * (nt0 + t2) + r32) * RQ + (32 * mt + 8 * g + 4 * hi) * 2) = w; }
            }
            if (wid < 4) {
                const int si = wid >> 1, ti = wid & 1;
                f32x16 P = {};
#pragma unroll
                for (int ks = 0; ks < 8; ++ks) {
                    const bf16x8 ka = *(const bf16x8*)(lds + O_KR + (32 * si + r32) * RQ + (16 * ks + 8 * hi) * 2);
                    const bf16x8 qb = *(const bf16x8*)(lds + O_QR + (32 * ti + r32) * RQ + (16 * ks + 8 * hi) * 2);
                    P = __builtin_amdgcn_mfma_f32_32x32x16_bf16(ka, qb, P, 0, 0, 0);
                }
                const int t = 32 * ti + r32;
#pragma unroll
                for (int g = 0; g < 4; ++g) {
                    float pv[4];
#pragma unroll
                    for (int e = 0; e < 4; ++e) { const int s = 32 * si + 8 * g + 4 * hi + e; const bool keep = dir == 0 ? (s <= t) : (s >= t); pv[e] = keep ? P[4 * g + e] : 0.f; }
                    u32x2 w; w.x = pk2(pv[0], pv[1]); w.y = pk2(pv[2], pv[3]);
                    *(u32x2*)(lds + O_PL + t * RT + (32 * si + 8 * g + 4 * hi) * 2) = w;
                }
            }
            LBAR();
            f32x16 o = {};
            {
                bf16x8 pa[4];
#pragma unroll
                for (int ks = 0; ks < 4; ++ks) pa[ks] = *(const bf16x8*)(lds + O_PL + (32 * rt + r32) * RT + (16 * ks + 8 * hi) * 2);
                pv_one<0>(o, vb + ct * 512, pa[0], pa[1], pa[2], pa[3]);
#pragma unroll
                for (int ks = 0; ks < 8; ++ks) {
                    const bf16x8 qa = *(const bf16x8*)(lds + O_QR + (32 * rt + r32) * RQ + (16 * ks + 8 * hi) * 2);
                    const bf16x8 sb = *(const bf16x8*)(lds + O_ST + (32 * ct + r32) * RQ + (16 * ks + 8 * hi) * 2);
                    o = __builtin_amdgcn_mfma_f32_32x32x16_bf16(qa, sb, o, 0, 0, 0);
                }
            }
            __builtin_amdgcn_sched_barrier(0);
            float ofv[16];
            if (dir == 1) {
#pragma unroll
                for (int r = 0; r < 16; ++r) ofv[r] = ofp[r * 64];
            }
            __builtin_amdgcn_sched_barrier(0);
            state_update(S, lds, mt, nt0, r32, hi, vb);
            if (dir == 0) {
#pragma unroll
                for (int r = 0; r < 16; ++r) ofp[r * 64] = o[r];
                LBAR();
            } else {
                float* OT = (float*)(lds + O_RS);
#pragma unroll
                for (int r = 0; r < 16; ++r) OT[(32 * rt + crow(r, hi)) * 132 + 32 * ct + r32] = o[r] + ofv[r];
                LBAR();
                const int row = tid >> 3, seg = tid & 7;
                f32x4 x[4]; float ss = 0.f;
#pragma unroll
                for (int q = 0; q < 4; ++q) { x[q] = *(const f32x4*)(OT + row * 132 + 16 * seg + 4 * q); ss += (x[q].x * x[q].x + x[q].y * x[q].y) + (x[q].z * x[q].z + x[q].w * x[q].w); }
                ss += __shfl_xor(ss, 1); ss += __shfl_xor(ss, 2); ss += __shfl_xor(ss, 4);
                const float rs = rsqrtf(ss * (1.f / 128.f) + RMS_EPS);
                const int trow = 256 * sc + 64 * c + row;
                const bf16_t* gp = parts + ((size_t)b * TPB + CTX + trow) * NIN + C_HG + h * 128 + 16 * seg;
                const u32x4 g0 = *(const u32x4*)gp, g1 = *(const u32x4*)(gp + 8);
                const float* ngp = ng + h * 128 + 16 * seg;
                const f32x4 n0 = *(const f32x4*)ngp * rs, n1 = *(const f32x4*)(ngp + 4) * rs, n2 = *(const f32x4*)(ngp + 8) * rs, n3 = *(const f32x4*)(ngp + 12) * rs;
                u32x4 w0, w1;
#define GLO(w) __uint_as_float((w) << 16)
#define GHI(w) __uint_as_float((w) & 0xffff0000u)
                w0.x = pk2(x[0].x * n0.x * GLO(g0.x), x[0].y * n0.y * GHI(g0.x)); w0.y = pk2(x[0].z * n0.z * GLO(g0.y), x[0].w * n0.w * GHI(g0.y));
                w0.z = pk2(x[1].x * n1.x * GLO(g0.z), x[1].y * n1.y * GHI(g0.z)); w0.w = pk2(x[1].z * n1.z * GLO(g0.w), x[1].w * n1.w * GHI(g0.w));
                w1.x = pk2(x[2].x * n2.x * GLO(g1.x), x[2].y * n2.y * GHI(g1.x)); w1.y = pk2(x[2].z * n2.z * GLO(g1.y), x[2].w * n2.w * GHI(g1.y));
                w1.z = pk2(x[3].x * n3.x * GLO(g1.z), x[3].y * n3.y * GHI(g1.z)); w1.w = pk2(x[3].z * n3.z * GLO(g1.w), x[3].w * n3.w * GHI(g1.w));
#undef GLO
#undef GHI
                bf16_t* mo = mix + ((size_t)(b * SEQ + trow)) * D + h * 128 + 16 * seg;
                *(u32x4*)mo = w0; *(u32x4*)(mo + 8) = w1;
            }
        }
    }
    LBAR();
}
#undef LBAR
}

namespace tk {
constexpr int LKP = 17;
__device__ __forceinline__ unsigned umax_(unsigned a, unsigned b) { return a > b ? a : b; }
__device__ __forceinline__ unsigned umin_(unsigned a, unsigned b) { return a < b ? a : b; }
__device__ __forceinline__ unsigned f2key(float s) { const unsigned b = __float_as_uint(s); return b ^ ((unsigned)((int)b >> 31) | 0x80000000u); }
__device__ __forceinline__ float key2f(unsigned k) { return __uint_as_float(k ^ (~(unsigned)((int)k >> 31) | 0x80000000u)); }
template <int N> __device__ __forceinline__ void sort_desc(unsigned (&a)[N]) {
#pragma unroll
    for (int k = 2; k <= N; k <<= 1)
#pragma unroll
        for (int j = k >> 1; j > 0; j >>= 1)
#pragma unroll
            for (int i = 0; i < N; ++i) { const int l = i ^ j; if (l > i) { const bool desc = ((i & k) == 0); const unsigned mx = umax_(a[i], a[l]), mn = umin_(a[i], a[l]); a[i] = desc ? mx : mn; a[l] = desc ? mn : mx; } }
}
__device__ __forceinline__ void merge16(unsigned (&a)[16], const unsigned (&b)[16]) {
#pragma unroll
    for (int i = 0; i < 16; ++i) a[i] = umax_(a[i], b[15 - i]);
#pragma unroll
    for (int j = 8; j > 0; j >>= 1)
#pragma unroll
        for (int i = 0; i < 16; ++i) { const int l = i ^ j; if (l > i) { const unsigned mx = umax_(a[i], a[l]), mn = umin_(a[i], a[l]); a[i] = mx; a[l] = mn; } }
}
__device__ __forceinline__ void task(const bf16_t* qbase  , int qpitch, const bf16_t* __restrict__ keys, int* __restrict__ idx, float* __restrict__ coef, int tb, int h, char* lds) {
    const int tid = threadIdx.x, wid = tid >> 6, lane = tid & 63, r32 = lane & 31, hi = lane >> 5;
    unsigned* LK = (unsigned*)lds;
    int* CT = (int*)(lds + 2 * 128 * LKP * 4);
    if (tid < 64) {
        const int cnt[16] = {16, 8, 5, 4, 3, 2, 2, 2, 1, 1, 1, 1, 1, 1, 1, 1};
        int a = 0, base = 0, found = 0, fa = 0, fb = 0;
#pragma unroll
        for (a = 0; a < 16; ++a) { const bool in = !found && tid < base + cnt[a]; fa = in ? a : fa; fb = in ? tid - base : fb; found |= in; base += cnt[a]; }
        CT[tid] = found ? (fa | (fb << 8) | 0x10000) : 0; }
    {
        const int tt = wid & 3, j = wid >> 2;
        bf16x8 qb[8];
        const bf16_t* qrow = qbase + (size_t)(32 * tt + r32) * qpitch + j * 128 + 8 * hi;
#pragma unroll
        for (int ks = 0; ks < 8; ++ks) qb[ks] = *(const bf16x8*)(qrow + 16 * ks);
        unsigned g[4][16];
        {
            bf16x8 ka[4][8];
#pragma unroll
            for (int kt = 0; kt < 4; ++kt) { const bf16_t* kp = keys + (size_t)((h * 2 + j) * 128 + 32 * kt + r32) * 128 + 8 * hi;
#pragma unroll
                for (int ks = 0; ks < 8; ++ks) ka[kt][ks] = *(const bf16x8*)(kp + 16 * ks); }
            __builtin_amdgcn_sched_barrier(0);
#pragma unroll
            for (int kt = 0; kt < 4; ++kt) {
                f32x16 acc = {};
#pragma unroll
                for (int ks = 0; ks < 8; ++ks) acc = __builtin_amdgcn_mfma_f32_32x32x16_bf16(ka[kt][ks], qb[ks], acc, 0, 0, 0);
#pragma unroll
                for (int r = 0; r < 16; ++r) g[kt][r] = (f2key(acc[r]) & ~127u) | (unsigned)(127 - 32 * kt - (r & 3) - 8 * (r >> 2) - 4 * hi);
            }
        }
#pragma unroll
        for (int kt = 0; kt < 4; ++kt) sort_desc<16>(g[kt]);
        merge16(g[0], g[1]); merge16(g[2], g[3]); merge16(g[0], g[2]);
        unsigned o[16];
#pragma unroll
        for (int i = 0; i < 16; ++i) o[i] = (unsigned)__shfl_xor((int)g[0][i], 32);
        merge16(g[0], o);
        if (hi == 0) {
#pragma unroll
            for (int i = 0; i < 16; ++i) LK[(j * 128 + 32 * tt + r32) * LKP + i] = g[0][i]; }
    }
    __syncthreads();
    {
        const int token = tid >> 2, q = tid & 3;
        const unsigned* k1 = LK + token * LKP; const unsigned* k2 = LK + (128 + token) * LKP;
        unsigned cand[16];
#pragma unroll
        for (int i = 0; i < 16; ++i) {
            const int ct = CT[16 * q + i]; const int a = ct & 255, b = (ct >> 8) & 255;
            const float v = key2f(k1[a] & ~127u) + key2f(k2[b] & ~127u);
            const unsigned ck_ = (f2key(v) & ~255u) | (unsigned)(255 - (a * 16 + b));
            cand[i] = (ct & 0x10000) ? ck_ : 0u;
        }
        sort_desc<16>(cand);
        unsigned o[16];
#pragma unroll
        for (int i = 0; i < 16; ++i) o[i] = (unsigned)__shfl_xor((int)cand[i], 1);
        merge16(cand, o);
#pragma unroll
        for (int i = 0; i < 16; ++i) o[i] = (unsigned)__shfl_xor((int)cand[i], 2);
        merge16(cand, o);
        float e[16], sum = 0.f; const float m = key2f(cand[0] & ~255u);
#pragma unroll
        for (int i = 0; i < 16; ++i) { e[i] = __expf(key2f(cand[i] & ~255u) - m); sum += e[i]; }
        const float inv = 1.f / sum;
        i32x4 oi; f32x4 oc;
#pragma unroll
        for (int kk = 0; kk < 4; ++kk) {
            const unsigned ck = q == 0 ? cand[kk] : q == 1 ? cand[4 + kk] : q == 2 ? cand[8 + kk] : cand[12 + kk];
            const float ek = q == 0 ? e[kk] : q == 1 ? e[4 + kk] : q == 2 ? e[8 + kk] : e[12 + kk];
            const int flat = 255 - (int)(ck & 255u);
            const int i1 = 127 - (int)(k1[flat >> 4] & 127u), i2 = 127 - (int)(k2[flat & 15] & 127u);
            oi[kk] = i1 * 128 + i2; oc[kk] = ek * inv;
        }
        const size_t ob = ((size_t)(tb * 128 + token) * 8 + h) * 16 + 4 * q;
        *(i32x4*)(idx + ob) = oi; *(f32x4*)(coef + ob) = oc;
    }
    __syncthreads();
}
}

namespace pe {
constexpr size_t CHB = (size_t)NEXP * 128;
static_assert(CHB == (1u << 21), "chunk stride");
constexpr size_t WS_UQ = WS_UBF, WS_VQ = WS_VBF, WS_SU = WS_SMALL + 65536, WS_SV = WS_SMALL + 131072;
__device__ __forceinline__ float gelu_erf(float v) {
    const float av = fabsf(v), t = __builtin_amdgcn_rcpf(av * 0.2316418882f + 1.0f);
    float q = t * 0.5307027145f + (-0.7265760135f); q = q * t + 0.7107068705f; q = q * t + (-0.142248368f); q = q * t + 0.127414796f; q = q * t;
    const float e = __builtin_amdgcn_exp2f((v * v) * (-0.72134752044f));
    const float m = v * (q * e);
    return v < 0.f ? m : v - m;
}
__device__ __forceinline__ float lo16(unsigned w) { return __uint_as_float(w << 16); }
__device__ __forceinline__ float hi16(unsigned w) { return __uint_as_float(w & 0xffff0000u); }
__device__ __forceinline__ void cvt_row(const float* __restrict__ src, unsigned char* __restrict__ q, float* __restrict__ scale, int row, int lane) {
    f32x4 x[8]; float am = 0.f;
#pragma unroll
    for (int j = 0; j < 8; ++j) { x[j] = __builtin_nontemporal_load((const f32x4*)(src + 256 * j + 4 * lane));        am = fmaxf(am, fmaxf(fmaxf(fabsf(x[j].x), fabsf(x[j].y)), fmaxf(fabsf(x[j].z), fabsf(x[j].w)))); }
#pragma unroll
    for (int o = 1; o < 64; o <<= 1) am = fmaxf(am, __shfl_xor(am, o));
    const float inv = am > 0.f ? 127.f / am : 0.f;
    if (lane == 0) scale[row] = am * (1.f / 127.f);
#pragma unroll
    for (int j = 0; j < 8; ++j) {
        const int q0 = (int)__builtin_rintf(x[j].x * inv), q1 = (int)__builtin_rintf(x[j].y * inv), q2 = (int)__builtin_rintf(x[j].z * inv), q3 = (int)__builtin_rintf(x[j].w * inv);
        const int w = (q0 & 255) | ((q1 & 255) << 8) | ((q2 & 255) << 16) | (int)((unsigned)q3 << 24);
        __builtin_nontemporal_store(w, (int*)(q + (size_t)(2 * j + (lane >> 5)) * CHB + (size_t)row * 128 + 4 * (lane & 31)));
    }
}
__device__ __forceinline__ void cvt_row4(const float* __restrict__ src, unsigned char* __restrict__ q, float* __restrict__ scale, int row, int lane) {
    f32x4 x[8]; float am = 0.f;
#pragma unroll
    for (int j = 0; j < 8; ++j) { x[j] = __builtin_nontemporal_load((const f32x4*)(src + 256 * j + 4 * lane));        am = fmaxf(am, fmaxf(fmaxf(fabsf(x[j].x), fabsf(x[j].y)), fmaxf(fabsf(x[j].z), fabsf(x[j].w)))); }
#pragma unroll
    for (int o = 1; o < 64; o <<= 1) am = fmaxf(am, __shfl_xor(am, o));
    const float inv = am > 0.f ? 6.f / am : 0.f;
    if (lane == 0) scale[row] = am * (1.f / 6.f);
#pragma unroll
    for (int j = 0; j < 8; ++j) {
        unsigned w = __builtin_amdgcn_cvt_scalef32_pk_fp4_f32(0u, x[j].x * inv, x[j].y * inv, 1.0f, 0);
        w = __builtin_amdgcn_cvt_scalef32_pk_fp4_f32(w, x[j].z * inv, x[j].w * inv, 1.0f, 1);
        __builtin_nontemporal_store((unsigned short)(w & 0xffffu), (unsigned short*)(q + (size_t)j * CHB + (size_t)row * 128 + 2 * lane));
    }
}
__device__ __forceinline__ void cvt_tables(const Args& a, int first, int stride, int lane) {
    for (int r = first; r < 2 * NEXP; r += stride) {
        if (r < NEXP) cvt_row(a.in[I_PU] + (size_t)r * D, a.ws + WS_UQ, (float*)(a.ws + WS_SU), r, lane);
        else cvt_row4(a.in[I_PV] + (size_t)(r - NEXP) * D, a.ws + WS_VQ, (float*)(a.ws + WS_SV), r - NEXP, lane);
    }
}
#define PE_DOT16(W, XQ, A) do { A = __builtin_amdgcn_sdot4((int)(W).x, (int)(XQ).x, A, false); A = __builtin_amdgcn_sdot4((int)(W).y, (int)(XQ).y, A, false); \
    A = __builtin_amdgcn_sdot4((int)(W).z, (int)(XQ).z, A, false); A = __builtin_amdgcn_sdot4((int)(W).w, (int)(XQ).w, A, false); } while (0)
#define PE_AX4(Wd, d, CF, Y) do { \
    Y[4 * (d) + 0] += __builtin_amdgcn_cvt_scalef32_pk_f32_fp4((Wd), 1.0f, 0) * CF; Y[4 * (d) + 1] += __builtin_amdgcn_cvt_scalef32_pk_f32_fp4((Wd), 1.0f, 1) * CF; \
    Y[4 * (d) + 2] += __builtin_amdgcn_cvt_scalef32_pk_f32_fp4((Wd), 1.0f, 2) * CF; Y[4 * (d) + 3] += __builtin_amdgcn_cvt_scalef32_pk_f32_fp4((Wd), 1.0f, 3) * CF; } while (0)
#define PE_AXPY32(W, CF, Y) do { PE_AX4((W).x, 0, CF, Y); PE_AX4((W).y, 1, CF, Y); PE_AX4((W).z, 2, CF, Y); PE_AX4((W).w, 3, CF, Y); } while (0)
#define PE_AX4I(Wd, d, CF, Y) do { \
    Y[4 * (d) + 0] = __builtin_amdgcn_cvt_scalef32_pk_f32_fp4((Wd), 1.0f, 0) * CF; Y[4 * (d) + 1] = __builtin_amdgcn_cvt_scalef32_pk_f32_fp4((Wd), 1.0f, 1) * CF; \
    Y[4 * (d) + 2] = __builtin_amdgcn_cvt_scalef32_pk_f32_fp4((Wd), 1.0f, 2) * CF; Y[4 * (d) + 3] = __builtin_amdgcn_cvt_scalef32_pk_f32_fp4((Wd), 1.0f, 3) * CF; } while (0)
#define PE_AXPY32I(W, CF, Y) do { PE_AX4I((W).x, 0, CF, Y); PE_AX4I((W).y, 1, CF, Y); PE_AX4I((W).z, 2, CF, Y); PE_AX4I((W).w, 3, CF, Y); } while (0)
__device__ __forceinline__ f32x2 shx2(f32x2 v, int m) { f32x2 r; r.x = __shfl_xor(v.x, m); r.y = __shfl_xor(v.y, m); return r; }
constexpr int TW = 4, PB = 4, PBU = 8;
__device__ __forceinline__ void wave_task(const Args& a, float* __restrict__ xbase, int t0, int lane, unsigned* __restrict__ ROW  , bf16_t* __restrict__ X2L  ) {
    const int g = lane >> 3, sub = lane & 7;
    const unsigned char* UQ = a.ws + WS_UQ; const unsigned char* VQ = a.ws + WS_VQ;
    const float* SU = (const float*)(a.ws + WS_SU); const float* SV = (const float*)(a.ws + WS_SV);
    const int* idx = (const int*)(a.ws + WS_IDX) + (size_t)t0 * 128; const float* coef = (const float*)(a.ws + WS_COEF) + (size_t)t0 * 128;
    const bf16_t* H2 = (const bf16_t*)(a.ws + WS_H) + (size_t)t0 * D;
    float acc[TW][16]; int iacc[TW][16]; u32x4 wv[PBU]; unsigned ro[PBU];
    const unsigned sub16 = 16u * sub;
#pragma unroll
    for (int tt = 0; tt < TW; ++tt) { ROW[tt * 128 + lane] = (unsigned)idx[tt * 128 + lane] * 128u; ROW[tt * 128 + 64 + lane] = (unsigned)idx[tt * 128 + 64 + lane] * 128u;
#pragma unroll
        for (int it = 0; it < 16; ++it) iacc[tt][it] = 0; }
#define ROFF(tt, e) (ROW[(tt) * 128 + 8 * (e) + g] + sub16)
    unsigned char* XQ = (unsigned char*)X2L; float sx[TW];
#pragma unroll
    for (int tt = 0; tt < TW; ++tt) {
        const bf16_t* hp = H2 + tt * D + 32 * lane; u32x4 r[4];
#pragma unroll
        for (int k = 0; k < 4; ++k) r[k] = *(const u32x4*)(hp + 8 * k);
        float v[32];
#pragma unroll
        for (int k = 0; k < 4; ++k) { v[8 * k] = lo16(r[k].x); v[8 * k + 1] = hi16(r[k].x); v[8 * k + 2] = lo16(r[k].y); v[8 * k + 3] = hi16(r[k].y); v[8 * k + 4] = lo16(r[k].z); v[8 * k + 5] = hi16(r[k].z); v[8 * k + 6] = lo16(r[k].w); v[8 * k + 7] = hi16(r[k].w); }
        float am = 0.f;
#pragma unroll
        for (int k = 0; k < 32; ++k) am = fmaxf(am, fabsf(v[k]));
#pragma unroll
        for (int o = 1; o < 64; o <<= 1) am = fmaxf(am, __shfl_xor(am, o));
        const float inv = am > 0.f ? 127.f / am : 0.f; sx[tt] = am * (1.f / 127.f);
        unsigned w[8];
#pragma unroll
        for (int k = 0; k < 8; ++k) { const int q0 = (int)__builtin_rintf(v[4 * k] * inv), q1 = (int)__builtin_rintf(v[4 * k + 1] * inv), q2 = (int)__builtin_rintf(v[4 * k + 2] * inv), q3 = (int)__builtin_rintf(v[4 * k + 3] * inv);
            w[k] = (unsigned)((q0 & 255) | ((q1 & 255) << 8) | ((q2 & 255) << 16)) | ((unsigned)q3 << 24); }
        *(u32x4*)(XQ + tt * 2048 + 32 * lane) = (u32x4){w[0], w[1], w[2], w[3]}; *(u32x4*)(XQ + tt * 2048 + 32 * lane + 16) = (u32x4){w[4], w[5], w[6], w[7]};
    }
    u32x4 wb[PBU];
#define UB_LOAD(W, tt, hb, coff) do { _Pragma("unroll") for (int i = 0; i < PBU; ++i) ro[i] = ROFF(tt, PBU * (hb) + i) + (coff);          \
        _Pragma("unroll") for (int i = 0; i < PBU; ++i) W[i] = *(const u32x4*)(UQ + (size_t)ro[i]); } while (0)
#define UB_DOT(W, tt, hb, XQV) do { _Pragma("unroll") for (int i = 0; i < PBU; ++i) PE_DOT16(W[i], XQV, iacc[tt][PBU * (hb) + i]); } while (0)
#define X_LOAD(XA, tt, c) do { XA = *(const u32x4*)(XQ + (tt) * 2048 + 128 * (c) + 16 * sub); } while (0)
#define U_TOKEN(tt, XA, XNA, ntt, nc, ncoff) do {                                                                                          \
        UB_LOAD(wb, tt, 1, coff); __builtin_amdgcn_sched_barrier(0); UB_DOT(wv, tt, 0, XA); __builtin_amdgcn_sched_barrier(0);                \
        UB_LOAD(wv, ntt, 0, ncoff); X_LOAD(XNA, ntt, nc); __builtin_amdgcn_sched_barrier(0); UB_DOT(wb, tt, 1, XA); __builtin_amdgcn_sched_barrier(0); } while (0)
    static_assert(PBU == 8 && TW == 4, "the pipelined U phase is written for 2 batches per token and 4 tokens per wave");
    { u32x4 xa0, xa1;
      UB_LOAD(wv, 0, 0, 0u); X_LOAD(xa0, 0, 0);
#pragma nounroll
      for (int c = 0; c < 16; ++c) {
        const unsigned coff = (unsigned)c << 21;
        const int cn = c < 15 ? c + 1 : 15; const unsigned coffn = (unsigned)cn << 21;
        U_TOKEN(0, xa0, xa1, 1, c, coff);
        U_TOKEN(1, xa1, xa0, 2, c, coff);
        U_TOKEN(2, xa0, xa1, 3, c, coff);
        U_TOKEN(3, xa1, xa0, 0, cn, coffn);
      } }
#undef U_TOKEN
#undef X_LOAD
#undef UB_DOT
#undef UB_LOAD
#pragma unroll
    for (int tt = 0; tt < TW; ++tt)
#pragma unroll
        for (int it = 0; it < 16; ++it) {
            int di = iacc[tt][it]; di += __shfl_xor(di, 1); di += __shfl_xor(di, 2); di += __shfl_xor(di, 4);
            const unsigned row = ROW[tt * 128 + 8 * it + g] >> 7;
            acc[tt][it] = coef[tt * 128 + 8 * it + g] * gelu_erf((float)di * (SU[row] * sx[tt])) * SV[row];
        }
    const int b = t0 / SEQ;
    const float* mod = (const float*)(a.ws + WS_MOD) + b * NMOD + 5 * D; const float* bada = a.in[I_BADA] + 5 * D; const float* fg = a.in[I_FNG];
    float* xo = xbase + (size_t)t0 * D; const bf16_t* X1 = (const bf16_t*)(a.ws + WS_X1B) + (size_t)t0 * D;
    const int cown = 32 * sub + ((lane >> 5) & 1) * 16 + ((lane >> 4) & 1) * 8 + ((lane >> 3) & 1) * 4;
    float ssq[TW];
#pragma unroll
    for (int tt = 0; tt < TW; ++tt) ssq[tt] = 0.f;
#define VB_LOAD(W, tt, hb, coff) do { _Pragma("unroll") for (int i = 0; i < PB; ++i) ro[i] = ROFF(tt, PB * (hb) + i) + (coff);             \
        _Pragma("unroll") for (int i = 0; i < PB; ++i) W[i] = *(const u32x4*)(VQ + (size_t)ro[i]); } while (0)
#define VB_AXPY(W, tt, hb) do { _Pragma("unroll") for (int i = 0; i < PB; ++i) { const float cf = acc[tt][PB * (hb) + i]; if ((hb) == 0 && i == 0) PE_AXPY32I(W[i], cf, y); else PE_AXPY32(W[i], cf, y); } } while (0)
    static_assert(PB == 4, "the pipelined V phase is written for 4 batches of 4 row pieces per token");
    VB_LOAD(wv, 0, 0, 0u);
#pragma nounroll
    for (int c = 0; c < 8; ++c) {
        const unsigned coff = (unsigned)c << 21;
        const unsigned coffn = (unsigned)(c < 7 ? c + 1 : 7) << 21;
        const int col = 256 * c + cown;
        u32x2 x1w[TW];
#pragma unroll
        for (int tt = 0; tt < TW; ++tt) x1w[tt] = *(const u32x2*)(X1 + tt * D + col);
        const f32x4 g2 = *(const f32x4*)(mod + col) + *(const f32x4*)(bada + col);
#pragma unroll
        for (int tt = 0; tt < TW; ++tt) {
            f32x2 y[16];
            VB_LOAD(wb, tt, 1, coff); __builtin_amdgcn_sched_barrier(0); VB_AXPY(wv, tt, 0); __builtin_amdgcn_sched_barrier(0);
            VB_LOAD(wv, tt, 2, coff); __builtin_amdgcn_sched_barrier(0); VB_AXPY(wb, tt, 1); __builtin_amdgcn_sched_barrier(0);
            VB_LOAD(wb, tt, 3, coff); __builtin_amdgcn_sched_barrier(0); VB_AXPY(wv, tt, 2); __builtin_amdgcn_sched_barrier(0);
            if (tt + 1 < TW) VB_LOAD(wv, tt + 1, 0, coff); else VB_LOAD(wv, 0, 0, coffn);
            __builtin_amdgcn_sched_barrier(0); VB_AXPY(wb, tt, 3); __builtin_amdgcn_sched_barrier(0);
#pragma unroll
            for (int i = 0; i < 8; ++i) {
                auto sx_ = __builtin_amdgcn_permlane32_swap(__float_as_uint(y[i].x), __float_as_uint(y[i + 8].x), false, false); auto sy_ = __builtin_amdgcn_permlane32_swap(__float_as_uint(y[i].y), __float_as_uint(y[i + 8].y), false, false);
                y[i] = (f32x2){__uint_as_float(sx_[0]), __uint_as_float(sy_[0])} + (f32x2){__uint_as_float(sx_[1]), __uint_as_float(sy_[1])}; }
#pragma unroll
            for (int i = 0; i < 4; ++i) {
                auto sx_ = __builtin_amdgcn_permlane16_swap(__float_as_uint(y[i].x), __float_as_uint(y[i + 4].x), false, false); auto sy_ = __builtin_amdgcn_permlane16_swap(__float_as_uint(y[i].y), __float_as_uint(y[i + 4].y), false, false);
                y[i] = (f32x2){__uint_as_float(sx_[0]), __uint_as_float(sy_[0])} + (f32x2){__uint_as_float(sx_[1]), __uint_as_float(sy_[1])}; }
#pragma unroll
            for (int i = 0; i < 2; ++i) { const f32x2 snd = (lane & 8) ? y[i] : y[i + 2]; const f32x2 kp = (lane & 8) ? y[i + 2] : y[i]; y[i] = kp + shx2(snd, 8); }
            const f32x4 x1 = {__uint_as_float(x1w[tt].x << 16), __uint_as_float(x1w[tt].x & 0xffff0000u), __uint_as_float(x1w[tt].y << 16), __uint_as_float(x1w[tt].y & 0xffff0000u)};
            const f32x4 v = x1 + g2 * (f32x4){y[0].x, y[0].y, y[1].x, y[1].y};
            ssq[tt] += (v.x * v.x + v.y * v.y) + (v.z * v.z + v.w * v.w);
            { u32x2 w; w.x = pk2(v.x, v.y); w.y = pk2(v.z, v.w); *(u32x2*)(X2L + tt * D + col) = w; }
        }
    }
#undef VB_AXPY
#undef VB_LOAD
    float rstd[TW];
#pragma unroll
    for (int tt = 0; tt < TW; ++tt) rstd[tt] = rsqrtf(wave_sum(ssq[tt]) * (1.f / D) + RMS_EPS);
#pragma nounroll
    for (int c = 0; c < 8; ++c) {
        const int col = 256 * c + cown; const f32x4 gg = *(const f32x4*)(fg + col);
#pragma unroll
        for (int tt = 0; tt < TW; ++tt) { const u32x2 w = *(const u32x2*)(X2L + tt * D + col);
            const f32x4 v = {__uint_as_float(w.x << 16), __uint_as_float(w.x & 0xffff0000u), __uint_as_float(w.y << 16), __uint_as_float(w.y & 0xffff0000u)};
            __builtin_nontemporal_store(v * rstd[tt] * gg, (f32x4*)(xo + tt * D + col)); }
    }
#undef ROFF
}
}

__global__ void __launch_bounds__(NTHR, 2) fwd_kernel(Args a) {
    extern __shared__ __attribute__((aligned(16))) unsigned char lds[];
    const int tid = threadIdx.x, lane = tid & 63, wave = __builtin_amdgcn_readfirstlane(tid >> 6);
    const int G = gridDim.x, bx = blockIdx.x, vcu = (G % 8 == 0) ? (bx % 8) * (G / 8) + bx / 8 : bx;
    unsigned char* ws = a.ws;
    const int lo = a.ph_lo, hi_ = a.ph_hi;
#if ONE_LAUNCH && SYNC_XCD
    volatile LAS unsigned* bst = (volatile LAS unsigned*)((LAS unsigned char*)lds + LDS_BYTES - 16);
    if (tid < 4) bst[tid] = 0u;
    __syncthreads();
    const XcdBarrier bar = xcd_barrier_post((unsigned*)(ws + WS_CTL) + 1024, bst);
#define SEAM(k) do { if (lo <= (k) && (k) + 1 < hi_) xcd_barrier(bar); } while (0)
#define SEAM_ALWAYS() xcd_barrier(bar)
#elif ONE_LAUNCH
    cg::grid_group grid = cg::this_grid();
#define SEAM(k) do { if (lo <= (k) && (k) + 1 < hi_) grid.sync(); } while (0)
#define SEAM_ALWAYS() grid.sync()
#else
#define SEAM(k) do { } while (0)
#define SEAM_ALWAYS() do { } while (0)
#endif
#ifndef PHASE_MASK
#define PHASE_MASK 0x7ff
#endif
#define IN(k) ((((PHASE_MASK) >> (k)) & 1) && lo <= (k) && (k) < hi_)
    bf16_t* PARTS = (bf16_t*)(ws + WS_PARTS); bf16_t* MIX = (bf16_t*)(ws + WS_MIX);
    const float* sm = (const float*)(ws + WS_SMALL);
#ifndef REPEAT_MASK
#define REPEAT_MASK 0
#endif
#define NREP(k) ((((REPEAT_MASK) >> (k)) & 1) ? 2 : 1)
#define RSEAM(k, rep) do { if ((rep) + 1 < NREP(k)) { SEAM_ALWAYS(); } else { SEAM(k); } } while (0)
    if (IN(0)) {
        p0_prologue(a, lds, vcu, G, tid, lane, wave);
        if (tid == 0) { unsigned* mc = (unsigned*)(ws + WS_CTL) + 12288; unsigned sp = 0;
            while (__hip_atomic_load(mc, __ATOMIC_RELAXED, __HIP_MEMORY_SCOPE_AGENT) < (G < 192 ? (unsigned)G : 192u)) { __builtin_amdgcn_s_sleep(2); if (++sp > (1u << 22)) break; }
            __builtin_amdgcn_fence(__ATOMIC_ACQUIRE, "agent"); }
        asm volatile("s_waitcnt vmcnt(0)" ::: "memory"); __syncthreads();
        norm_phase<0>(a, vcu, G, lane, wave);
        SEAM(0);
    }
    if (IN(2)) for (int rep = 0; rep < NREP(2); ++rep) {
        pg8::Gemm g{(const bf16_t*)(ws + WS_H), (const bf16_t*)(ws + WS_WIN), M1, NIN, D};
        pg8::OrderIn S{G, bx};
        pg8::EpiIn E{PARTS, sm, sm + 4096, sm + 5120, (bf16_t*)(ws + WS_KH), (bf16_t*)(ws + WS_VH)};
        pg8::gemm_phase<pg8::EpiIn, pg8::OrderIn, true, true>((LAS unsigned char*)lds, g, S, E);
        if (G == 256) { if (bx >= 40) pe::cvt_tables(a, (bx - 40) * NWAVES + wave, 216 * NWAVES, lane); }
        else pe::cvt_tables(a, bx * NWAVES + wave, G * NWAVES, lane);
        RSEAM(2, rep);
    }
#define MERGED345 (ONE_LAUNCH && ((REPEAT_MASK) & 0x38) == 0 && (PHASE_MASK) == 0x7ff)
#if MERGED345
    if (lo <= 3 && 5 < hi_) {
        unsigned* const c1 = (unsigned*)(ws + WS_CTL) + 12352; unsigned* const c2 = (unsigned*)(ws + WS_CTL) + 12416;
        const float lam = sm[2048];
        for (int u = vcu; u < 512; u += G) { const int chain = u >> 4, j = u & 15; hg::task_trans(PARTS, (float*)(ws + WS_HST), (float*)(ws + WS_HD), chain >> 4, (chain >> 1) & 7, chain & 1, j, (char*)lds); }
        asm volatile("s_waitcnt vmcnt(0)" ::: "memory"); __syncthreads();
        if (tid == 0) __hip_atomic_fetch_add(c1, 1u, __ATOMIC_RELAXED, __HIP_MEMORY_SCOPE_AGENT);
        for (int u = vcu; u < 256; u += G) { const int bh = (u >> 5); att::attn_unit(PARTS, (const bf16_t*)(ws + WS_KH), (const bf16_t*)(ws + WS_VH), MIX, a.in[I_SUBG], lam, bh >> 3, bh & 7, u & 31, (char*)lds); }
        if (tid == 0) { unsigned sp = 0;
            while (__hip_atomic_load(c1, __ATOMIC_RELAXED, __HIP_MEMORY_SCOPE_AGENT) < (unsigned)G) { __builtin_amdgcn_s_sleep(2); if (++sp > (1u << 22)) break; }
            __builtin_amdgcn_fence(__ATOMIC_ACQUIRE, "agent"); }
        asm volatile("s_waitcnt vmcnt(0) lgkmcnt(0)" ::: "memory"); __syncthreads();
        hg::scan_phase((float*)(ws + WS_HST), (const float*)(ws + WS_HD), vcu, G, tid);
        asm volatile("s_waitcnt vmcnt(0)" ::: "memory"); __syncthreads();
#if SYNC_XCD
        if (tid == 0) {
            const unsigned nloc = bst[0] ? bst[0] : 1u;
            const unsigned old = __hip_atomic_fetch_add((unsigned*)(ws + WS_CTL) + 16704 + 64 * bar.x, 1u, __ATOMIC_RELAXED, __HIP_MEMORY_SCOPE_AGENT);
            if (old + 1u == nloc) { __builtin_amdgcn_fence(__ATOMIC_RELEASE, "agent"); asm volatile("s_waitcnt vmcnt(0)" ::: "memory");
                __hip_atomic_fetch_add(c2, nloc, __ATOMIC_RELAXED, __HIP_MEMORY_SCOPE_AGENT); } }
#else
        if (tid == 0) { __builtin_amdgcn_fence(__ATOMIC_RELEASE, "agent"); asm volatile("s_waitcnt vmcnt(0)" ::: "memory");
            __hip_atomic_fetch_add(c2, 1u, __ATOMIC_RELAXED, __HIP_MEMORY_SCOPE_AGENT); }
#endif
        for (int u = vcu; u < 256; u += G) { const int bh = (u >> 5) + 8; att::attn_unit(PARTS, (const bf16_t*)(ws + WS_KH), (const bf16_t*)(ws + WS_VH), MIX, a.in[I_SUBG], lam, bh >> 3, bh & 7, u & 31, (char*)lds); }
        if (tid == 0) { unsigned sp = 0;
            while (__hip_atomic_load(c2, __ATOMIC_RELAXED, __HIP_MEMORY_SCOPE_AGENT) < (unsigned)G) { __builtin_amdgcn_s_sleep(2); if (++sp > (1u << 22)) break; }
            __builtin_amdgcn_fence(__ATOMIC_ACQUIRE, "agent"); }
        asm volatile("s_waitcnt vmcnt(0) lgkmcnt(0)" ::: "memory"); __syncthreads();
        for (int u = vcu; u < 256; u += G) hg::task_out(PARTS, MIX, (const float*)(ws + WS_HST), (float*)(ws + WS_OF), a.in[I_HGNG], u >> 7, (u >> 4) & 7, u & 15, (char*)lds);
        SEAM(5);
    }
#else
    if (IN(3)) for (int rep = 0; rep < NREP(3); ++rep) {
        { const float lam = sm[2048];
          for (int u = vcu; u < 256; u += G) { const int bh = (u >> 5); att::attn_unit(PARTS, (const bf16_t*)(ws + WS_KH), (const bf16_t*)(ws + WS_VH), MIX, a.in[I_SUBG], lam, bh >> 3, bh & 7, u & 31, (char*)lds); } }
        for (int u = vcu; u < 512; u += G) { const int chain = u >> 4, j = u & 15; hg::task_trans(PARTS, (float*)(ws + WS_HST), (float*)(ws + WS_HD), chain >> 4, (chain >> 1) & 7, chain & 1, j, (char*)lds); }
#if ONE_LAUNCH
        if (rep + 1 < NREP(3)) { SEAM_ALWAYS(); }
        else if (lo <= 3 && 4 < hi_) {
            asm volatile("s_waitcnt vmcnt(0)" ::: "memory"); __syncthreads();
            if (tid == 0) __hip_atomic_fetch_add((unsigned*)(ws + WS_CTL) + 12352, 1u, __ATOMIC_RELAXED, __HIP_MEMORY_SCOPE_AGENT);
        }
#else
        RSEAM(3, rep);
#endif
    }
    if (IN(4)) for (int rep = 0; rep < NREP(4); ++rep) {
        { const float lam = sm[2048];
          for (int u = vcu; u < 256; u += G) { const int bh = (u >> 5) + 8; att::attn_unit(PARTS, (const bf16_t*)(ws + WS_KH), (const bf16_t*)(ws + WS_VH), MIX, a.in[I_SUBG], lam, bh >> 3, bh & 7, u & 31, (char*)lds); } }
#if ONE_LAUNCH
        if (rep == 0 && lo <= 3) {
            if (tid == 0) { unsigned* tc = (unsigned*)(ws + WS_CTL) + 12352; unsigned sp = 0;
                while (__hip_atomic_load(tc, __ATOMIC_RELAXED, __HIP_MEMORY_SCOPE_AGENT) < (unsigned)G) { __builtin_amdgcn_s_sleep(2); if (++sp > (1u << 22)) break; }
                __builtin_amdgcn_fence(__ATOMIC_ACQUIRE, "agent"); }
            asm volatile("s_waitcnt vmcnt(0) lgkmcnt(0)" ::: "memory"); __syncthreads();
        }
#endif
        if (rep == 0) hg::scan_phase((float*)(ws + WS_HST), (const float*)(ws + WS_HD), vcu, G, tid);
        RSEAM(4, rep);
    }
    if (IN(5)) for (int rep = 0; rep < NREP(5); ++rep) {
        for (int u = vcu; u < 256; u += G) hg::task_out(PARTS, MIX, (const float*)(ws + WS_HST), (float*)(ws + WS_OF), a.in[I_HGNG], u >> 7, (u >> 4) & 7, u & 15, (char*)lds);
        RSEAM(5, rep);
    }
#endif
    if (IN(6)) for (int rep = 0; rep < NREP(6); ++rep) {
        pg8::Gemm g{MIX, (const bf16_t*)(ws + WS_WOUT), ML, D, D};
        pg8::StaticOrder S; S.init(ML, D, G, bx);
        if (G == 256) {
            pg8::EpiOutNorm E{a.in[I_X], (bf16_t*)(ws + WS_X1B), (bf16_t*)(ws + WS_H), (const float*)(ws + WS_MOD), a.in[I_BADA], a.in[I_N2G], (unsigned*)(ws + WS_HD + 512 * 1024), (unsigned*)(ws + WS_CTL) + 8192};
            pg8::gemm_phase<pg8::EpiOutNorm, pg8::StaticOrder, false, true>((LAS unsigned char*)lds, g, S, E);
        } else {
            pg8::EpiOut E{a.in[I_X], (bf16_t*)(ws + WS_X1B), (const float*)(ws + WS_MOD), a.in[I_BADA]};
            pg8::gemm_phase<pg8::EpiOut, pg8::StaticOrder, true, true>((LAS unsigned char*)lds, g, S, E);
        }
        RSEAM(6, rep);
    }
    if (IN(7) && G != 256) for (int rep = 0; rep < NREP(7); ++rep) { norm_phase<1>(a, vcu, G, lane, wave); RSEAM(7, rep); }
    if (IN(8)) for (int rep = 0; rep < NREP(8); ++rep) {
        pg8::Gemm g{(const bf16_t*)(ws + WS_H), (const bf16_t*)(ws + WS_WQ), ML, D, D};
        pg8::StaticOrder S; S.init(ML, D, G, bx);
        if (G == 256) {
            pg8::EpiLds E{};
            pg8::gemm_phase<pg8::EpiLds, pg8::StaticOrder, false, true>((LAS unsigned char*)lds, g, S, E);
            asm volatile("s_waitcnt lgkmcnt(0)" ::: "memory"); __syncthreads();
            pg8::Unit uu; S.next(0, uu);
            for (int hb = 0; hb < 2; ++hb)
                tk::task((const bf16_t*)lds + hb * 128 * pg8::EpiLds::PITCH, pg8::EpiLds::PITCH, (const bf16_t*)(ws + WS_SMALL + 512 * 1024), (int*)(ws + WS_IDX), (float*)(ws + WS_COEF), 2 * uu.pm + hb, uu.pn, (char*)lds + 256 * pg8::EpiLds::PITCH * 2);
        } else {
            pg8::EpiBf16<0> E{(bf16_t*)(ws + WS_QP), D, nullptr, 0, 0, 1.f};
            pg8::gemm_phase<pg8::EpiBf16<0>, pg8::StaticOrder, true, true>((LAS unsigned char*)lds, g, S, E);
            asm volatile("s_waitcnt vmcnt(0)" ::: "memory"); __syncthreads();
            pg8::Unit uu; for (int i = 0; S.next(i, uu); ++i) for (int hb = 0; hb < 2; ++hb)
                tk::task((const bf16_t*)(ws + WS_QP) + (size_t)((2 * uu.pm + hb) * 128) * D + uu.pn * 256, D, (const bf16_t*)(ws + WS_SMALL + 512 * 1024), (int*)(ws + WS_IDX), (float*)(ws + WS_COEF), 2 * uu.pm + hb, uu.pn, (char*)lds);
        }
        RSEAM(8, rep);
    }
    if (IN(10)) for (int rep = 0; rep < NREP(10); ++rep) {
        const int gw = vcu * NWAVES + wave, NGW = G * NWAVES;
        float* xb = (rep + 1 < NREP(10)) ? (float*)(ws + WS_PARTS + 32 * MiB) : a.out;
        for (int t4 = gw; t4 < ML / pe::TW; t4 += NGW) pe::wave_task(a, xb, pe::TW * t4, lane, (unsigned*)lds + wave * (pe::TW * 128), (bf16_t*)(lds + 16384) + wave * (pe::TW * D));
        if (rep + 1 < NREP(10)) SEAM_ALWAYS();
    }
#undef IN
#undef SEAM
#undef SEAM_ALWAYS
}

constexpr int N_PHASES = 11;
extern "C" void kernel_launch(void* const* d_in, const int* in_sizes, int n_in, void* d_out, int out_size, void* d_ws, size_t ws_size, hipStream_t stream) {
    static int grid = 0;
    if (grid == 0) {
        if (n_in != 22 || out_size != ML * D || ws_size < WS_END) { fprintf(stderr, "kernel_launch: unexpected shapes (n_in %d out %d ws %zu, need ws >= %zu); nothing launched\n", n_in, out_size, ws_size, (size_t)WS_END); grid = -1; return; }
        int dev = 0, cus = 0, per_cu = 0;
        if (hipGetDevice(&dev) != hipSuccess || hipDeviceGetAttribute(&cus, hipDeviceAttributeMultiprocessorCount, dev) != hipSuccess) { fprintf(stderr, "kernel_launch: device query failed\n"); grid = -1; return; }
        if (hipFuncSetAttribute((const void*)fwd_kernel, hipFuncAttributeMaxDynamicSharedMemorySize, LDS_BYTES) != hipSuccess) { fprintf(stderr, "kernel_launch: hipFuncSetAttribute failed\n"); grid = -1; return; }
        if (hipOccupancyMaxActiveBlocksPerMultiprocessor(&per_cu, (const void*)fwd_kernel, NTHR, LDS_BYTES) != hipSuccess || per_cu < 1) { fprintf(stderr, "kernel_launch: occupancy query says %d blocks per CU\n", per_cu); (void)hipGetLastError(); grid = -1; return; }
        grid = cus;
        if (grid > 256) grid = 256;
    }
    if (grid < 0) return;
    (void)hipMemsetAsync((char*)d_ws + WS_CTL, 0, CTL_BYTES, stream);
    Args a{};
    for (int i = 0; i < 22; ++i) a.in[i] = (const float*)d_in[i];
    a.out = (float*)d_out; a.ws = (unsigned char*)d_ws;
#if ONE_LAUNCH
    a.ph_lo = 0; a.ph_hi = N_PHASES;
    void* args[] = {&a};
    hipError_t e = hipLaunchCooperativeKernel((const void*)fwd_kernel, dim3(grid), dim3(NTHR), args, LDS_BYTES, stream);
    if (e != hipSuccess) fprintf(stderr, "kernel_launch: cooperative launch failed: %s (grid %d)\n", hipGetErrorString(e), grid);
#else
    for (int k = 0; k < N_PHASES; ++k) { a.ph_lo = k; a.ph_hi = k + 1; hipLaunchKernelGGL(fwd_kernel, dim3(grid), dim3(NTHR), LDS_BYTES, stream, a); }
    const hipError_t le = hipPeekAtLastError();
    if (le != hipSuccess) fprintf(stderr, "kernel_launch: launch failed: %s\n", hipGetErrorName(le));
#endif
}
```

```cpp
#include <hip/hip_runtime.h>
#include <hip/hip_cooperative_groups.h>
#include <cstdio>
#include <cstdint>
namespace cg = cooperative_groups;
#ifndef ONE_LAUNCH
#define ONE_LAUNCH 1
#endif
namespace pg8 {
#define PG8_LAS __attribute__((address_space(3)))
typedef unsigned short bf16_t;
typedef short bf16x8 __attribute__((ext_vector_type(8)));
typedef float f32x4 __attribute__((ext_vector_type(4)));
typedef unsigned u32x4 __attribute__((ext_vector_type(4)));
constexpr int BM = 256, BK = 64, HALF = 128, HTB = HALF * BK * 2  , STAGE_BYTES = 8 * HTB, NXCD = 8, WGM = 8;

__host__ __device__ __forceinline__ int lds_byte(int r, int c) { const int st = (r >> 4) * 2 + (c >> 5), rr = r & 15, cc = c & 31, ob = rr * 64 + cc * 2; return st * 1024 + (ob ^ (((ob >> 9) & 1) << 5)); }
__host__ __device__ __forceinline__ void stage_rc(int b, int& R, int& C) { const int st = b / 1024, sb = b % 1024, swz = sb ^ (((sb >> 9) & 1) << 5); R = (st >> 1) * 16 + swz / 64; C = (st & 1) * 32 + (swz % 64) / 2; }
__host__ __device__ __forceinline__ int perm32(int rho) { const int n = rho >> 4, i = rho & 15; return 8 * (i >> 2) + 4 * n + (i & 3); }

struct Unit { int pm, pn; };
struct Gemm { const bf16_t* A; const bf16_t* Bt; int M, N, K; };

struct StaticOrder {
    int nM, nN, nwg, G, c;
    __host__ __device__ void init(int M, int N, int G_, int c_) { nM = M / BM; nN = N / BM; nwg = nM * nN; G = G_; c = c_; }
    __host__ __device__ bool next(int i, Unit& u) const {
        const long L = (long)i * G + c; if (L >= nwg) return false;
        int wgid = (int)L; { const int q = nwg / NXCD, r = nwg % NXCD, xcd = wgid % NXCD, off = wgid / NXCD; wgid = (xcd < r ? xcd * (q + 1) : r * (q + 1) + (xcd - r) * q) + off; }
        const int nig = WGM * nN, gid = wgid / nig, fm = gid * WGM, gsz = (nM - fm) < WGM ? (nM - fm) : WGM;
        u.pm = fm + ((wgid % nig) % gsz); u.pn = (wgid % nig) / gsz; return true;
    }
    __device__ __forceinline__ void a_ready(const Unit&) const {}
    __device__ __forceinline__ void done(const Unit&) const {}
};

__device__ __forceinline__ unsigned cvt_pk_bf16(float lo, float hi) { unsigned r; asm volatile("v_cvt_pk_bf16_f32 %0, %1, %2" : "=v"(r) : "v"(lo), "v"(hi)); return r; }
typedef float f32x2 __attribute__((ext_vector_type(2)));
__device__ __forceinline__ f32x2 gelu_pk(f32x2 v) {
    const f32x2 av = __builtin_elementwise_abs(v), d = av * 0.2316418882f + 1.0f;
    f32x2 t; t.x = __builtin_amdgcn_rcpf(d.x); t.y = __builtin_amdgcn_rcpf(d.y);
    f32x2 q = t * 0.5307027145f + (-0.7265760135f); q = q * t + 0.7107068705f; q = q * t + (-0.142248368f); q = q * t + 0.127414796f; q = q * t;
    const f32x2 s = (v * v) * (-0.72134752044f);
    f32x2 e; e.x = __builtin_amdgcn_exp2f(s.x); e.y = __builtin_amdgcn_exp2f(s.y);
    const f32x2 m = v * (q * e), r = v - m;
    f32x2 o; o.x = v.x < 0.f ? m.x : r.x; o.y = v.y < 0.f ? m.y : r.y; return o;
}

template <int ACT  > struct EpiBf16 {
    static constexpr bool PERM = true, AFTER_DRAIN = false; static_assert(ACT == 0 || ACT == 1, "EpiBf16: ACT is 0 (none) or 1 (gelu_pk)");
    bf16_t* O; int ldc; const float* bias; int split_cols; size_t split_stride; float scale0;
    __device__ __forceinline__ void operator()(const f32x4 (&acc)[2][2][4][2], const Unit& u, int wr, int wc, int fr, int fq) const {
        const int row0 = u.pm * BM + wr * 64 + fr; int colt = u.pn * BM; bf16_t* base = O;
        float sc = 1.f; if (split_cols) { const int t = colt / split_cols; base += (size_t)t * split_stride; colt -= t * split_cols; if (t == 0) sc = scale0; }
        const int col0 = colt + wc * 32 + 8 * fq, bcol0 = u.pn * BM + wc * 32 + 8 * fq;
        f32x4 bv[2][2];
#pragma unroll
        for (int bj = 0; bj < 2; ++bj)
#pragma unroll
            for (int n = 0; n < 2; ++n) bv[bj][n] = bias ? *(const f32x4*)(bias + bcol0 + bj * HALF + 4 * n) : (f32x4){0.f, 0.f, 0.f, 0.f};
#pragma unroll
        for (int ai = 0; ai < 2; ++ai)
#pragma unroll
            for (int m = 0; m < 4; ++m) { bf16_t* rowp = base + (size_t)(row0 + ai * HALF + m * 16) * ldc + col0;
#pragma unroll
                for (int bj = 0; bj < 2; ++bj) { f32x4 v0 = acc[ai][bj][m][0] + bv[bj][0], v1 = acc[ai][bj][m][1] + bv[bj][1];
                    if (ACT == 1) { f32x2 a = gelu_pk((f32x2){v0[0], v0[1]}), b = gelu_pk((f32x2){v0[2], v0[3]}), c = gelu_pk((f32x2){v1[0], v1[1]}), d = gelu_pk((f32x2){v1[2], v1[3]});
                        v0 = (f32x4){a.x, a.y, b.x, b.y}; v1 = (f32x4){c.x, c.y, d.x, d.y}; }
                    v0 = v0 * sc; v1 = v1 * sc; u32x4 w; w.x = cvt_pk_bf16(v0[0], v0[1]); w.y = cvt_pk_bf16(v0[2], v0[3]); w.z = cvt_pk_bf16(v1[0], v1[1]); w.w = cvt_pk_bf16(v1[2], v1[3]);
                    *(u32x4*)(rowp + bj * HALF) = w; } }
    }
};

struct PanelStats {
    unsigned* xbuf;
    unsigned* cnt;
    unsigned* tmo;
    int ntn; float eps;
    unsigned code;
    __device__ __forceinline__ bool run(const f32x4 (&v)[2][2][4][2], const Unit& u, int wr, int wc, int fr, int fq, PG8_LAS unsigned char* lds, int wid, int lane) const {
        typedef float f32x2v __attribute__((ext_vector_type(2)));
        PG8_LAS f32x2v* P = (PG8_LAS f32x2v*)lds;
        PG8_LAS f32x2v* S = (PG8_LAS f32x2v*)(lds + 8192);
        PG8_LAS unsigned* flag = (PG8_LAS unsigned*)(lds + 8192 + 2048);
#pragma unroll
        for (int ai = 0; ai < 2; ++ai)
#pragma unroll
            for (int m = 0; m < 4; ++m) {
                float s = 0.f;
#pragma unroll
                for (int bj = 0; bj < 2; ++bj)
#pragma unroll
                    for (int n = 0; n < 2; ++n) { const f32x4 x = v[ai][bj][m][n]; s += (x[0] + x[1]) + (x[2] + x[3]); }
                s += __shfl_xor(s, 16); s += __shfl_xor(s, 32);
                const float mw = s * (1.0f / 64.0f); float q = 0.f;
#pragma unroll
                for (int bj = 0; bj < 2; ++bj)
#pragma unroll
                    for (int n = 0; n < 2; ++n) { const f32x4 d = v[ai][bj][m][n] - mw; q += (d[0] * d[0] + d[1] * d[1]) + (d[2] * d[2] + d[3] * d[3]); }
                q += __shfl_xor(q, 16); q += __shfl_xor(q, 32);
                if (fq == 0) P[(ai * HALF + wr * 64 + m * 16 + fr) * 4 + wc] = (f32x2v){mw, q};
            }
        asm volatile("s_waitcnt lgkmcnt(0)" ::: "memory"); __builtin_amdgcn_s_barrier(); asm volatile("" ::: "memory");
#if defined(BROKEN_EXCHANGE_NO_WAIT)
#warning BROKEN CONTROL BUILD: the row-statistics exchange does not wait; results are wrong by design
        if (blockIdx.x >= 64) { const long long t0_ = clock64(); while (clock64() - t0_ < 60000) __builtin_amdgcn_s_sleep(8); }
#endif
        const int row = wid * 32 + (lane & 31);
        if (lane < 32) {
            const f32x2v a = P[row * 4 + 0], b = P[row * 4 + 1], c = P[row * 4 + 2], d = P[row * 4 + 3];
            const float mt = (a.x + b.x + c.x + d.x) * 0.25f;
            const float da = a.x - mt, db = b.x - mt, dc = c.x - mt, dd = d.x - mt;
            const float m2 = (a.y + b.y) + (c.y + d.y) + 64.0f * ((da * da + db * db) + (dc * dc + dd * dd));
            unsigned long long* slot = (unsigned long long*)xbuf + ((size_t)(u.pm * BM + row) * 4 + u.pn);
            __hip_atomic_store(slot, ((unsigned long long)__float_as_uint(m2) << 32) | __float_as_uint(mt), __ATOMIC_RELAXED, __HIP_MEMORY_SCOPE_AGENT);
        }
        asm volatile("s_waitcnt vmcnt(0)" ::: "memory");
        if (lane == 0) __hip_atomic_fetch_add(cnt + 64 * u.pm, 1u, __ATOMIC_RELAXED, __HIP_MEMORY_SCOPE_AGENT);
        if (wid == 0) {
            bool dead = false; const unsigned long long t0 = __builtin_amdgcn_s_memrealtime(); const unsigned want = 8u * (unsigned)ntn;
            for (;;) {
#if defined(BROKEN_EXCHANGE_NO_WAIT)
                break;
#endif
                if ((unsigned)__builtin_amdgcn_readfirstlane(__hip_atomic_load(cnt + 64 * u.pm, __ATOMIC_RELAXED, __HIP_MEMORY_SCOPE_AGENT)) >= want) break;
                if (__builtin_amdgcn_s_memrealtime() - t0 > 2000000ull) {
                    if (lane == 0) { unsigned expect = 0u; __hip_atomic_compare_exchange_strong(tmo + 1, &expect, code | (unsigned)(u.pm & 0xff), __ATOMIC_RELAXED, __ATOMIC_RELAXED, __HIP_MEMORY_SCOPE_AGENT);
                                     __hip_atomic_store(tmo, 1u, __ATOMIC_RELAXED, __HIP_MEMORY_SCOPE_AGENT); }
                    dead = true; break; }
                __builtin_amdgcn_s_sleep(2);
            }
            __builtin_amdgcn_fence(__ATOMIC_ACQUIRE, "agent");
            if (lane == 0) flag[0] = dead ? 1u : 0u;
        }
        asm volatile("s_waitcnt vmcnt(0) lgkmcnt(0)" ::: "memory"); __builtin_amdgcn_s_barrier(); asm volatile("" ::: "memory");
        const bool bad = flag[0] != 0u;
        if (lane < 32) {
            const unsigned long long* slot = (const unsigned long long*)xbuf + (size_t)(u.pm * BM + row) * 4; float mt[4], m2[4]; float ms = 0.f;
#pragma unroll
            for (int t = 0; t < 4; ++t) { if (t < ntn) { const unsigned long long w = __hip_atomic_load(slot + t, __ATOMIC_RELAXED, __HIP_MEMORY_SCOPE_AGENT); mt[t] = __uint_as_float((unsigned)w); m2[t] = __uint_as_float((unsigned)(w >> 32)); } else { mt[t] = 0.f; m2[t] = 0.f; } ms += mt[t]; }
            const float mean = ms / (float)ntn; float q = 0.f;
#pragma unroll
            for (int t = 0; t < 4; ++t) if (t < ntn) { const float dm = mt[t] - mean; q += m2[t] + 256.0f * dm * dm; }
            S[row] = (f32x2v){mean, 1.0f / sqrtf(q / (256.0f * (float)ntn) + eps)};
        }
        asm volatile("s_waitcnt lgkmcnt(0)" ::: "memory"); __builtin_amdgcn_s_barrier(); asm volatile("" ::: "memory");
        return bad;
    }
};
struct EpiLnRes {
    static constexpr bool PERM = false, AFTER_DRAIN = true;
    const float* base; float* out; int ldc; const float* bias; PanelStats st; unsigned poison;
    __device__ __forceinline__ void fused(f32x4 (&acc)[2][2][4][2], const Unit& u, int wr, int wc, int fr, int fq, PG8_LAS unsigned char* lds, int wid, int lane) const {
        typedef float f32x2v __attribute__((ext_vector_type(2)));
        const PG8_LAS f32x2v* S = (const PG8_LAS f32x2v*)(lds + 8192);
        const int col0 = u.pn * BM + wc * 32 + 4 * fq;
#pragma unroll
        for (int bj = 0; bj < 2; ++bj)
#pragma unroll
            for (int n = 0; n < 2; ++n) { const f32x4 bv = bias ? *(const f32x4*)(bias + col0 + bj * HALF + n * 16) : (f32x4){0.f, 0.f, 0.f, 0.f};
#pragma unroll
                for (int ai = 0; ai < 2; ++ai)
#pragma unroll
                    for (int m = 0; m < 4; ++m) acc[ai][bj][m][n] += bv; }
        f32x4 pre[4][2][2];
#pragma unroll
        for (int m = 0; m < 4; ++m) { const size_t off = (size_t)(u.pm * BM + wr * 64 + m * 16 + fr) * ldc + col0;
#pragma unroll
            for (int bj = 0; bj < 2; ++bj)
#pragma unroll
                for (int n = 0; n < 2; ++n) pre[m][bj][n] = *(const f32x4*)(base + off + bj * HALF + n * 16); }
        const bool bad = st.run(acc, u, wr, wc, fr, fq, lds, wid, lane) || poison != 0u;
        const float qnan = __builtin_nanf("");
#pragma unroll
        for (int ai = 0; ai < 2; ++ai)
#pragma unroll
            for (int m = 0; m < 4; ++m) { const int r = ai * HALF + wr * 64 + m * 16 + fr; const f32x2v sr = S[r]; const size_t off = (size_t)(u.pm * BM + r) * ldc + col0;
#pragma unroll
                for (int bj = 0; bj < 2; ++bj)
#pragma unroll
                    for (int n = 0; n < 2; ++n) { const f32x4 bs = ai == 0 ? pre[m][bj][n] : *(const f32x4*)(base + off + bj * HALF + n * 16); f32x4 o = bs + (acc[ai][bj][m][n] - sr.x) * sr.y;
                        if (bad) o = (f32x4){qnan, qnan, qnan, qnan}; *(f32x4*)(out + off + bj * HALF + n * 16) = o; }
                if (m & 1) asm volatile("" ::: "memory"); }
    }
};
struct EpiLnResLn {
    static constexpr bool PERM = false, AFTER_DRAIN = true;
    const float* base; float* out; bf16_t* xn; int ldc; const float* bias; PanelStats st1, st2; unsigned poison;
    __device__ __forceinline__ void fused(f32x4 (&acc)[2][2][4][2], const Unit& u, int wr, int wc, int fr, int fq, PG8_LAS unsigned char* lds, int wid, int lane) const {
        typedef float f32x2v __attribute__((ext_vector_type(2))); typedef unsigned u32x2v __attribute__((ext_vector_type(2)));
        const PG8_LAS f32x2v* S = (const PG8_LAS f32x2v*)(lds + 8192);
        const int col0 = u.pn * BM + wc * 32 + 4 * fq;
#pragma unroll
        for (int bj = 0; bj < 2; ++bj)
#pragma unroll
            for (int n = 0; n < 2; ++n) { const f32x4 bv = bias ? *(const f32x4*)(bias + col0 + bj * HALF + n * 16) : (f32x4){0.f, 0.f, 0.f, 0.f};
#pragma unroll
                for (int ai = 0; ai < 2; ++ai)
#pragma unroll
                    for (int m = 0; m < 4; ++m) acc[ai][bj][m][n] += bv; }
        bool bad = st1.run(acc, u, wr, wc, fr, fq, lds, wid, lane) || poison != 0u;
        const float qnan = __builtin_nanf("");
#pragma unroll
        for (int ai = 0; ai < 2; ++ai)
#pragma unroll
            for (int m = 0; m < 4; ++m) { const int r = ai * HALF + wr * 64 + m * 16 + fr; const f32x2v sr = S[r]; const size_t off = (size_t)(u.pm * BM + r) * ldc + col0;
#pragma unroll
                for (int bj = 0; bj < 2; ++bj)
#pragma unroll
                    for (int n = 0; n < 2; ++n) { const f32x4 bs = *(const f32x4*)(base + off + bj * HALF + n * 16); acc[ai][bj][m][n] = bs + (acc[ai][bj][m][n] - sr.x) * sr.y; }
                asm volatile("" : "+v"(acc[ai][0][m][0]), "+v"(acc[ai][0][m][1]), "+v"(acc[ai][1][m][0]), "+v"(acc[ai][1][m][1]));
                if (m & 1) asm volatile("" ::: "memory"); }
        const bool bad1 = bad;
        bad = st2.run(acc, u, wr, wc, fr, fq, lds, wid, lane) || bad;
#pragma unroll
        for (int ai = 0; ai < 2; ++ai)
#pragma unroll
            for (int m = 0; m < 4; ++m) { const int r = ai * HALF + wr * 64 + m * 16 + fr; const f32x2v sr = S[r]; const size_t off = (size_t)(u.pm * BM + r) * ldc + col0;
#pragma unroll
                for (int bj = 0; bj < 2; ++bj)
#pragma unroll
                    for (int n = 0; n < 2; ++n) { const f32x4 x1 = acc[ai][bj][m][n]; *(f32x4*)(out + off + bj * HALF + n * 16) = bad1 ? (f32x4){qnan, qnan, qnan, qnan} : x1;
                        const f32x4 o = (x1 - sr.x) * sr.y; u32x2v w; w.x = cvt_pk_bf16(o[0], o[1]); w.y = cvt_pk_bf16(o[2], o[3]);
                        if (bad) { w.x = 0x7fc07fc0u; w.y = 0x7fc07fc0u; } *(u32x2v*)(xn + off + bj * HALF + n * 16) = w; }
                asm volatile("" ::: "memory"); }
    }
};

template <class Epi, class Sched, bool ALIGN_EPI = false, bool SP2 = false>
__device__ __forceinline__ void gemm_phase(PG8_LAS unsigned char* lds, const Gemm g, const Sched& S, const Epi& E) {
    const int tid = threadIdx.x, wid = __builtin_amdgcn_readfirstlane(tid >> 6), lane = tid & 63, wr = wid >> 2, wc = wid & 3, fr = lane & 15, fq = lane >> 4;
    const int K = g.K, nt = K / BK;
    unsigned voffA[2], voffB[2];
#pragma unroll
    for (int i = 0; i < 2; ++i) { int R, C; stage_rc(tid * 16 + i * 8192, R, C); const int Rb = Epi::PERM ? ((R & ~31) + perm32(R & 31)) : R;
        voffA[i] = (unsigned)(R * K + C) * 2u; voffB[i] = (unsigned)(Rb * K + C) * 2u; }
    const size_t kstep = (size_t)(BK * 2);
    const size_t hstep = (size_t)HALF * K * 2;
    const size_t tstep = 2 * hstep;
    const unsigned ldsw = (unsigned)wid * 1024u;
    const int aoff = lds_byte(wr * 64 + fr, fq * 8), boff = lds_byte(wc * 32 + fr, fq * 8);
#define PG8_SA(b, h) (((b) * 2 + (h)) * HTB)
#define PG8_SB(b, h) ((4 + (b) * 2 + (h)) * HTB)
#define PG8_STAGE(bufoff, gbase, voff) do { _Pragma("unroll") for (int _i = 0; _i < 2; ++_i) \
        __builtin_amdgcn_global_load_lds((const unsigned*)((const char*)(gbase) + (voff)[_i]), (PG8_LAS unsigned*)(lds + (bufoff) + ldsw + _i * 8192), 16, 0, 0); } while (0)
#define PG8_LDA(dst, b, h) do { _Pragma("unroll") for (int m = 0; m < 4; ++m) _Pragma("unroll") for (int k = 0; k < 2; ++k) dst[m][k] = *(const PG8_LAS bf16x8*)(lds + PG8_SA(b, h) + aoff + m * 2048 + k * 1024); } while (0)
#define PG8_LDB(dst, b, h) do { _Pragma("unroll") for (int n = 0; n < 2; ++n) _Pragma("unroll") for (int k = 0; k < 2; ++k) dst[n][k] = *(const PG8_LAS bf16x8*)(lds + PG8_SB(b, h) + boff + n * 2048 + k * 1024); } while (0)
#define PG8_MMA(ai, bj, At, Bt) do { __builtin_amdgcn_s_setprio(1); _Pragma("unroll") for (int m = 0; m < 4; ++m) _Pragma("unroll") for (int n = 0; n < 2; ++n) _Pragma("unroll") for (int k = 0; k < 2; ++k) \
        acc[ai][bj][m][n] = __builtin_amdgcn_mfma_f32_16x16x32_bf16(Bt[n][k], At[m][k], acc[ai][bj][m][n], 0, 0, 0); __builtin_amdgcn_s_setprio(0); } while (0)
#define PG8_WAIT_V(n) asm volatile("s_waitcnt vmcnt(" #n ")" ::: "memory")
#define PG8_WAIT_L(n) asm volatile("s_waitcnt lgkmcnt(" #n ")" ::: "memory")
#define PG8_BAR __builtin_amdgcn_s_barrier()
#define PG8_SCHED __builtin_amdgcn_sched_barrier(0)
    Unit cur, nxt; int ui = 0;
    if (!S.next(0, cur)) return;
    f32x4 acc[2][2][4][2];
#pragma unroll
    for (int a = 0; a < 2; ++a)
#pragma unroll
        for (int b = 0; b < 2; ++b)
#pragma unroll
            for (int m = 0; m < 4; ++m)
#pragma unroll
                for (int n = 0; n < 2; ++n) acc[a][b][m][n] = (f32x4){0.f, 0.f, 0.f, 0.f};
    bf16x8 At[4][2], B0[2][2], B1[2][2];
    const char* cA = (const char*)g.A + (size_t)cur.pm * tstep; const char* cB = (const char*)g.Bt + (size_t)cur.pn * tstep;
    S.a_ready(cur);
    if constexpr (SP2) {
        PG8_STAGE(PG8_SB(0, 0), cB, voffB); PG8_STAGE(PG8_SB(0, 1), cB + hstep, voffB); PG8_STAGE(PG8_SA(0, 0), cA, voffA); PG8_STAGE(PG8_SA(0, 1), cA + hstep, voffA);
        if (wr == 1) PG8_BAR;
        PG8_WAIT_V(2); PG8_BAR;
        PG8_STAGE(PG8_SB(1, 0), cB + kstep, voffB); PG8_STAGE(PG8_SA(1, 0), cA + kstep, voffA); PG8_STAGE(PG8_SB(1, 1), cB + hstep + kstep, voffB);
        PG8_WAIT_V(6); PG8_BAR;
    } else {
        PG8_STAGE(PG8_SB(0, 0), cB, voffB); PG8_STAGE(PG8_SA(0, 0), cA, voffA); PG8_STAGE(PG8_SB(0, 1), cB + hstep, voffB); PG8_STAGE(PG8_SA(0, 1), cA + hstep, voffA);
        if (wr == 1) PG8_BAR;
        PG8_WAIT_V(4); PG8_BAR;
        PG8_STAGE(PG8_SB(1, 0), cB + kstep, voffB); PG8_STAGE(PG8_SA(1, 0), cA + kstep, voffA); PG8_STAGE(PG8_SB(1, 1), cB + hstep + kstep, voffB);
        PG8_WAIT_V(6); PG8_BAR;
    }
    for (;;) {
        const bool has_next = S.next(ui + 1, nxt);
        const char* nA = has_next ? (const char*)g.A + (size_t)nxt.pm * tstep : cA; const char* nB = has_next ? (const char*)g.Bt + (size_t)nxt.pn * tstep : cB;
        for (int t = 0; t < nt; t += 2) {
            const bool last = (t == nt - 2);
            const char* a1 = cA + (size_t)(t + 1) * kstep;
            const char* a2 = last ? nA : cA + (size_t)(t + 2) * kstep; const char* b2 = last ? nB : cB + (size_t)(t + 2) * kstep;
            const char* a3 = a2 + kstep; const char* b3 = b2 + kstep;
            if (last && has_next) S.a_ready(nxt);
            if constexpr (SP2) {
            PG8_LDB(B0, 0, 0); PG8_LDB(B1, 0, 1); PG8_SCHED; PG8_LDA(At, 0, 0); PG8_STAGE(PG8_SA(1, 1), a1 + hstep, voffA);
            PG8_WAIT_V(8); PG8_WAIT_L(0); PG8_BAR; PG8_MMA(0, 0, At, B0); PG8_MMA(0, 1, At, B1); PG8_BAR; PG8_SCHED;
            PG8_LDA(At, 0, 1); PG8_STAGE(PG8_SB(0, 0), b2, voffB); PG8_STAGE(PG8_SB(0, 1), b2 + hstep, voffB); PG8_STAGE(PG8_SA(0, 0), a2, voffA);
            PG8_WAIT_V(8); PG8_WAIT_L(0); PG8_BAR; PG8_MMA(1, 0, At, B0); PG8_MMA(1, 1, At, B1); PG8_BAR; PG8_SCHED;
            PG8_LDB(B0, 1, 0); PG8_LDB(B1, 1, 1); PG8_SCHED; PG8_LDA(At, 1, 0); PG8_STAGE(PG8_SA(0, 1), a2 + hstep, voffA);
            PG8_WAIT_V(8); PG8_WAIT_L(0); PG8_BAR; PG8_MMA(0, 0, At, B0); PG8_MMA(0, 1, At, B1); PG8_BAR; PG8_SCHED;
            PG8_LDA(At, 1, 1); PG8_STAGE(PG8_SB(1, 0), b3, voffB); PG8_STAGE(PG8_SB(1, 1), b3 + hstep, voffB); PG8_STAGE(PG8_SA(1, 0), a3, voffA);
            PG8_WAIT_V(8); PG8_WAIT_L(0); PG8_BAR; PG8_MMA(1, 0, At, B0); PG8_MMA(1, 1, At, B1); PG8_BAR; PG8_SCHED;
            } else {
            PG8_LDB(B0, 0, 0); PG8_SCHED; PG8_LDA(At, 0, 0); PG8_STAGE(PG8_SA(1, 1), a1 + hstep, voffA);
            PG8_WAIT_L(8); PG8_BAR; PG8_WAIT_L(0); PG8_MMA(0, 0, At, B0); PG8_BAR; PG8_SCHED;
            PG8_LDB(B1, 0, 1); PG8_STAGE(PG8_SB(0, 0), b2, voffB);
            PG8_BAR; PG8_WAIT_L(0); PG8_MMA(0, 1, At, B1); PG8_BAR;
            PG8_LDA(At, 0, 1); PG8_STAGE(PG8_SA(0, 0), a2, voffA);
            PG8_BAR; PG8_WAIT_L(0); PG8_MMA(1, 0, At, B0); PG8_BAR; PG8_SCHED;
            PG8_STAGE(PG8_SB(0, 1), b2 + hstep, voffB);
            PG8_WAIT_V(6); PG8_BAR; PG8_MMA(1, 1, At, B1); PG8_BAR;
            PG8_LDB(B0, 1, 0); PG8_SCHED; PG8_LDA(At, 1, 0); PG8_STAGE(PG8_SA(0, 1), a2 + hstep, voffA);
            PG8_WAIT_L(8); PG8_BAR; PG8_WAIT_L(0); PG8_MMA(0, 0, At, B0); PG8_BAR; PG8_SCHED;
            PG8_LDB(B1, 1, 1); PG8_STAGE(PG8_SB(1, 0), b3, voffB);
            PG8_BAR; PG8_WAIT_L(0); PG8_MMA(0, 1, At, B1); PG8_BAR;
            PG8_LDA(At, 1, 1); PG8_STAGE(PG8_SA(1, 0), a3, voffA);
            PG8_BAR; PG8_WAIT_L(0); PG8_MMA(1, 0, At, B0); PG8_BAR; PG8_SCHED;
            PG8_STAGE(PG8_SB(1, 1), b3 + hstep, voffB);
            PG8_WAIT_V(6); PG8_BAR; PG8_MMA(1, 1, At, B1); PG8_BAR;
            }
        }
        if constexpr (ALIGN_EPI) { if (wr == 0) PG8_BAR; }
        if constexpr (!Epi::AFTER_DRAIN) { E(acc, cur, wr, wc, fr, fq); S.done(cur); }
        if (!has_next) break;
#pragma unroll
        for (int a = 0; a < 2; ++a)
#pragma unroll
            for (int b = 0; b < 2; ++b)
#pragma unroll
                for (int m = 0; m < 4; ++m)
#pragma unroll
                    for (int n = 0; n < 2; ++n) acc[a][b][m][n] = (f32x4){0.f, 0.f, 0.f, 0.f};
        cur = nxt; cA = nA; cB = nB; ++ui;
        if constexpr (ALIGN_EPI) { if (wr == 1) PG8_BAR; }
    }
    PG8_WAIT_V(0);
    if constexpr (!ALIGN_EPI) { if (wr == 0) PG8_BAR; }
    PG8_BAR;
    if constexpr (Epi::AFTER_DRAIN) { E.fused(acc, cur, wr, wc, fr, fq, lds, wid, lane); S.done(cur); }
#undef PG8_SA
#undef PG8_SB
#undef PG8_STAGE
#undef PG8_LDA
#undef PG8_LDB
#undef PG8_MMA
#undef PG8_WAIT_V
#undef PG8_WAIT_L
#undef PG8_BAR
#undef PG8_SCHED
}
}

#define LAS __attribute__((address_space(3)))
typedef unsigned short bf16_t;
typedef short bf16x8 __attribute__((ext_vector_type(8)));
typedef short s16x4 __attribute__((ext_vector_type(4)));
typedef float f32x2 __attribute__((ext_vector_type(2)));
typedef float f32x4 __attribute__((ext_vector_type(4)));
typedef float f32x16 __attribute__((ext_vector_type(16)));
typedef unsigned u32x2 __attribute__((ext_vector_type(2)));
typedef unsigned u32x4 __attribute__((ext_vector_type(4)));
typedef int i32x4 __attribute__((ext_vector_type(4)));
typedef __bf16 bf16x2_t __attribute__((ext_vector_type(2)));

constexpr int NWAVES = 8, NTHR = 512;
constexpr int D = 2048, BATCH = 2, SEQ = 4096, CTX = 256, TPB = SEQ + CTX, M1 = BATCH * TPB, ML = BATCH * SEQ, NIN = 8192;
constexpr int C_HQ = 0, C_FF = 1024, C_FB = 2048, C_HI = 3072, C_HG = 4096, C_DQ = 5120, C_DK = 6144, C_DV = 7168;
constexpr float RMS_EPS = 1e-6f;
constexpr int NEXP = 16384, NMOD = 6 * D;
constexpr int LDS_BYTES = 155648;

constexpr size_t MiB = 1u << 20;
constexpr size_t WS_CTL = 0, CTL_BYTES = 1 * MiB;
constexpr size_t WS_MOD = 512 * 1024;
constexpr size_t WS_SMALL = 1 * MiB;
constexpr size_t WS_WIN = 2 * MiB, WS_WOUT = 34 * MiB, WS_WQ = 42 * MiB, WS_UBF = 50 * MiB, WS_VBF = 114 * MiB, WS_H = 178 * MiB, WS_PARTS = 212 * MiB,
                 WS_MIX = 348 * MiB, WS_HST = 380 * MiB, WS_HD = 412 * MiB, WS_IDX = 413 * MiB, WS_COEF = 417 * MiB, WS_OF = 421 * MiB, WS_KH = 453 * MiB, WS_VH = 471 * MiB, WS_END = 489 * MiB;
constexpr size_t WS_QP = WS_PARTS, WS_X1B = WS_PARTS + 96 * MiB;

struct Args { const float* in[22]; float* out; unsigned char* ws; int ph_lo, ph_hi; };
enum { I_X = 0, I_C, I_CTX, I_CCTX, I_WADA, I_BADA, I_N1G, I_WIN, I_HGG, I_HGNG, I_LQ1, I_LK1, I_LQ2, I_LK2, I_SUBG, I_WOUT, I_N2G, I_WQ, I_KEYS, I_PU, I_PV, I_FNG };

__device__ __forceinline__ float bf2f(unsigned short h) { return __uint_as_float((unsigned)h << 16); }
__device__ __forceinline__ unsigned pk2(float lo, float hi) { f32x2 v = {lo, hi}; bf16x2_t b = __builtin_convertvector(v, bf16x2_t); return __builtin_bit_cast(unsigned, b); }
__device__ __forceinline__ unsigned short f2bf(float f) { return (unsigned short)(pk2(f, 0.f) & 0xffffu); }
__device__ __forceinline__ float wave_sum(float v) {
#pragma unroll
    for (int o = 1; o < 64; o <<= 1) v += __shfl_xor(v, o);
    return v;
}
__device__ __forceinline__ int crow(int r, int hi) { return (r & 3) + 8 * (r >> 2) + 4 * hi; }
__device__ __forceinline__ float silu_f(float x) { return x / (1.f + __expf(-x)); }
#define SBAR() __builtin_amdgcn_sched_barrier(0)

__device__ __forceinline__ int v_st(int k, int c) { const int kk = (k & ~0xC) | ((k & 4) << 1) | ((k & 8) >> 1); return ((kk >> 3) * 4 + (c >> 5)) * 512 + ((kk & 7) * 32 + (c & 31)) * 2; }
__device__ __forceinline__ int v_rd_base(int lane) { return ((lane & 3) << 3) | (((lane >> 2) & 3) << 6) | (((lane >> 4) & 1) << 5) | (((lane >> 5) & 1) << 8); }
constexpr int v_rd_off(int d0, int ks, int half) { return d0 * 512 + ks * 4096 + half * 2048; }
template <int OFF> __device__ __forceinline__ s16x4 tr_read(int vb) {
  s16x4 r; asm volatile("ds_read_b64_tr_b16 %0, %1 offset:%2" : "=&v"(r) : "v"(vb), "i"(OFF) : "memory"); return r;
}
template <int D0> __device__ __forceinline__ void pv_one(f32x16& od, int vb, bf16x8 pa0, bf16x8 pa1, bf16x8 pa2, bf16x8 pa3) {
  const s16x4 l0 = tr_read<v_rd_off(D0, 0, 0)>(vb), h0 = tr_read<v_rd_off(D0, 0, 1)>(vb), l1 = tr_read<v_rd_off(D0, 1, 0)>(vb), h1 = tr_read<v_rd_off(D0, 1, 1)>(vb);
  const s16x4 l2 = tr_read<v_rd_off(D0, 2, 0)>(vb), h2 = tr_read<v_rd_off(D0, 2, 1)>(vb), l3 = tr_read<v_rd_off(D0, 3, 0)>(vb), h3 = tr_read<v_rd_off(D0, 3, 1)>(vb);
  asm volatile("s_waitcnt lgkmcnt(0)" ::: "memory"); SBAR();
#define PK(L, H) (bf16x8){L[0], L[1], L[2], L[3], H[0], H[1], H[2], H[3]}
  od = __builtin_amdgcn_mfma_f32_32x32x16_bf16(pa0, PK(l0, h0), od, 0, 0, 0);
  od = __builtin_amdgcn_mfma_f32_32x32x16_bf16(pa1, PK(l1, h1), od, 0, 0, 0);
  od = __builtin_amdgcn_mfma_f32_32x32x16_bf16(pa2, PK(l2, h2), od, 0, 0, 0);
  od = __builtin_amdgcn_mfma_f32_32x32x16_bf16(pa3, PK(l3, h3), od, 0, 0, 0);
#undef PK
}

__device__ __forceinline__ void p0_transpose_item(const float* W, int K, int N, bf16_t* WT, LAS float* scr, int item, int lane) {
    const int nblk = N / 32, kb = item / nblk, nb = item % nblk, k0 = 64 * kb, n0 = 32 * nb;
    float wv_[32];
#pragma unroll
    for (int i = 0; i < 32; ++i) wv_[i] = __builtin_nontemporal_load(W + (size_t)(k0 + 2 * i + (lane >> 5)) * N + n0 + (lane & 31));
#pragma unroll
    for (int i = 0; i < 32; ++i) scr[(2 * i + (lane >> 5)) * 33 + (lane & 31)] = wv_[i];
    asm volatile("s_waitcnt lgkmcnt(0)" ::: "memory");
    const int c = lane & 7;
#pragma unroll
    for (int j = 0; j < 4; ++j) { const int n = (lane >> 3) + 8 * j; const LAS float* s = scr + (8 * c) * 33 + n;
        u32x4 o; o.x = pk2(s[0 * 33], s[1 * 33]); o.y = pk2(s[2 * 33], s[3 * 33]); o.z = pk2(s[4 * 33], s[5 * 33]); o.w = pk2(s[6 * 33], s[7 * 33]);
        *(u32x4*)(WT + (size_t)(n0 + n) * K + k0 + 8 * c) = o; }
    asm volatile("s_waitcnt lgkmcnt(0)" ::: "memory");
}
__device__ __forceinline__ void cvt8(const float* src, bf16_t* dst) {
    const f32x4 a = *(const f32x4*)src, b = *(const f32x4*)(src + 4);
    u32x4 o; o.x = pk2(a.x, a.y); o.y = pk2(a.z, a.w); o.z = pk2(b.x, b.y); o.w = pk2(b.z, b.w); *(u32x4*)dst = o;
}
__device__ __forceinline__ void p0_prologue(const Args& a, unsigned char* lds, int vcu, int G, int tid, int lane, int wave) {
    unsigned char* ws = a.ws;
    LAS float* scr = (LAS float*)lds + wave * 4096;
    const int gw = vcu * NWAVES + wave, NGW = G * NWAVES;
    float* mod = (float*)(ws + WS_MOD);
    if (vcu < 192) {
        LAS float* sl = (LAS float*)lds;
        for (int i = tid; i < 3 * D; i += NTHR) { const int v = i >> 11, k = i & 2047; const float cv = v < 2 ? a.in[I_C][v * D + k] : a.in[I_CCTX][k]; sl[i] = silu_f(cv); }
        __syncthreads();
        const int rs = lane >> 4, c4 = lane & 15;
        const float* wp = a.in[I_WADA] + (size_t)(wave * 256 + rs) * NMOD + vcu * 64 + 4 * c4;
        f32x4 acc0 = {0.f, 0.f, 0.f, 0.f}, acc1 = acc0, acc2 = acc0;
#pragma unroll 8
        for (int i = 0; i < 64; ++i) { const int k = wave * 256 + 4 * i + rs; const f32x4 w = __builtin_nontemporal_load((const f32x4*)(wp + (size_t)(4 * i) * NMOD));
            acc0 += w * sl[k]; acc1 += w * sl[D + k]; acc2 += w * sl[2 * D + k]; }
        LAS float* pr = sl + 3 * D;
#pragma unroll
        for (int e = 0; e < 4; ++e) {
            float x0 = acc0[e], x1 = acc1[e], x2 = acc2[e];
            x0 += __shfl_xor(x0, 16); x0 += __shfl_xor(x0, 32); x1 += __shfl_xor(x1, 16); x1 += __shfl_xor(x1, 32); x2 += __shfl_xor(x2, 16); x2 += __shfl_xor(x2, 32);
            if (rs == 0) { pr[(wave * 3 + 0) * 64 + 4 * c4 + e] = x0; pr[(wave * 3 + 1) * 64 + 4 * c4 + e] = x1; pr[(wave * 3 + 2) * 64 + 4 * c4 + e] = x2; }
        }
        __syncthreads();
        if (tid < 192) { const int v = tid >> 6, c = tid & 63; float s = 0.f;
#pragma unroll
            for (int w = 0; w < 8; ++w) s += pr[(w * 3 + v) * 64 + c];
            __hip_atomic_store((unsigned*)mod + v * NMOD + vcu * 64 + c, __float_as_uint(s), __ATOMIC_RELAXED, __HIP_MEMORY_SCOPE_AGENT); }
        asm volatile("s_waitcnt vmcnt(0)" ::: "memory");
        __syncthreads();
        if (tid == 0) __hip_atomic_fetch_add((unsigned*)(ws + WS_CTL) + 12288, 1u, __ATOMIC_RELAXED, __HIP_MEMORY_SCOPE_AGENT);
    }
    constexpr int I_IN = (D / 64) * (NIN / 32), I_O = (D / 64) * (D / 32);
    for (int it = gw; it < I_IN + 2 * I_O; it += NGW) {
        int r = it;
        if (r < I_IN) { p0_transpose_item(a.in[I_WIN], D, NIN, (bf16_t*)(ws + WS_WIN), scr, r, lane); continue; } r -= I_IN;
        if (r < I_O) { p0_transpose_item(a.in[I_WOUT], D, D, (bf16_t*)(ws + WS_WOUT), scr, r, lane); continue; } r -= I_O;
        p0_transpose_item(a.in[I_WQ], D, D, (bf16_t*)(ws + WS_WQ), scr, r, lane);
    }
    {
        const long NK8 = 8 * 2 * 128 * 128 / 8, gt = (long)vcu * NTHR + tid, NT = (long)G * NTHR;
        for (long i = gt; i < NK8; i += NT) cvt8(a.in[I_KEYS] + i * 8, (bf16_t*)(ws + WS_SMALL + 512 * 1024) + i * 8);
    }
    if (vcu == (G > 192 ? G - 1 : 0)) {
        float* sm = (float*)(ws + WS_SMALL);
        for (int i = tid; i < 2048; i += NTHR) { const float g0 = a.in[I_HGG][i], g1 = a.in[I_HGG][2048 + i]; sm[i] = 1.f / (1.f + expf(g1 - g0)); }
        if (tid < 16) {
            const float invf = expf(-(float)tid * (1.f / 16.f) * 9.210340371976184f);
            const double w = (double)invf, w2 = w * w;
            double cs = 1.0, sn = w, tc = 1.0, tsn = w;
#pragma unroll
            for (int n = 1; n < 12; ++n) { tc = -tc * w2 * (1.0 / (double)((2 * n - 1) * (2 * n))); tsn = -tsn * w2 * (1.0 / (double)((2 * n) * (2 * n + 1))); cs += tc; sn += tsn; }
            double c = 1.0, s = 0.0;
            for (int pos = 0; pos < 64; ++pos) {
                sm[4096 + pos * 16 + tid] = (float)c; sm[5120 + pos * 16 + tid] = (float)s;
                const double c2 = c * cs - s * sn, s2 = s * cs + c * sn; c = c2; s = s2;
            }
        }
        if (tid == 64) {
            float d1 = 0.f, d2 = 0.f;
            for (int i = 0; i < 64; ++i) { d1 += a.in[I_LQ1][i] * a.in[I_LK1][i]; d2 += a.in[I_LQ2][i] * a.in[I_LK2][i]; }
            sm[2048] = expf(d1) - expf(d2) + 0.2f;
        }
    }
}

template <int WHICH> __device__ __forceinline__ void norm_phase(const Args& a, int vcu, int G, int lane, int wave) {
    const int gw = vcu * NWAVES + wave, NGW = G * NWAVES;
    const float* mod = (const float*)(a.ws + WS_MOD);
    const float* bada = a.in[I_BADA];
    const float* gain = a.in[WHICH == 0 ? I_N1G : I_N2G];
    bf16_t* H = (bf16_t*)(a.ws + WS_H);
    constexpr int NR = WHICH == 0 ? M1 : ML, CSH = WHICH == 0 ? 0 : 3 * D, CSC = WHICH == 0 ? D : 4 * D;
    for (int R = gw; R < NR; R += NGW) {
        const float* src; int v;
        if (WHICH == 0) { const int b = R / TPB, p = R % TPB; if (p < CTX) { src = a.in[I_CTX] + (size_t)(b * CTX + p) * D; v = 2; } else { src = a.in[I_X] + (size_t)(b * SEQ + p - CTX) * D; v = b; } }
        else { src = nullptr; v = R / SEQ; }
        f32x4 x[8]; float ss = 0.f;
#pragma unroll
        for (int j = 0; j < 8; ++j) {
            if (WHICH == 0) x[j] = __builtin_nontemporal_load((const f32x4*)(src + 256 * j + 4 * lane));
            else { const u32x2 w = *(const u32x2*)((const bf16_t*)(a.ws + WS_X1B) + (size_t)R * D + 256 * j + 4 * lane);
                   x[j] = (f32x4){__uint_as_float(w.x << 16), __uint_as_float(w.x & 0xffff0000u), __uint_as_float(w.y << 16), __uint_as_float(w.y & 0xffff0000u)}; }
            ss += (x[j].x * x[j].x + x[j].y * x[j].y) + (x[j].z * x[j].z + x[j].w * x[j].w); }
        const float rstd = rsqrtf(wave_sum(ss) * (1.f / D) + RMS_EPS);
#pragma unroll
        for (int j = 0; j < 8; ++j) {
            const int col = 256 * j + 4 * lane;
            const f32x4 g = *(const f32x4*)(gain + col);
            const f32x4 sh = *(const f32x4*)(mod + v * NMOD + CSH + col) + *(const f32x4*)(bada + CSH + col);
            const f32x4 sc = *(const f32x4*)(mod + v * NMOD + CSC + col) + *(const f32x4*)(bada + CSC + col);
            const f32x4 y = x[j] * rstd * g * (sc + 1.f) + sh;
            u32x2 o; o.x = pk2(y.x, y.y); o.y = pk2(y.z, y.w);
            *(u32x2*)(H + (size_t)R * D + col) = o;
        }
    }
}

#define GAS __attribute__((address_space(1)))
#ifndef SYNC_XCD
#define SYNC_XCD 1
#endif
#define XB_TMO      128
#define XB_XCNT(j)  (256  + 64 * (j))
#define XB_XSUB(j)  (1280 + 64 * (j))
#define XB_XGEN(j)  (2304 + 64 * (j))
#define XB_TOP      3328
#define XB_TOPGEN   3392
#define XCD_BAR_WORDS 3456
#define XB_SPIN_CAP (1u << 18)

__device__ __forceinline__ unsigned xb_ld(unsigned* p)              { return __hip_atomic_load(p, __ATOMIC_RELAXED, __HIP_MEMORY_SCOPE_AGENT); }
__device__ __forceinline__ unsigned xb_add(unsigned* p, unsigned v) { return __hip_atomic_fetch_add(p, v, __ATOMIC_RELAXED, __HIP_MEMORY_SCOPE_AGENT); }
__device__ __forceinline__ unsigned xb_xcc_id() { return (unsigned)__builtin_amdgcn_s_getreg((3 << 11) | 20) & 0xFu; }
#define XB_SPIN(cond, bar) do { unsigned _sp = 0; while (cond) { __builtin_amdgcn_s_sleep(1); \
    if ((++_sp & 255u) == 0u) { if (xb_ld(&(bar)[XB_TMO])) break; if (_sp > XB_SPIN_CAP) { atomicAdd(&(bar)[XB_TMO], 1u); break; } } } } while (0)

struct XcdBarrier {
    unsigned* bar; unsigned x;
    volatile LAS unsigned* st;
};

__device__ __forceinline__ XcdBarrier xcd_barrier_post(unsigned* bar, volatile LAS unsigned* st) {
    XcdBarrier b; b.bar = bar; b.x = xb_xcc_id(); b.st = st;
    if (threadIdx.x == 0) (void)xb_add(&bar[XB_XCNT(b.x)], 1u);
    return b;
}
__device__ __forceinline__ void xcd_barrier_complete(unsigned* bar, unsigned x, unsigned& nloc, unsigned& nx) {
    const unsigned G = gridDim.x * gridDim.y * gridDim.z;
    unsigned sum, cnt, mine, sp = 0u;
    for (;;) {
        sum = 0u; cnt = 0u; mine = 0u;
#pragma unroll
        for (unsigned j = 0; j < 16; ++j) { const unsigned c = xb_ld(&bar[XB_XCNT(j)]); sum += c; cnt += (c > 0u) ? 1u : 0u; mine = (j == x) ? c : mine; }
        if (sum == G) break;
        __builtin_amdgcn_s_sleep(1);
        if ((++sp & 255u) == 0u) { if (xb_ld(&bar[XB_TMO])) break; if (sp > XB_SPIN_CAP) { atomicAdd(&bar[XB_TMO], 1u); break; } }
    }
    nloc = mine > 0u ? mine : 1u; nx = cnt > 0u ? cnt : 1u;
}

__device__ __forceinline__ void xcd_barrier(const XcdBarrier& b) {
    asm volatile("s_waitcnt vmcnt(0)" ::: "memory");
    __syncthreads();
    if (threadIdx.x == 0) {
        unsigned* bar = b.bar;
        __builtin_amdgcn_s_waitcnt(0);
        unsigned nloc = b.st[0], nx = b.st[1];
        if (nloc == 0u) { xcd_barrier_complete(bar, b.x, nloc, nx); b.st[0] = nloc; b.st[1] = nx; }
        const unsigned old = xb_add(&bar[XB_XSUB(b.x)], 1u);
        const unsigned gen = old / nloc;
        if (old + 1u == (gen + 1u) * nloc) {
            __builtin_amdgcn_fence(__ATOMIC_RELEASE, "agent");
            asm volatile("s_waitcnt vmcnt(0)" ::: "memory");
            const unsigned og = xb_add(&bar[XB_TOP], 1u);
            const unsigned tg = og / nx;
            if (og + 1u == (tg + 1u) * nx) xb_add(&bar[XB_TOPGEN], 1u);
            else XB_SPIN(xb_ld(&bar[XB_TOPGEN]) == tg, bar);
            __builtin_amdgcn_fence(__ATOMIC_ACQUIRE, "agent");
            xb_add(&bar[XB_XGEN(b.x)], 1u);
            asm volatile("s_waitcnt vmcnt(0)" ::: "memory");
        } else {
            XB_SPIN(xb_ld(&bar[XB_XGEN(b.x)]) == gen, bar);
            __builtin_amdgcn_fence(__ATOMIC_ACQUIRE, "agent");
            asm volatile("s_waitcnt vmcnt(0)" ::: "memory");
        }
    }
    __syncthreads();
}

namespace pg8 {
struct OrderIn {
    int G, c;
    __device__ bool next(int i, Unit& u) const {
        const long L = (long)i * G + c; if (L >= 1064) return false;
        if (L < 1024) {
            int wgid = (int)L; wgid = (wgid & 7) * 128 + (wgid >> 3);
            const int pml = (wgid >> 8) * 8 + (wgid & 7);
            u.pm = pml < 16 ? pml + 1 : pml + 2; u.pn = (wgid & 255) >> 3;
        } else {
            const int e = (int)L - 1024, k = e % 20, g = k >> 2;
            u.pm = (e / 20) * 17; u.pn = (g < 3 ? g + 1 : g + 3) * 4 + (k & 3);
        }
        return true;
    }
    __device__ __forceinline__ void a_ready(const Unit&) const {}
    __device__ __forceinline__ void done(const Unit&) const {}
};
constexpr float QSC = 0.125f * 1.4426950408889634f;
struct EpiIn {
    static constexpr bool PERM = true, AFTER_DRAIN = false;
    bf16_t* O; const float* lb; const float* ropec; const float* ropes; bf16_t* KH; bf16_t* VH;
    __device__ __forceinline__ void operator()(const f32x4 (&acc)[2][2][4][2], const Unit& u, int wr, int wc, int fr, int fq) const {
        const int part = u.pn >> 2; const bool is_ctx = (u.pm == 0 || u.pm == 17);
        const int row0 = u.pm * BM + wr * 64 + fr, col0 = u.pn * BM + wc * 32 + 8 * fq;
        f32x4 lbv[2][2];
        if (part == 1 || part == 2) {
#pragma unroll
            for (int bj = 0; bj < 2; ++bj)
#pragma unroll
                for (int n = 0; n < 2; ++n) lbv[bj][n] = *(const f32x4*)(lb + (col0 + bj * HALF + 4 * n - 1024));
        }
        const int tb = (u.pm >= 17) ? (row0 - 4352 - 256) : (row0 - 256);
        const bool lowhalf = fq < 2;
#pragma unroll
        for (int ai = 0; ai < 2; ++ai)
#pragma unroll
            for (int m = 0; m < 4; ++m) {
                const int row = row0 + ai * HALF + m * 16;
                bf16_t* rowp = O + (size_t)row * 8192 + col0; size_t hstep = HALF;
                if (part >= 6) { const int bb = u.pm >= 17 ? 1 : 0, pos = row - bb * 4352;
                    rowp = (part == 6 ? KH : VH) + ((size_t)(bb * 8 + (u.pn & 3) * 2) * 4352 + pos) * 128 + wc * 32 + 8 * fq; hstep = (size_t)4352 * 128; }
                const bool rope = (part == 5 || part == 6) && !is_ctx;
                f32x4 cs[2], sn[2];
                if (rope) { const int t = tb + ai * HALF + m * 16; const int pos = (wc & 1) ? (t & 63) : (t >> 6);
#pragma unroll
                    for (int n = 0; n < 2; ++n) { cs[n] = *(const f32x4*)(ropec + pos * 16 + 8 * (fq & 1) + 4 * n); sn[n] = *(const f32x4*)(ropes + pos * 16 + 8 * (fq & 1) + 4 * n);
                        if (part == 5) { cs[n] *= QSC; sn[n] *= QSC; }
                        { const f32x4 c_ = cs[n], s_ = sn[n]; cs[n] = lowhalf ? c_ : s_; sn[n] = lowhalf ? -s_ : c_; } } }
#pragma unroll
                for (int bj = 0; bj < 2; ++bj) {
                    f32x4 v[2] = {acc[ai][bj][m][0], acc[ai][bj][m][1]};
                    if (part == 0 || part == 4) {
#pragma unroll
                        for (int n = 0; n < 2; ++n)
#pragma unroll
                            for (int j = 0; j < 4; j += 2) {
                                const f32x2 x2 = {v[n][j], v[n][j + 1]}; const f32x2 t2 = x2 * -1.4426950408889634f;
                                const f32x2 d2 = (f32x2){__builtin_amdgcn_exp2f(t2.x), __builtin_amdgcn_exp2f(t2.y)} + 1.f;
                                const f32x2 o2 = x2 * (f32x2){__builtin_amdgcn_rcpf(d2.x), __builtin_amdgcn_rcpf(d2.y)}; v[n][j] = o2.x; v[n][j + 1] = o2.y; }
                    } else if (part == 1 || part == 2) {
#pragma unroll
                        for (int n = 0; n < 2; ++n)
#pragma unroll
                            for (int j = 0; j < 4; j += 2) {
                                const f32x2 l2 = {lbv[bj][n][j], lbv[bj][n][j + 1]}; const f32x2 t2 = (f32x2){v[n][j], v[n][j + 1]} * -1.4426950408889634f;
                                const f32x2 d2 = (f32x2){__builtin_amdgcn_exp2f(t2.x), __builtin_amdgcn_exp2f(t2.y)} + 1.f;
                                const f32x2 w2 = (1.f - l2) * (f32x2){__builtin_amdgcn_rcpf(d2.x), __builtin_amdgcn_rcpf(d2.y)} + l2;
                                const f32x2 o2 = (f32x2){__builtin_amdgcn_logf(w2.x), __builtin_amdgcn_logf(w2.y)} * 0.6931471805599453f; v[n][j] = o2.x; v[n][j + 1] = o2.y; }
                    } else if (rope) {
#pragma unroll
                        for (int n = 0; n < 2; ++n)
#pragma unroll
                            for (int j = 0; j < 4; j += 2) {
                                auto r0 = __builtin_amdgcn_permlane32_swap(__float_as_uint(v[n][j]), __float_as_uint(v[n][j]), false, false);
                                auto r1 = __builtin_amdgcn_permlane32_swap(__float_as_uint(v[n][j + 1]), __float_as_uint(v[n][j + 1]), false, false);
                                const f32x2 t1 = {__uint_as_float(r0[0]), __uint_as_float(r1[0])}, t2 = {__uint_as_float(r0[1]), __uint_as_float(r1[1])};
                                const f32x2 o2 = t1 * (f32x2){cs[n][j], cs[n][j + 1]} + t2 * (f32x2){sn[n][j], sn[n][j + 1]}; v[n][j] = o2.x; v[n][j + 1] = o2.y;
                            }
                    }
                    u32x4 w; w.x = pk2(v[0][0], v[0][1]); w.y = pk2(v[0][2], v[0][3]); w.z = pk2(v[1][0], v[1][1]); w.w = pk2(v[1][2], v[1][3]);
                    *(u32x4*)(rowp + bj * hstep) = w;
                }
            }
    }
};
struct EpiOut {
    static constexpr bool PERM = true, AFTER_DRAIN = false;
    const float* x; bf16_t* out; const float* mod; const float* bada;
    __device__ __forceinline__ void operator()(const f32x4 (&acc)[2][2][4][2], const Unit& u, int wr, int wc, int fr, int fq) const {
        const int row0 = u.pm * BM + wr * 64 + fr, col0 = u.pn * BM + wc * 32 + 8 * fq;
        const int b = (u.pm * BM) / 4096;
        f32x4 gv[2][2];
#pragma unroll
        for (int bj = 0; bj < 2; ++bj)
#pragma unroll
            for (int n = 0; n < 2; ++n) { const int c = col0 + bj * HALF + 4 * n; gv[bj][n] = *(const f32x4*)(mod + b * 12288 + 4096 + c) + *(const f32x4*)(bada + 4096 + c); }
#pragma unroll
        for (int ai = 0; ai < 2; ++ai)
#pragma unroll
            for (int m = 0; m < 4; ++m) { const size_t off = (size_t)(row0 + ai * HALF + m * 16) * 2048 + col0;
#pragma unroll
                for (int bj = 0; bj < 2; ++bj) {
                    const f32x4 x0 = *(const f32x4*)(x + off + bj * HALF), x1 = *(const f32x4*)(x + off + bj * HALF + 4);
                    const f32x4 r0 = x0 + gv[bj][0] * acc[ai][bj][m][0], r1 = x1 + gv[bj][1] * acc[ai][bj][m][1];
                    u32x4 w; w.x = pk2(r0.x, r0.y); w.y = pk2(r0.z, r0.w); w.z = pk2(r1.x, r1.y); w.w = pk2(r1.z, r1.w);
                    *(u32x4*)(out + off + bj * HALF) = w; } }
    }
};
struct EpiOutNorm {
    static constexpr bool PERM = true, AFTER_DRAIN = true;
    const float* x; bf16_t* x1b; bf16_t* h2; const float* mod; const float* bada; const float* gain; unsigned* xs; unsigned* cnt;
    __device__ __forceinline__ void fused(f32x4 (&acc)[2][2][4][2], const Unit& u, int wr, int wc, int fr, int fq, PG8_LAS unsigned char* lds, int wid, int lane) const {
        const int row0 = u.pm * BM + wr * 64 + fr, col0 = u.pn * BM + wc * 32 + 8 * fq;
        const int b = (u.pm * BM) / 4096, tid = wid * 64 + lane;
        PG8_LAS float* P = (PG8_LAS float*)lds;
        PG8_LAS float* SR = (PG8_LAS float*)(lds + 4096);
        f32x4 gv[2][2];
#pragma unroll
        for (int bj = 0; bj < 2; ++bj)
#pragma unroll
            for (int n = 0; n < 2; ++n) { const int c = col0 + bj * HALF + 4 * n; gv[bj][n] = *(const f32x4*)(mod + b * 12288 + 4096 + c) + *(const f32x4*)(bada + 4096 + c); }
#pragma unroll
        for (int ai = 0; ai < 2; ++ai) {
            f32x4 xv[4][2][2];
#pragma unroll
            for (int m = 0; m < 4; ++m) { const size_t off = (size_t)(row0 + ai * HALF + m * 16) * 2048 + col0;
#pragma unroll
                for (int bj = 0; bj < 2; ++bj) { xv[m][bj][0] = __builtin_nontemporal_load((const f32x4*)(x + off + bj * HALF)); xv[m][bj][1] = __builtin_nontemporal_load((const f32x4*)(x + off + bj * HALF + 4)); } }
            __builtin_amdgcn_sched_barrier(0);
#pragma unroll
            for (int m = 0; m < 4; ++m) { const size_t off = (size_t)(row0 + ai * HALF + m * 16) * 2048 + col0; float ss = 0.f;
#pragma unroll
                for (int bj = 0; bj < 2; ++bj) {
                    const f32x4 x0 = xv[m][bj][0], x1 = xv[m][bj][1];
                    const f32x4 r0 = x0 + gv[bj][0] * acc[ai][bj][m][0], r1 = x1 + gv[bj][1] * acc[ai][bj][m][1];
                    acc[ai][bj][m][0] = r0; acc[ai][bj][m][1] = r1;
                    ss += ((r0.x * r0.x + r0.y * r0.y) + (r0.z * r0.z + r0.w * r0.w)) + ((r1.x * r1.x + r1.y * r1.y) + (r1.z * r1.z + r1.w * r1.w));
                    u32x4 w; w.x = pk2(r0.x, r0.y); w.y = pk2(r0.z, r0.w); w.z = pk2(r1.x, r1.y); w.w = pk2(r1.z, r1.w);
                    *(u32x4*)(x1b + off + bj * HALF) = w; }
                ss += __shfl_xor(ss, 16); ss += __shfl_xor(ss, 32);
                if (fq == 0) P[(ai * HALF + wr * 64 + m * 16 + fr) * 4 + wc] = ss; }
        }
        asm volatile("s_waitcnt lgkmcnt(0)" ::: "memory"); __builtin_amdgcn_s_barrier(); asm volatile("" ::: "memory");
        if (tid < 256) { const float s = (P[tid * 4] + P[tid * 4 + 1]) + (P[tid * 4 + 2] + P[tid * 4 + 3]);
            __hip_atomic_store(xs + (size_t)(u.pm * 256 + tid) * 8 + u.pn, __float_as_uint(s), __ATOMIC_RELAXED, __HIP_MEMORY_SCOPE_AGENT); }
        asm volatile("s_waitcnt vmcnt(0)" ::: "memory");
        __syncthreads();
        if (tid == 0) {
            __hip_atomic_fetch_add(cnt + 64 * u.pm, 1u, __ATOMIC_RELAXED, __HIP_MEMORY_SCOPE_AGENT);
            unsigned sp = 0;
            while (__hip_atomic_load(cnt + 64 * u.pm, __ATOMIC_RELAXED, __HIP_MEMORY_SCOPE_AGENT) < 8u) { __builtin_amdgcn_s_sleep(2); if (++sp > (1u << 22)) break; }
            __builtin_amdgcn_fence(__ATOMIC_ACQUIRE, "agent");
        }
        asm volatile("s_waitcnt vmcnt(0) lgkmcnt(0)" ::: "memory"); __builtin_amdgcn_s_barrier(); asm volatile("" ::: "memory");
        if (tid < 256) { float s = 0.f;
#pragma unroll
            for (int t = 0; t < 8; ++t) s += __uint_as_float(__hip_atomic_load(xs + (size_t)(u.pm * 256 + tid) * 8 + t, __ATOMIC_RELAXED, __HIP_MEMORY_SCOPE_AGENT));
            SR[tid] = rsqrtf(s * (1.f / 2048.f) + 1e-6f); }
        asm volatile("s_waitcnt lgkmcnt(0)" ::: "memory"); __builtin_amdgcn_s_barrier(); asm volatile("" ::: "memory");
        f32x4 ga[2][2], sb[2][2];
#pragma unroll
        for (int bj = 0; bj < 2; ++bj)
#pragma unroll
            for (int n = 0; n < 2; ++n) { const int c = col0 + bj * HALF + 4 * n;
                ga[bj][n] = *(const f32x4*)(gain + c) * ((*(const f32x4*)(mod + b * 12288 + 8192 + c) + *(const f32x4*)(bada + 8192 + c)) + 1.f);
                sb[bj][n] = *(const f32x4*)(mod + b * 12288 + 6144 + c) + *(const f32x4*)(bada + 6144 + c); }
#pragma unroll
        for (int ai = 0; ai < 2; ++ai)
#pragma unroll
            for (int m = 0; m < 4; ++m) { const int rl = ai * HALF + wr * 64 + m * 16 + fr; const float rs = SR[rl]; const size_t off = (size_t)(u.pm * BM + rl) * 2048 + col0;
#pragma unroll
                for (int bj = 0; bj < 2; ++bj) { const f32x4 y0 = acc[ai][bj][m][0] * rs * ga[bj][0] + sb[bj][0], y1 = acc[ai][bj][m][1] * rs * ga[bj][1] + sb[bj][1];
                    u32x4 w; w.x = pk2(y0.x, y0.y); w.y = pk2(y0.z, y0.w); w.z = pk2(y1.x, y1.y); w.w = pk2(y1.z, y1.w);
                    *(u32x4*)(h2 + off + bj * HALF) = w; } }
    }
};
struct EpiLds {
    static constexpr bool PERM = true, AFTER_DRAIN = true;
    static constexpr int PITCH = 264;
    __device__ __forceinline__ void fused(f32x4 (&acc)[2][2][4][2], const Unit&, int wr, int wc, int fr, int fq, PG8_LAS unsigned char* lds, int, int) const {
#pragma unroll
        for (int ai = 0; ai < 2; ++ai)
#pragma unroll
            for (int m = 0; m < 4; ++m) { const int rl = ai * HALF + wr * 64 + m * 16 + fr;
#pragma unroll
                for (int bj = 0; bj < 2; ++bj) { const f32x4 r0 = acc[ai][bj][m][0], r1 = acc[ai][bj][m][1];
                    u32x4 w; w.x = pk2(r0.x, r0.y); w.y = pk2(r0.z, r0.w); w.z = pk2(r1.x, r1.y); w.w = pk2(r1.z, r1.w);
                    *(PG8_LAS u32x4*)(lds + (size_t)rl * (PITCH * 2) + (bj * HALF + wc * 32 + 8 * fq) * 2) = w; } }
    }
};
}

namespace att {
constexpr int QBLK = 32, KVBLK = 64, NT = TPB / KVBLK;
constexpr float SCALE = 0.125f, THR = 8.f;
constexpr int SHM_V = 16384, SHM_K = 16384, OFF_WS = 65536, OFF_X = 67584, XROW = 132;
#define KSWZ(row, colB) ((row) * 256 + ((colB) ^ (((row) & 7) << 4)))
__device__ __forceinline__ unsigned cvtpk(float lo, float hi) { unsigned r; asm volatile("v_cvt_pk_bf16_f32 %0, %1, %2" : "=v"(r) : "v"(lo), "v"(hi)); return r; }
constexpr float THRL = THR * 1.4426950408889634f;
__device__ __forceinline__ void partialSM(f32x16& p0, f32x16& p1, float& negm, bf16x8& qxb, float& l_reg, float& alpha, bool first) {
  float pmax, pmb = fmaxf(p0[8], p0[9]), pmc = fmaxf(p1[0], p1[1]), pmd = fmaxf(p1[8], p1[9]); pmax = fmaxf(p0[0], p0[1]);
#pragma unroll
  for (int r = 2; r < 8; ++r) { pmax = fmaxf(pmax, p0[r]); pmb = fmaxf(pmb, p0[8 + r]); pmc = fmaxf(pmc, p1[r]); pmd = fmaxf(pmd, p1[8 + r]); }
  pmax = fmaxf(fmaxf(pmax, pmb), fmaxf(pmc, pmd));
  { auto rr = __builtin_amdgcn_permlane32_swap(__float_as_uint(pmax), __float_as_uint(pmax), false, false);
    pmax = fmaxf(__uint_as_float(rr[0]), __uint_as_float(rr[1])); }
  if (__builtin_expect(!first && __all(pmax <= THRL), 1)) { alpha = 1.f; }
  else {
    const float d0 = first ? pmax : fmaxf(0.f, pmax);
    const unsigned nb = cvtpk(negm - d0, 0.f) & 0xffffu; const float nn = __uint_as_float(nb << 16), d = negm - nn;
    alpha = __builtin_amdgcn_exp2f(-d); negm = nn; l_reg *= alpha; { u32x4 w = {nb, 0u, 0u, 0u}; qxb = *reinterpret_cast<bf16x8*>(&w); }
#pragma unroll
    for (int r = 0; r < 16; ++r) { float t = p0[r]; asm volatile("v_sub_f32 %0, %0, %1" : "+v"(t) : "v"(d)); p0[r] = t; }
#pragma unroll
    for (int r = 0; r < 16; ++r) { float t = p1[r]; asm volatile("v_sub_f32 %0, %0, %1" : "+v"(t) : "v"(d)); p1[r] = t; }
  }
#pragma unroll
  for (int r = 0; r < 16; ++r) p0[r] = __builtin_amdgcn_exp2f(p0[r]);
}
__device__ __forceinline__ void finishSM(f32x16& p0, f32x16& p1, float& l_reg, bf16x8& pa0, bf16x8& pa1, bf16x8& pa2, bf16x8& pa3) {
#pragma unroll
  for (int r = 0; r < 16; ++r) p1[r] = __builtin_amdgcn_exp2f(p1[r]);
  float ps = p0[0], psb = p0[8], psc = p1[0], psd = p1[8];
#pragma unroll
  for (int r = 1; r < 8; ++r) { ps += p0[r]; psb += p0[8 + r]; psc += p1[r]; psd += p1[8 + r]; }
  ps = (ps + psb) + (psc + psd);
  { auto rr = __builtin_amdgcn_permlane32_swap(__float_as_uint(ps), __float_as_uint(ps), false, false);
    ps = __uint_as_float(rr[0]) + __uint_as_float(rr[1]); }
  l_reg += ps;
#define PK4(P, BASE, OUT) do { unsigned a0 = cvtpk(P[BASE + 0], P[BASE + 1]), a1 = cvtpk(P[BASE + 2], P[BASE + 3]);   \
    unsigned b0 = cvtpk(P[BASE + 4], P[BASE + 5]), b1 = cvtpk(P[BASE + 6], P[BASE + 7]);                              \
    auto r0 = __builtin_amdgcn_permlane32_swap(a0, b0, false, false); auto r1 = __builtin_amdgcn_permlane32_swap(a1, b1, false, false); \
    u32x4 w = {r0[0], r1[0], r0[1], r1[1]}; OUT = *reinterpret_cast<bf16x8*>(&w); } while (0)
  PK4(p0, 0, pa0); PK4(p0, 8, pa1); PK4(p1, 0, pa2); PK4(p1, 8, pa3);
#undef PK4
}
__device__ __forceinline__ void qkt(f32x16& p0, f32x16& p1, const char* Ks, const bf16x8* qr, int r32, int hi, int stb, bf16x8 koneb, bf16x8 qxb) {
  p0 = __builtin_amdgcn_mfma_f32_32x32x16_bf16(koneb, qxb, f32x16{}, 0, 0, 0); p1 = p0;
#pragma unroll
  for (int d0 = 0; d0 < 4; ++d0) { int cb = stb + (d0 * 16 + hi * 8) * 2;
    bf16x8 b0 = *reinterpret_cast<const bf16x8*>(Ks + KSWZ(r32, cb));
    bf16x8 b1 = *reinterpret_cast<const bf16x8*>(Ks + KSWZ(32 + r32, cb));
    p0 = __builtin_amdgcn_mfma_f32_32x32x16_bf16(b0, qr[d0], p0, 0, 0, 0);
    p1 = __builtin_amdgcn_mfma_f32_32x32x16_bf16(b1, qr[d0], p1, 0, 0, 0); }
}
__device__ __forceinline__ void pv_d0(f32x16* o, int vb, bf16x8 pa0, bf16x8 pa1, bf16x8 pa2, bf16x8 pa3) {
  pv_one<0>(o[0], vb, pa0, pa1, pa2, pa3); pv_one<1>(o[1], vb, pa0, pa1, pa2, pa3); pv_one<2>(o[2], vb, pa0, pa1, pa2, pa3); pv_one<3>(o[3], vb, pa0, pa1, pa2, pa3);
}
struct VSet { s16x4 l0, h0, l1, h1, l2, h2, l3, h3; };
template <int J> __device__ __forceinline__ void rv(VSet& s, int vb) {
  s.l0 = tr_read<v_rd_off(0, J, 0)>(vb); s.h0 = tr_read<v_rd_off(0, J, 1)>(vb); s.l1 = tr_read<v_rd_off(1, J, 0)>(vb); s.h1 = tr_read<v_rd_off(1, J, 1)>(vb);
  s.l2 = tr_read<v_rd_off(2, J, 0)>(vb); s.h2 = tr_read<v_rd_off(2, J, 1)>(vb); s.l3 = tr_read<v_rd_off(3, J, 0)>(vb); s.h3 = tr_read<v_rd_off(3, J, 1)>(vb);
}
__device__ __forceinline__ void xstep(f32x16* o, int vb, const VSet& A, const VSet& B, bf16x8 pa0, bf16x8 pa1, bf16x8 pa2, bf16x8 pa3, f32x16& p0, f32x16& p1, const char* Ks, const bf16x8* qr, int r32, int hi, int stb, bf16x8 koneb, bf16x8 qxb) {
#define PK(L, H) (bf16x8){L[0], L[1], L[2], L[3], H[0], H[1], H[2], H[3]}
#define MF(PA, S) do { o[0] = __builtin_amdgcn_mfma_f32_32x32x16_bf16(PK(S.l0, S.h0), PA, o[0], 0, 0, 0); o[1] = __builtin_amdgcn_mfma_f32_32x32x16_bf16(PK(S.l1, S.h1), PA, o[1], 0, 0, 0); \
                       o[2] = __builtin_amdgcn_mfma_f32_32x32x16_bf16(PK(S.l2, S.h2), PA, o[2], 0, 0, 0); o[3] = __builtin_amdgcn_mfma_f32_32x32x16_bf16(PK(S.l3, S.h3), PA, o[3], 0, 0, 0); } while (0)
#define LW(n) do { asm volatile("s_waitcnt lgkmcnt(" #n ")" ::: "memory"); SBAR(); } while (0)
#define KF(d0, rowoff) (*reinterpret_cast<const bf16x8*>(Ks + KSWZ((rowoff) + r32, stb + ((d0) * 16 + hi * 8) * 2)))
  VSet C, D;
  LW(8); MF(pa0, A); SBAR();
  rv<2>(C, vb);
  LW(8); MF(pa1, B); SBAR();
  rv<3>(D, vb);
  LW(8); MF(pa2, C); SBAR();
  const bf16x8 k00 = KF(0, 0), k01 = KF(0, 32), k10 = KF(1, 0), k11 = KF(1, 32);
  LW(4); MF(pa3, D); SBAR();
  const bf16x8 k20 = KF(2, 0), k21 = KF(2, 32), k30 = KF(3, 0), k31 = KF(3, 32);
  p0 = __builtin_amdgcn_mfma_f32_32x32x16_bf16(koneb, qxb, f32x16{}, 0, 0, 0); p1 = p0;
  p0 = __builtin_amdgcn_mfma_f32_32x32x16_bf16(k00, qr[0], p0, 0, 0, 0); p1 = __builtin_amdgcn_mfma_f32_32x32x16_bf16(k01, qr[0], p1, 0, 0, 0);
  p0 = __builtin_amdgcn_mfma_f32_32x32x16_bf16(k10, qr[1], p0, 0, 0, 0); p1 = __builtin_amdgcn_mfma_f32_32x32x16_bf16(k11, qr[1], p1, 0, 0, 0);
  p0 = __builtin_amdgcn_mfma_f32_32x32x16_bf16(k20, qr[2], p0, 0, 0, 0); p1 = __builtin_amdgcn_mfma_f32_32x32x16_bf16(k21, qr[2], p1, 0, 0, 0);
  p0 = __builtin_amdgcn_mfma_f32_32x32x16_bf16(k30, qr[3], p0, 0, 0, 0); p1 = __builtin_amdgcn_mfma_f32_32x32x16_bf16(k31, qr[3], p1, 0, 0, 0);
#undef PK
#undef MF
#undef LW
#undef KF
}
__device__ __forceinline__ void attn_unit(const bf16_t* __restrict__ parts, const bf16_t* __restrict__ khp, const bf16_t* __restrict__ vhp, bf16_t* __restrict__ mix, const float* __restrict__ subg, float lam, int b, int h, int qb, char* lds) {
  const int tid = threadIdx.x, wid = tid >> 6, lane = tid & 63, r32 = lane & 31, hi = lane >> 5;
  const int st = __builtin_amdgcn_readfirstlane(wid >> 2), rb = wid & 3;
  char* V_lds = lds; char* K_lds = lds + 2 * SHM_V;
  float* ws = (float*)(lds + OFF_WS) + wid * 64; float* li_l = ws; float* al_l = ws + 32;
  float negm = 0.f, l_reg = 0; f32x16 o[4] = {}; bf16x8 qr[4];
  bf16x8 koneb, qxb; { u32x4 w = {hi == 0 ? 0x3F80u : 0u, 0u, 0u, 0u}; koneb = *reinterpret_cast<bf16x8*>(&w); u32x4 z = {0u, 0u, 0u, 0u}; qxb = *reinterpret_cast<bf16x8*>(&z); }
  const bf16_t* Kh = khp + (size_t)(b * 8 + h) * TPB * 128;
  const bf16_t* Vh = vhp + (size_t)(b * 8 + h) * TPB * 128;
  const bf16_t* Qw = parts + ((size_t)b * TPB + CTX + qb * 128 + rb * QBLK + r32) * NIN + C_DQ + h * 128 + st * 64 + hi * 8;
#pragma unroll
  for (int d0 = 0; d0 < 4; ++d0) qr[d0] = *reinterpret_cast<const bf16x8*>(Qw + d0 * 16);
  const int stb = st * 128;
  const int sr = tid >> 4, sc = (tid & 15) * 8, vst0 = v_st(sr, sc), vst1 = v_st(32 + sr, sc);
  const int vb0 = (int)(uintptr_t)V_lds + v_rd_base(lane);
  bf16x8 vs0, vs1, ks0, ks1;
#define LOADV(k0) do { vs0 = *reinterpret_cast<const bf16x8*>(&Vh[(size_t)((k0) + sr) * 128 + sc]); vs1 = *reinterpret_cast<const bf16x8*>(&Vh[(size_t)((k0) + 32 + sr) * 128 + sc]); } while (0)
#define LOADK(k0) do { ks0 = *reinterpret_cast<const bf16x8*>(&Kh[(size_t)((k0) + sr) * 128 + sc]); ks1 = *reinterpret_cast<const bf16x8*>(&Kh[(size_t)((k0) + 32 + sr) * 128 + sc]); } while (0)
#define WRITEV(bb) do { *(bf16x8*)(V_lds + (bb) * SHM_V + vst0) = vs0; *(bf16x8*)(V_lds + (bb) * SHM_V + vst1) = vs1; } while (0)
#define WRITEK(bb) do { int kc = sc * 2; *(bf16x8*)(K_lds + (bb) * SHM_K + KSWZ(sr, kc)) = ks0; *(bf16x8*)(K_lds + (bb) * SHM_K + KSWZ(32 + sr, kc)) = ks1; } while (0)
#define VMW() asm volatile("s_waitcnt vmcnt(0)" ::: "memory")
#define RESC(a) do { if (__any((a) < 1.f)) { _Pragma("unroll") for (int d = 0; d < 4; ++d) _Pragma("unroll") for (int r = 0; r < 16; ++r) o[d][r] *= (a); } } while (0)
#define STAGE(k, VS) do { VMW(); WRITEV(1 - (VS)); WRITEK(VS);                                                                                  \
    const int tv = (k) + 2 < NT ? (k) + 2 : NT - 1, tk = (k) + 3 < NT ? (k) + 3 : NT - 1; LOADV(tv * KVBLK); LOADK(tk * KVBLK); } while (0)
#define BARR() do { SBAR(); __syncthreads(); SBAR(); } while (0)
#define PERIOD(k, VS, first) do {                                                                                                            \
    if (st == 1) STAGE(k, VS);                                                                                                               \
    { float al; partialSM(p0, p1, negm, qxb, l_reg, al, first); RESC(al); finishSM(p0, p1, l_reg, pa0, pa1, pa2, pa3); }                          \
    BARR();                                                                                                                                  \
    if (st == 0) STAGE(k, VS);                                                                                                               \
    VSet va, vb_; rv<0>(va, vb0 + (VS) * SHM_V); rv<1>(vb_, vb0 + (VS) * SHM_V); SBAR();                                                     \
    xstep(o, vb0 + (VS) * SHM_V, va, vb_, pa0, pa1, pa2, pa3, p0, p1, K_lds + (1 - (VS)) * SHM_K, qr, r32, hi, stb, koneb, qxb);    \
    BARR(); } while (0)
  f32x16 p0, p1; bf16x8 pa0, pa1, pa2, pa3;
  LOADV(0); LOADK(0); VMW(); WRITEV(0); WRITEK(0);
  LOADK(KVBLK); VMW(); WRITEK(1);
  LOADV(KVBLK); LOADK(2 * KVBLK);
  __syncthreads();
  if (st == 1) BARR();
  qkt(p0, p1, K_lds, qr, r32, hi, stb, koneb, qxb);
  BARR();
  PERIOD(0, 0, true); PERIOD(1, 1, false);
  for (int k = 2; k < NT; k += 2) { PERIOD(k, 0, false); PERIOD(k + 1, 1, false); }
  if (st == 0) BARR();
#undef PERIOD
#undef STAGE
#undef BARR
#undef LOADV
#undef LOADK
#undef WRITEV
#undef WRITEK
#undef VMW
  const float rl = __builtin_amdgcn_rcpf(l_reg);
  float* X = (float*)(lds + OFF_X) + (32 * rb + r32) * XROW + 4 * hi;
  if (st == 1) { const float sc2 = rl * lam;
#pragma unroll
    for (int d0 = 0; d0 < 4; ++d0)
#pragma unroll
      for (int g = 0; g < 4; ++g) *(f32x4*)(X + 32 * d0 + 8 * g) = (f32x4){o[d0][4 * g] * sc2, o[d0][4 * g + 1] * sc2, o[d0][4 * g + 2] * sc2, o[d0][4 * g + 3] * sc2};
  }
  __syncthreads();
  if (st == 0) {
    float ss = 0.f;
#pragma unroll
    for (int d0 = 0; d0 < 4; ++d0)
#pragma unroll
      for (int g = 0; g < 4; ++g) { const f32x4 x = *(const f32x4*)(X + 32 * d0 + 8 * g);
#pragma unroll
        for (int e = 0; e < 4; ++e) { const float v = o[d0][4 * g + e] * rl - x[e]; o[d0][4 * g + e] = v; ss += v * v; } }
    { auto rr = __builtin_amdgcn_permlane32_swap(__float_as_uint(ss), __float_as_uint(ss), false, false); ss = __uint_as_float(rr[0]) + __uint_as_float(rr[1]); }
    const float rs = rsqrtf(ss * (1.f / 128.f) + RMS_EPS) * 0.8f;
    const float* gp = subg + h * 128 + 4 * hi;
    bf16_t* mo = mix + ((size_t)b * SEQ + qb * 128 + rb * QBLK + r32) * D + 1024 + h * 128 + 8 * hi;
#pragma unroll
    for (int d0 = 0; d0 < 4; ++d0)
#pragma unroll
      for (int g = 0; g < 4; g += 2) {
        const f32x4 ga = *(const f32x4*)(gp + 32 * d0 + 8 * g) * rs, gb = *(const f32x4*)(gp + 32 * d0 + 8 * g + 8) * rs;
        unsigned a0 = pk2(o[d0][4 * g] * ga.x, o[d0][4 * g + 1] * ga.y), a1 = pk2(o[d0][4 * g + 2] * ga.z, o[d0][4 * g + 3] * ga.w);
        unsigned b0 = pk2(o[d0][4 * g + 4] * gb.x, o[d0][4 * g + 5] * gb.y), b1 = pk2(o[d0][4 * g + 6] * gb.z, o[d0][4 * g + 7] * gb.w);
        auto r0 = __builtin_amdgcn_permlane32_swap(a0, b0, false, false); auto r1 = __builtin_amdgcn_permlane32_swap(a1, b1, false, false);
        *(u32x4*)(mo + 32 * d0 + 8 * g) = (u32x4){r0[0], r1[0], r0[1], r1[1]};
      }
  }
  __syncthreads();
#undef RESC
}
}

namespace hg {
#define LBAR() do { asm volatile("s_waitcnt lgkmcnt(0)" ::: "memory"); __builtin_amdgcn_s_barrier(); asm volatile("" ::: "memory"); } while (0)
constexpr int O_V = 0, O_QR = 16384, O_KR = 33792, O_KT = 51200, O_PL = 69632, O_ST = 78848, O_TAB = 113664, O_RS = 119296;
constexpr int RQ = 272, RT = 144;

struct ChunkRaw { unsigned lf[8], q[8]; bf16x8 v0, v1; };
template <bool WITH_Q> __device__ __forceinline__ void elem_load(ChunkRaw& R, const bf16_t* __restrict__ parts, size_t r0, int h, int dir, int tid) {
    const int dkp = tid & 63, q8 = tid >> 6;
    const bf16_t* plf = parts + (r0 + 8 * q8) * NIN + (dir ? C_FB : C_FF) + h * 128 + 2 * dkp;
#pragma unroll
    for (int i = 0; i < 8; ++i) R.lf[i] = *(const unsigned*)(plf + (size_t)i * NIN);
    if (WITH_Q) { const bf16_t* pq = parts + (r0 + 8 * q8) * NIN + C_HQ + h * 128 + 2 * dkp;
#pragma unroll
        for (int i = 0; i < 8; ++i) R.q[i] = *(const unsigned*)(pq + (size_t)i * NIN); }
    const int sr = tid >> 4, scn = (tid & 15) * 8;
    R.v0 = *(const bf16x8*)(parts + (r0 + sr) * NIN + C_HI + h * 128 + scn); R.v1 = *(const bf16x8*)(parts + (r0 + 32 + sr) * NIN + C_HI + h * 128 + scn);
}
template <bool WITH_Q> __device__ __forceinline__ f32x2 elem_stage(const ChunkRaw& R, int dir, char* lds, int tid) {
    constexpr float L2E = 1.4426950408889634f;
    const int dkp = tid & 63, q8 = tid >> 6;
    f32x2 lfv[8], cum[8];
#pragma unroll
    for (int i = 0; i < 8; ++i) lfv[i] = (f32x2){__uint_as_float(R.lf[i] << 16), __uint_as_float(R.lf[i] & 0xffff0000u)};
    const int sr = tid >> 4, scn = (tid & 15) * 8;
    f32x2 run = {0.f, 0.f};
    if (dir == 0) {
#pragma unroll
        for (int i = 0; i < 8; ++i) { run += lfv[i]; cum[i] = run; }
    } else {
#pragma unroll
        for (int i = 7; i >= 0; --i) { run += lfv[i]; cum[i] = run; }
    }
    float* TAB = (float*)(lds + O_TAB);
    *(f32x2*)(TAB + q8 * 128 + 2 * dkp) = run;
    *(bf16x8*)(lds + O_V + v_st(sr, scn)) = R.v0; *(bf16x8*)(lds + O_V + v_st(32 + sr, scn)) = R.v1;
    LBAR();
    f32x2 sg[8];
#pragma unroll
    for (int j = 0; j < 8; ++j) sg[j] = *(const f32x2*)(TAB + j * 128 + 2 * dkp);
    const f32x2 lo4 = (sg[0] + sg[1]) + (sg[2] + sg[3]), hi4 = (sg[4] + sg[5]) + (sg[6] + sg[7]);
    const f32x2 total = lo4 + hi4;
    f32x2 off = {0.f, 0.f};
#pragma unroll
    for (int j = 0; j < 8; ++j) { const bool take = dir == 0 ? (j < q8) : (j > q8); if (take) off += sg[j]; }
    const f32x2 ref = dir == 0 ? lo4 : hi4;
    const f32x2 rmo = (ref - off) * L2E, omr = (off - ref) * L2E;
    unsigned kp[2][4];
#pragma unroll
    for (int i = 0; i < 8; i += 2) {
        f32x2 kk[2];
#pragma unroll
        for (int e = 0; e < 2; ++e) {
            const f32x2 a2 = lfv[i + e] * L2E, b2 = rmo - cum[i + e] * L2E;
            const f32x2 ea = {__builtin_amdgcn_exp2f(a2.x), __builtin_amdgcn_exp2f(a2.y)}, eb = {__builtin_amdgcn_exp2f(b2.x), __builtin_amdgcn_exp2f(b2.y)};
            kk[e] = (1.f - ea) * eb;
        }
        kp[0][i >> 1] = pk2(kk[0].x, kk[1].x); kp[1][i >> 1] = pk2(kk[0].y, kk[1].y);
        if (WITH_Q) {
#pragma unroll
            for (int e = 0; e < 2; ++e) { const int s = 8 * q8 + i + e;
                *(unsigned*)(lds + O_KR + s * RQ + dkp * 4) = pk2(kk[e].x, kk[e].y);
                const f32x2 c2 = cum[i + e] * L2E + omr;
                const f32x2 qv = (f32x2){__uint_as_float(R.q[i + e] << 16), __uint_as_float(R.q[i + e] & 0xffff0000u)} * (f32x2){__builtin_amdgcn_exp2f(c2.x), __builtin_amdgcn_exp2f(c2.y)};
                *(unsigned*)(lds + O_QR + s * RQ + dkp * 4) = pk2(qv.x, qv.y); }
        }
    }
    *(u32x4*)(lds + O_KT + (2 * dkp) * RT + q8 * 16) = (u32x4){kp[0][0], kp[0][1], kp[0][2], kp[0][3]};
    *(u32x4*)(lds + O_KT + (2 * dkp + 1) * RT + q8 * 16) = (u32x4){kp[1][0], kp[1][1], kp[1][2], kp[1][3]};
    if (q8 == 0) { *(f32x2*)(TAB + 1024 + 2 * dkp) = (f32x2){__expf(ref[0]), __expf(ref[1])}; *(f32x2*)(TAB + 1152 + 2 * dkp) = (f32x2){__expf(total[0]), __expf(total[1])};
                   *(f32x2*)(TAB + 1280 + 2 * dkp) = (f32x2){__expf(total[0] - ref[0]), __expf(total[1] - ref[1])}; }
    return total;
}
__device__ __forceinline__ void state_update(f32x16 (&S)[2], const char* lds, int mt, int nt0, int r32, int hi, int vb) {
    const float* TAB = (const float*)(lds + O_TAB);
    float el[16], er[16];
#pragma unroll
    for (int r = 0; r < 16; ++r) { const int d = 32 * mt + crow(r, hi); el[r] = TAB[1152 + d]; er[r] = TAB[1280 + d]; }
    bf16x8 kt[4];
#pragma unroll
    for (int ks = 0; ks < 4; ++ks) kt[ks] = *(const bf16x8*)(lds + O_KT + (32 * mt + r32) * RT + (16 * ks + 8 * hi) * 2);
#pragma unroll
    for (int t2 = 0; t2 < 2; ++t2) { f32x16 U = {}; pv_one<0>(U, vb + (nt0 + t2) * 512, kt[0], kt[1], kt[2], kt[3]);
#pragma unroll
        for (int r = 0; r < 16; ++r) S[t2][r] = el[r] * S[t2][r] + er[r] * U[r]; }
}
__device__ __forceinline__ void task_trans(const bf16_t* __restrict__ parts, float* __restrict__ hst, float* __restrict__ hd, int b, int h, int dir, int j, char* lds) {
    const int tid = threadIdx.x, wid = tid >> 6, lane = tid & 63, r32 = lane & 31, hi = lane >> 5, mt = wid >> 1, nt0 = 2 * (wid & 1);
    const int p0 = (j == 0) ? 0 : CTX + 256 * (dir == 0 ? j - 1 : 16 - j);
    const int vb = (int)(uintptr_t)(lds + O_V) + v_rd_base(lane);
    f32x16 S[2] = {}; f32x2 lsum = {0.f, 0.f};
    ChunkRaw R; elem_load<false>(R, parts, (size_t)b * TPB + p0 + 64 * (dir ? 3 : 0), h, dir, tid);
    for (int cc = 0; cc < 4; ++cc) {
        lsum += elem_stage<false>(R, dir, lds, tid);
        if (cc < 3) elem_load<false>(R, parts, (size_t)b * TPB + p0 + 64 * (dir ? 2 - cc : cc + 1), h, dir, tid);
        LBAR();
        state_update(S, lds, mt, nt0, r32, hi, vb);
        LBAR();
    }
    const int chain = (b * 8 + h) * 2 + dir;
    float* sp = hst + (size_t)(chain * 16 + j) * 16384;
#pragma unroll
    for (int t2 = 0; t2 < 2; ++t2)
#pragma unroll
        for (int r = 0; r < 16; ++r)
            __hip_atomic_store((unsigned*)&sp[(32 * mt + crow(r, hi)) * 128 + 32 * (nt0 + t2) + r32], __float_as_uint(S[t2][r]), __ATOMIC_RELAXED, __HIP_MEMORY_SCOPE_AGENT);
    if (tid < 64) { unsigned* hp = (unsigned*)(hd + (chain * 16 + j) * 128 + 2 * tid);
        __hip_atomic_store(hp, __float_as_uint(__expf(lsum[0])), __ATOMIC_RELAXED, __HIP_MEMORY_SCOPE_AGENT); __hip_atomic_store(hp + 1, __float_as_uint(__expf(lsum[1])), __ATOMIC_RELAXED, __HIP_MEMORY_SCOPE_AGENT); }
}
__device__ __forceinline__ void scan_phase(float* __restrict__ hst, const float* __restrict__ hd, int vcu, int G, int tid) {
    for (int idx = vcu * NTHR + tid; idx < 32 * 4096; idx += G * NTHR) {
        const int chain = idx >> 12, e4 = idx & 4095, dk = e4 >> 5;
        f32x4 S = {0.f, 0.f, 0.f, 0.f};
        float* p = hst + (size_t)chain * 16 * 16384 + e4 * 4;
        f32x4 u[16]; float d[16];
#pragma unroll
        for (int j = 0; j < 16; ++j) { u[j] = *(const f32x4*)(p + (size_t)j * 16384); d[j] = hd[(chain * 16 + j) * 128 + dk]; }
#pragma unroll
        for (int j = 0; j < 16; ++j) { S = S * d[j] + u[j]; *(f32x4*)(p + (size_t)j * 16384) = S; }
    }
}
__device__ __forceinline__ void task_out(const bf16_t* __restrict__ parts, bf16_t* __restrict__ mix, const float* __restrict__ hst, float* __restrict__ of, const float* __restrict__ ng,
                                         int b, int h, int sc, char* lds) {
    const int tid = threadIdx.x, wid = tid >> 6, lane = tid & 63, r32 = lane & 31, hi = lane >> 5;
    const int mt = wid >> 1, nt0 = 2 * (wid & 1), rt = wid >> 2, ct = wid & 3;
    const int vb = (int)(uintptr_t)(lds + O_V) + v_rd_base(lane);
    const float* TAB = (const float*)(lds + O_TAB);
    ChunkRaw R; elem_load<true>(R, parts, (size_t)b * TPB + CTX + 256 * sc, h, 0, tid);
    for (int dir = 0; dir < 2; ++dir) {
        const int chain = (b * 8 + h) * 2 + dir, jj = dir == 0 ? sc : 15 - sc;
        const float* sp = hst + (size_t)(chain * 16 + jj) * 16384;
        f32x16 S[2];
#pragma unroll
        for (int t2 = 0; t2 < 2; ++t2)
#pragma unroll
            for (int r = 0; r < 16; ++r) S[t2][r] = sp[(32 * mt + crow(r, hi)) * 128 + 32 * (nt0 + t2) + r32];
#pragma unroll
        for (int t2 = 0; t2 < 2; ++t2)
#pragma unroll
            for (int r = 0; r < 16; ++r) asm volatile("" : "+v"(S[t2][r]));
        for (int cc = 0; cc < 4; ++cc) {
            const int c = dir ? 3 - cc : cc;
            elem_stage<true>(R, dir, lds, tid);
            { const int step = dir * 4 + cc + 1;
              if (step < 8) { const int nd = step >> 2, nc = nd ? 3 - (step & 3) : (step & 3); elem_load<true>(R, parts, (size_t)b * TPB + CTX + 256 * sc + 64 * nc, h, nd, tid); } }
            float* ofp = of + ((((size_t)(b * 8 + h) * 16 + sc) * 4 + c) * 8 + wid) * 1024 + lane;
            LBAR();
            {
                float ef[16];
#pragma unroll
                for (int r = 0; r < 16; ++r) ef[r] = TAB[1024 + 32 * mt + crow(r, hi)];
#pragma unroll
                for (int t2 = 0; t2 < 2; ++t2)
#pragma unroll
                    for (int g = 0; g < 4; ++g) { u32x2 w; w.x = pk2(S[t2][4 * g] * ef[4 * g], S[t2][4 * g + 1] * ef[4 * g + 1]); w.y = pk2(S[t2][4 * g + 2] * ef[4 * g + 2], S[t2][4 * g + 3] * ef[4 * g + 3]);
                        *(u32x2*)(lds + O_ST + (32 * (nt0 + t2) + r32) * RQ + (32 * mt + 8 * g + 4 * hi) * 2) = w; }
            }
            if (wid < 4) {
                const int si = wid >> 1, ti = wid & 1;
                f32x16 P = {};
#pragma unroll
                for (int ks = 0; ks < 8; ++ks) {
                    const bf16x8 ka = *(const bf16x8*)(lds + O_KR + (32 * si + r32) * RQ + (16 * ks + 8 * hi) * 2);
                    const bf16x8 qb = *(const bf16x8*)(lds + O_QR + (32 * ti + r32) * RQ + (16 * ks + 8 * hi) * 2);
                    P = __builtin_amdgcn_mfma_f32_32x32x16_bf16(ka, qb, P, 0, 0, 0);
                }
                const int t = 32 * ti + r32;
#pragma unroll
                for (int g = 0; g < 4; ++g) {
                    float pv[4];
#pragma unroll
                    for (int e = 0; e < 4; ++e) { const int s = 32 * si + 8 * g + 4 * hi + e; const bool keep = dir == 0 ? (s <= t) : (s >= t); pv[e] = keep ? P[4 * g + e] : 0.f; }
                    u32x2 w; w.x = pk2(pv[0], pv[1]); w.y = pk2(pv[2], pv[3]);
                    *(u32x2*)(lds + O_PL + t * RT + (32 * si + 8 * g + 4 * hi) * 2) = w;
                }
            }
            LBAR();
            f32x16 o = {};
            {
                bf16x8 pa[4];
#pragma unroll
                for (int ks = 0; ks < 4; ++ks) pa[ks] = *(const bf16x8*)(lds + O_PL + (32 * rt + r32) * RT + (16 * ks + 8 * hi) * 2);
                pv_one<0>(o, vb + ct * 512, pa[0], pa[1], pa[2], pa[3]);
#pragma unroll
                for (int ks = 0; ks < 8; ++ks) {
                    const bf16x8 qa = *(const bf16x8*)(lds + O_QR + (32 * rt + r32) * RQ + (16 * ks + 8 * hi) * 2);
                    const bf16x8 sb = *(const bf16x8*)(lds + O_ST + (32 * ct + r32) * RQ + (16 * ks + 8 * hi) * 2);
                    o = __builtin_amdgcn_mfma_f32_32x32x16_bf16(qa, sb, o, 0, 0, 0);
                }
            }
            __builtin_amdgcn_sched_barrier(0);
            float ofv[16];
            if (dir == 1) {
#pragma unroll
                for (int r = 0; r < 16; ++r) ofv[r] = ofp[r * 64];
            }
            __builtin_amdgcn_sched_barrier(0);
            state_update(S, lds, mt, nt0, r32, hi, vb);
            if (dir == 0) {
#pragma unroll
                for (int r = 0; r < 16; ++r) ofp[r * 64] = o[r];
                LBAR();
            } else {
                float* OT = (float*)(lds + O_RS);
#pragma unroll
                for (int r = 0; r < 16; ++r) OT[(32 * rt + crow(r, hi)) * 132 + 32 * ct + r32] = o[r] + ofv[r];
                LBAR();
                const int row = tid >> 3, seg = tid & 7;
                f32x4 x[4]; float ss = 0.f;
#pragma unroll
                for (int q = 0; q < 4; ++q) { x[q] = *(const f32x4*)(OT + row * 132 + 16 * seg + 4 * q); ss += (x[q].x * x[q].x + x[q].y * x[q].y) + (x[q].z * x[q].z + x[q].w * x[q].w); }
                ss += __shfl_xor(ss, 1); ss += __shfl_xor(ss, 2); ss += __shfl_xor(ss, 4);
                const float rs = rsqrtf(ss * (1.f / 128.f) + RMS_EPS);
                const int trow = 256 * sc + 64 * c + row;
                const bf16_t* gp = parts + ((size_t)b * TPB + CTX + trow) * NIN + C_HG + h * 128 + 16 * seg;
                const u32x4 g0 = *(const u32x4*)gp, g1 = *(const u32x4*)(gp + 8);
                const float* ngp = ng + h * 128 + 16 * seg;
                const f32x4 n0 = *(const f32x4*)ngp * rs, n1 = *(const f32x4*)(ngp + 4) * rs, n2 = *(const f32x4*)(ngp + 8) * rs, n3 = *(const f32x4*)(ngp + 12) * rs;
                u32x4 w0, w1;
#define GLO(w) __uint_as_float((w) << 16)
#define GHI(w) __uint_as_float((w) & 0xffff0000u)
                w0.x = pk2(x[0].x * n0.x * GLO(g0.x), x[0].y * n0.y * GHI(g0.x)); w0.y = pk2(x[0].z * n0.z * GLO(g0.y), x[0].w * n0.w * GHI(g0.y));
                w0.z = pk2(x[1].x * n1.x * GLO(g0.z), x[1].y * n1.y * GHI(g0.z)); w0.w = pk2(x[1].z * n1.z * GLO(g0.w), x[1].w * n1.w * GHI(g0.w));
                w1.x = pk2(x[2].x * n2.x * GLO(g1.x), x[2].y * n2.y * GHI(g1.x)); w1.y = pk2(x[2].z * n2.z * GLO(g1.y), x[2].w * n2.w * GHI(g1.y));
                w1.z = pk2(x[3].x * n3.x * GLO(g1.z), x[3].y * n3.y * GHI(g1.z)); w1.w = pk2(x[3].z * n3.z * GLO(g1.w), x[3].w * n3.w * GHI(g1.w));
#undef GLO
#undef GHI
                bf16_t* mo = mix + ((size_t)(b * SEQ + trow)) * D + h * 128 + 16 * seg;
                *(u32x4*)mo = w0; *(u32x4*)(mo + 8) = w1;
            }
        }
    }
    LBAR();
}
#undef LBAR
}

namespace tk {
constexpr int LKP = 17;
__device__ __forceinline__ unsigned umax_(unsigned a, unsigned b) { return a > b ? a : b; }
__device__ __forceinline__ unsigned umin_(unsigned a, unsigned b) { return a < b ? a : b; }
__device__ __forceinline__ unsigned f2key(float s) { const unsigned b = __float_as_uint(s); return b ^ ((unsigned)((int)b >> 31) | 0x80000000u); }
__device__ __forceinline__ float key2f(unsigned k) { return __uint_as_float(k ^ (~(unsigned)((int)k >> 31) | 0x80000000u)); }
template <int N> __device__ __forceinline__ void sort_desc(unsigned (&a)[N]) {
#pragma unroll
    for (int k = 2; k <= N; k <<= 1)
#pragma unroll
        for (int j = k >> 1; j > 0; j >>= 1)
#pragma unroll
            for (int i = 0; i < N; ++i) { const int l = i ^ j; if (l > i) { const bool desc = ((i & k) == 0); const unsigned mx = umax_(a[i], a[l]), mn = umin_(a[i], a[l]); a[i] = desc ? mx : mn; a[l] = desc ? mn : mx; } }
}
__device__ __forceinline__ void merge16(unsigned (&a)[16], const unsigned (&b)[16]) {
#pragma unroll
    for (int i = 0; i < 16; ++i) a[i] = umax_(a[i], b[15 - i]);
#pragma unroll
    for (int j = 8; j > 0; j >>= 1)
#pragma unroll
        for (int i = 0; i < 16; ++i) { const int l = i ^ j; if (l > i) { const unsigned mx = umax_(a[i], a[l]), mn = umin_(a[i], a[l]); a[i] = mx; a[l] = mn; } }
}
__device__ __forceinline__ void task(const bf16_t* qbase  , int qpitch, const bf16_t* __restrict__ keys, int* __restrict__ idx, float* __restrict__ coef, int tb, int h, char* lds) {
    const int tid = threadIdx.x, wid = tid >> 6, lane = tid & 63, r32 = lane & 31, hi = lane >> 5;
    unsigned* LK = (unsigned*)lds;
    int* CT = (int*)(lds + 2 * 128 * LKP * 4);
    if (tid < 64) {
        const int cnt[16] = {16, 8, 5, 4, 3, 2, 2, 2, 1, 1, 1, 1, 1, 1, 1, 1};
        int a = 0, base = 0, found = 0, fa = 0, fb = 0;
#pragma unroll
        for (a = 0; a < 16; ++a) { const bool in = !found && tid < base + cnt[a]; fa = in ? a : fa; fb = in ? tid - base : fb; found |= in; base += cnt[a]; }
        CT[tid] = found ? (fa | (fb << 8) | 0x10000) : 0; }
    {
        const int tt = wid & 3, j = wid >> 2;
        bf16x8 qb[8];
        const bf16_t* qrow = qbase + (size_t)(32 * tt + r32) * qpitch + j * 128 + 8 * hi;
#pragma unroll
        for (int ks = 0; ks < 8; ++ks) qb[ks] = *(const bf16x8*)(qrow + 16 * ks);
        unsigned g[4][16];
        {
            bf16x8 ka[4][8];
#pragma unroll
            for (int kt = 0; kt < 4; ++kt) { const bf16_t* kp = keys + (size_t)((h * 2 + j) * 128 + 32 * kt + r32) * 128 + 8 * hi;
#pragma unroll
                for (int ks = 0; ks < 8; ++ks) ka[kt][ks] = *(const bf16x8*)(kp + 16 * ks); }
            __builtin_amdgcn_sched_barrier(0);
#pragma unroll
            for (int kt = 0; kt < 4; ++kt) {
                f32x16 acc = {};
#pragma unroll
                for (int ks = 0; ks < 8; ++ks) acc = __builtin_amdgcn_mfma_f32_32x32x16_bf16(ka[kt][ks], qb[ks], acc, 0, 0, 0);
#pragma unroll
                for (int r = 0; r < 16; ++r) g[kt][r] = (f2key(acc[r]) & ~127u) | (unsigned)(127 - 32 * kt - (r & 3) - 8 * (r >> 2) - 4 * hi);
            }
        }
#pragma unroll
        for (int kt = 0; kt < 4; ++kt) sort_desc<16>(g[kt]);
        merge16(g[0], g[1]); merge16(g[2], g[3]); merge16(g[0], g[2]);
        unsigned o[16];
#pragma unroll
        for (int i = 0; i < 16; ++i) o[i] = (unsigned)__shfl_xor((int)g[0][i], 32);
        merge16(g[0], o);
        if (hi == 0) {
#pragma unroll
            for (int i = 0; i < 16; ++i) LK[(j * 128 + 32 * tt + r32) * LKP + i] = g[0][i]; }
    }
    __syncthreads();
    {
        const int token = tid >> 2, q = tid & 3;
        const unsigned* k1 = LK + token * LKP; const unsigned* k2 = LK + (128 + token) * LKP;
        unsigned cand[16];
#pragma unroll
        for (int i = 0; i < 16; ++i) {
            const int ct = CT[16 * q + i]; const int a = ct & 255, b = (ct >> 8) & 255;
            const float v = key2f(k1[a] & ~127u) + key2f(k2[b] & ~127u);
            const unsigned ck_ = (f2key(v) & ~255u) | (unsigned)(255 - (a * 16 + b));
            cand[i] = (ct & 0x10000) ? ck_ : 0u;
        }
        sort_desc<16>(cand);
        unsigned o[16];
#pragma unroll
        for (int i = 0; i < 16; ++i) o[i] = (unsigned)__shfl_xor((int)cand[i], 1);
        merge16(cand, o);
#pragma unroll
        for (int i = 0; i < 16; ++i) o[i] = (unsigned)__shfl_xor((int)cand[i], 2);
        merge16(cand, o);
        float e[16], sum = 0.f; const float m = key2f(cand[0] & ~255u);
#pragma unroll
        for (int i = 0; i < 16; ++i) { e[i] = __expf(key2f(cand[i] & ~255u) - m); sum += e[i]; }
        const float inv = 1.f / sum;
        i32x4 oi; f32x4 oc;
#pragma unroll
        for (int kk = 0; kk < 4; ++kk) {
            const unsigned ck = q == 0 ? cand[kk] : q == 1 ? cand[4 + kk] : q == 2 ? cand[8 + kk] : cand[12 + kk];
            const float ek = q == 0 ? e[kk] : q == 1 ? e[4 + kk] : q == 2 ? e[8 + kk] : e[12 + kk];
            const int flat = 255 - (int)(ck & 255u);
            const int i1 = 127 - (int)(k1[flat >> 4] & 127u), i2 = 127 - (int)(k2[flat & 15] & 127u);
            oi[kk] = i1 * 128 + i2; oc[kk] = ek * inv;
        }
        const size_t ob = ((size_t)(tb * 128 + token) * 8 + h) * 16 + 4 * q;
        *(i32x4*)(idx + ob) = oi; *(f32x4*)(coef + ob) = oc;
    }
    __syncthreads();
}
}

namespace pe {
constexpr size_t CHB = (size_t)NEXP * 128;
static_assert(CHB == (1u << 21), "chunk stride");
constexpr size_t WS_UQ = WS_UBF, WS_VQ = WS_VBF, WS_SU = WS_SMALL + 65536, WS_SV = WS_SMALL + 131072;
__device__ __forceinline__ float gelu_erf(float v) {
    const float av = fabsf(v), t = __builtin_amdgcn_rcpf(av * 0.2316418882f + 1.0f);
    float q = t * 0.5307027145f + (-0.7265760135f); q = q * t + 0.7107068705f; q = q * t + (-0.142248368f); q = q * t + 0.127414796f; q = q * t;
    const float e = __builtin_amdgcn_exp2f((v * v) * (-0.72134752044f));
    const float m = v * (q * e);
    return v < 0.f ? m : v - m;
}
__device__ __forceinline__ float lo16(unsigned w) { return __uint_as_float(w << 16); }
__device__ __forceinline__ float hi16(unsigned w) { return __uint_as_float(w & 0xffff0000u); }
__device__ __forceinline__ void cvt_row(const float* __restrict__ src, unsigned char* __restrict__ q, float* __restrict__ scale, int row, int lane) {
    f32x4 x[8]; float am = 0.f;
#pragma unroll
    for (int j = 0; j < 8; ++j) { x[j] = __builtin_nontemporal_load((const f32x4*)(src + 256 * j + 4 * lane));        am = fmaxf(am, fmaxf(fmaxf(fabsf(x[j].x), fabsf(x[j].y)), fmaxf(fabsf(x[j].z), fabsf(x[j].w)))); }
#pragma unroll
    for (int o = 1; o < 64; o <<= 1) am = fmaxf(am, __shfl_xor(am, o));
    const float inv = am > 0.f ? 127.f / am : 0.f;
    if (lane == 0) scale[row] = am * (1.f / 127.f);
#pragma unroll
    for (int j = 0; j < 8; ++j) {
        const int q0 = (int)__builtin_rintf(x[j].x * inv), q1 = (int)__builtin_rintf(x[j].y * inv), q2 = (int)__builtin_rintf(x[j].z * inv), q3 = (int)__builtin_rintf(x[j].w * inv);
        const int w = (q0 & 255) | ((q1 & 255) << 8) | ((q2 & 255) << 16) | (int)((unsigned)q3 << 24);
        __builtin_nontemporal_store(w, (int*)(q + (size_t)(2 * j + (lane >> 5)) * CHB + (size_t)row * 128 + 4 * (lane & 31)));
    }
}
__device__ __forceinline__ void cvt_row4(const float* __restrict__ src, unsigned char* __restrict__ q, float* __restrict__ scale, int row, int lane) {
    f32x4 x[8]; float am = 0.f;
#pragma unroll
    for (int j = 0; j < 8; ++j) { x[j] = __builtin_nontemporal_load((const f32x4*)(src + 256 * j + 4 * lane));        am = fmaxf(am, fmaxf(fmaxf(fabsf(x[j].x), fabsf(x[j].y)), fmaxf(fabsf(x[j].z), fabsf(x[j].w)))); }
#pragma unroll
    for (int o = 1; o < 64; o <<= 1) am = fmaxf(am, __shfl_xor(am, o));
    const float inv = am > 0.f ? 6.f / am : 0.f;
    if (lane == 0) scale[row] = am * (1.f / 6.f);
#pragma unroll
    for (int j = 0; j < 8; ++j) {
        unsigned w = __builtin_amdgcn_cvt_scalef32_pk_fp4_f32(0u, x[j].x * inv, x[j].y * inv, 1.0f, 0);
        w = __builtin_amdgcn_cvt_scalef32_pk_fp4_f32(w, x[j].z * inv, x[j].w * inv, 1.0f, 1);
        __builtin_nontemporal_store((unsigned short)(w & 0xffffu), (unsigned short*)(q + (size_t)j * CHB + (size_t)row * 128 + 2 * lane));
    }
}
__device__ __forceinline__ void cvt_tables(const Args& a, int first, int stride, int lane) {
    for (int r = first; r < 2 * NEXP; r += stride) {
        if (r < NEXP) cvt_row(a.in[I_PU] + (size_t)r * D, a.ws + WS_UQ, (float*)(a.ws + WS_SU), r, lane);
        else cvt_row4(a.in[I_PV] + (size_t)(r - NEXP) * D, a.ws + WS_VQ, (float*)(a.ws + WS_SV), r - NEXP, lane);
    }
}
#define PE_DOT16(W, XQ, A) do { A = __builtin_amdgcn_sdot4((int)(W).x, (int)(XQ).x, A, false); A = __builtin_amdgcn_sdot4((int)(W).y, (int)(XQ).y, A, false); \
    A = __builtin_amdgcn_sdot4((int)(W).z, (int)(XQ).z, A, false); A = __builtin_amdgcn_sdot4((int)(W).w, (int)(XQ).w, A, false); } while (0)
#define PE_AX4(Wd, d, CF, Y) do { \
    Y[4 * (d) + 0] += __builtin_amdgcn_cvt_scalef32_pk_f32_fp4((Wd), 1.0f, 0) * CF; Y[4 * (d) + 1] += __builtin_amdgcn_cvt_scalef32_pk_f32_fp4((Wd), 1.0f, 1) * CF; \
    Y[4 * (d) + 2] += __builtin_amdgcn_cvt_scalef32_pk_f32_fp4((Wd), 1.0f, 2) * CF; Y[4 * (d) + 3] += __builtin_amdgcn_cvt_scalef32_pk_f32_fp4((Wd), 1.0f, 3) * CF; } while (0)
#define PE_AXPY32(W, CF, Y) do { PE_AX4((W).x, 0, CF, Y); PE_AX4((W).y, 1, CF, Y); PE_AX4((W).z, 2, CF, Y); PE_AX4((W).w, 3, CF, Y); } while (0)
#define PE_AX4I(Wd, d, CF, Y) do { \
    Y[4 * (d) + 0] = __builtin_amdgcn_cvt_scalef32_pk_f32_fp4((Wd), 1.0f, 0) * CF; Y[4 * (d) + 1] = __builtin_amdgcn_cvt_scalef32_pk_f32_fp4((Wd), 1.0f, 1) * CF; \
    Y[4 * (d) + 2] = __builtin_amdgcn_cvt_scalef32_pk_f32_fp4((Wd), 1.0f, 2) * CF; Y[4 * (d) + 3] = __builtin_amdgcn_cvt_scalef32_pk_f32_fp4((Wd), 1.0f, 3) * CF; } while (0)
#define PE_AXPY32I(W, CF, Y) do { PE_AX4I((W).x, 0, CF, Y); PE_AX4I((W).y, 1, CF, Y); PE_AX4I((W).z, 2, CF, Y); PE_AX4I((W).w, 3, CF, Y); } while (0)
__device__ __forceinline__ f32x2 shx2(f32x2 v, int m) { f32x2 r; r.x = __shfl_xor(v.x, m); r.y = __shfl_xor(v.y, m); return r; }
constexpr int TW = 4, PB = 4, PBU = 8;
__device__ __forceinline__ void wave_task(const Args& a, float* __restrict__ xbase, int t0, int lane, unsigned* __restrict__ ROW  , bf16_t* __restrict__ X2L  ) {
    const int g = lane >> 3, sub = lane & 7;
    const unsigned char* UQ = a.ws + WS_UQ; const unsigned char* VQ = a.ws + WS_VQ;
    const float* SU = (const float*)(a.ws + WS_SU); const float* SV = (const float*)(a.ws + WS_SV);
    const int* idx = (const int*)(a.ws + WS_IDX) + (size_t)t0 * 128; const float* coef = (const float*)(a.ws + WS_COEF) + (size_t)t0 * 128;
    const bf16_t* H2 = (const bf16_t*)(a.ws + WS_H) + (size_t)t0 * D;
    float acc[TW][16]; int iacc[TW][16]; u32x4 wv[PBU]; unsigned ro[PBU];
    const unsigned sub16 = 16u * sub;
#pragma unroll
    for (int tt = 0; tt < TW; ++tt) { ROW[tt * 128 + lane] = (unsigned)idx[tt * 128 + lane] * 128u; ROW[tt * 128 + 64 + lane] = (unsigned)idx[tt * 128 + 64 + lane] * 128u;
#pragma unroll
        for (int it = 0; it < 16; ++it) iacc[tt][it] = 0; }
#define ROFF(tt, e) (ROW[(tt) * 128 + 8 * (e) + g] + sub16)
    unsigned char* XQ = (unsigned char*)X2L; float sx[TW];
#pragma unroll
    for (int tt = 0; tt < TW; ++tt) {
        const bf16_t* hp = H2 + tt * D + 32 * lane; u32x4 r[4];
#pragma unroll
        for (int k = 0; k < 4; ++k) r[k] = *(const u32x4*)(hp + 8 * k);
        float v[32];
#pragma unroll
        for (int k = 0; k < 4; ++k) { v[8 * k] = lo16(r[k].x); v[8 * k + 1] = hi16(r[k].x); v[8 * k + 2] = lo16(r[k].y); v[8 * k + 3] = hi16(r[k].y); v[8 * k + 4] = lo16(r[k].z); v[8 * k + 5] = hi16(r[k].z); v[8 * k + 6] = lo16(r[k].w); v[8 * k + 7] = hi16(r[k].w); }
        float am = 0.f;
#pragma unroll
        for (int k = 0; k < 32; ++k) am = fmaxf(am, fabsf(v[k]));
#pragma unroll
        for (int o = 1; o < 64; o <<= 1) am = fmaxf(am, __shfl_xor(am, o));
        const float inv = am > 0.f ? 127.f / am : 0.f; sx[tt] = am * (1.f / 127.f);
        unsigned w[8];
#pragma unroll
        for (int k = 0; k < 8; ++k) { const int q0 = (int)__builtin_rintf(v[4 * k] * inv), q1 = (int)__builtin_rintf(v[4 * k + 1] * inv), q2 = (int)__builtin_rintf(v[4 * k + 2] * inv), q3 = (int)__builtin_rintf(v[4 * k + 3] * inv);
            w[k] = (unsigned)((q0 & 255) | ((q1 & 255) << 8) | ((q2 & 255) << 16)) | ((unsigned)q3 << 24); }
        *(u32x4*)(XQ + tt * 2048 + 32 * lane) = (u32x4){w[0], w[1], w[2], w[3]}; *(u32x4*)(XQ + tt * 2048 + 32 * lane + 16) = (u32x4){w[4], w[5], w[6], w[7]};
    }
    u32x4 wb[PBU];
#define UB_LOAD(W, tt, hb, coff) do { _Pragma("unroll") for (int i = 0; i < PBU; ++i) ro[i] = ROFF(tt, PBU * (hb) + i) + (coff);          \
        _Pragma("unroll") for (int i = 0; i < PBU; ++i) W[i] = *(const u32x4*)(UQ + (size_t)ro[i]); } while (0)
#define UB_DOT(W, tt, hb, XQV) do { _Pragma("unroll") for (int i = 0; i < PBU; ++i) PE_DOT16(W[i], XQV, iacc[tt][PBU * (hb) + i]); } while (0)
#define X_LOAD(XA, tt, c) do { XA = *(const u32x4*)(XQ + (tt) * 2048 + 128 * (c) + 16 * sub); } while (0)
#define U_TOKEN(tt, XA, XNA, ntt, nc, ncoff) do {                                                                                          \
        UB_LOAD(wb, tt, 1, coff); __builtin_amdgcn_sched_barrier(0); UB_DOT(wv, tt, 0, XA); __builtin_amdgcn_sched_barrier(0);                \
        UB_LOAD(wv, ntt, 0, ncoff); X_LOAD(XNA, ntt, nc); __builtin_amdgcn_sched_barrier(0); UB_DOT(wb, tt, 1, XA); __builtin_amdgcn_sched_barrier(0); } while (0)
    static_assert(PBU == 8 && TW == 4, "the pipelined U phase is written for 2 batches per token and 4 tokens per wave");
    { u32x4 xa0, xa1;
      UB_LOAD(wv, 0, 0, 0u); X_LOAD(xa0, 0, 0);
#pragma nounroll
      for (int c = 0; c < 16; ++c) {
        const unsigned coff = (unsigned)c << 21;
        const int cn = c < 15 ? c + 1 : 15; const unsigned coffn = (unsigned)cn << 21;
        U_TOKEN(0, xa0, xa1, 1, c, coff);
        U_TOKEN(1, xa1, xa0, 2, c, coff);
        U_TOKEN(2, xa0, xa1, 3, c, coff);
        U_TOKEN(3, xa1, xa0, 0, cn, coffn);
      } }
#undef U_TOKEN
#undef X_LOAD
#undef UB_DOT
#undef UB_LOAD
#pragma unroll
    for (int tt = 0; tt < TW; ++tt)
#pragma unroll
        for (int it = 0; it < 16; ++it) {
            int di = iacc[tt][it]; di += __shfl_xor(di, 1); di += __shfl_xor(di, 2); di += __shfl_xor(di, 4);
            const unsigned row = ROW[tt * 128 + 8 * it + g] >> 7;
            acc[tt][it] = coef[tt * 128 + 8 * it + g] * gelu_erf((float)di * (SU[row] * sx[tt])) * SV[row];
        }
    const int b = t0 / SEQ;
    const float* mod = (const float*)(a.ws + WS_MOD) + b * NMOD + 5 * D; const float* bada = a.in[I_BADA] + 5 * D; const float* fg = a.in[I_FNG];
    float* xo = xbase + (size_t)t0 * D; const bf16_t* X1 = (const bf16_t*)(a.ws + WS_X1B) + (size_t)t0 * D;
    const int cown = 32 * sub + ((lane >> 5) & 1) * 16 + ((lane >> 4) & 1) * 8 + ((lane >> 3) & 1) * 4;
    float ssq[TW];
#pragma unroll
    for (int tt = 0; tt < TW; ++tt) ssq[tt] = 0.f;
#define VB_LOAD(W, tt, hb, coff) do { _Pragma("unroll") for (int i = 0; i < PB; ++i) ro[i] = ROFF(tt, PB * (hb) + i) + (coff);             \
        _Pragma("unroll") for (int i = 0; i < PB; ++i) W[i] = *(const u32x4*)(VQ + (size_t)ro[i]); } while (0)
#define VB_AXPY(W, tt, hb) do { _Pragma("unroll") for (int i = 0; i < PB; ++i) { const float cf = acc[tt][PB * (hb) + i]; if ((hb) == 0 && i == 0) PE_AXPY32I(W[i], cf, y); else PE_AXPY32(W[i], cf, y); } } while (0)
    static_assert(PB == 4, "the pipelined V phase is written for 4 batches of 4 row pieces per token");
    VB_LOAD(wv, 0, 0, 0u);
#pragma nounroll
    for (int c = 0; c < 8; ++c) {
        const unsigned coff = (unsigned)c << 21;
        const unsigned coffn = (unsigned)(c < 7 ? c + 1 : 7) << 21;
        const int col = 256 * c + cown;
        u32x2 x1w[TW];
#pragma unroll
        for (int tt = 0; tt < TW; ++tt) x1w[tt] = *(const u32x2*)(X1 + tt * D + col);
        const f32x4 g2 = *(const f32x4*)(mod + col) + *(const f32x4*)(bada + col);
#pragma unroll
        for (int tt = 0; tt < TW; ++tt) {
            f32x2 y[16];
            VB_LOAD(wb, tt, 1, coff); __builtin_amdgcn_sched_barrier(0); VB_AXPY(wv, tt, 0); __builtin_amdgcn_sched_barrier(0);
            VB_LOAD(wv, tt, 2, coff); __builtin_amdgcn_sched_barrier(0); VB_AXPY(wb, tt, 1); __builtin_amdgcn_sched_barrier(0);
            VB_LOAD(wb, tt, 3, coff); __builtin_amdgcn_sched_barrier(0); VB_AXPY(wv, tt, 2); __builtin_amdgcn_sched_barrier(0);
            if (tt + 1 < TW) VB_LOAD(wv, tt + 1, 0, coff); else VB_LOAD(wv, 0, 0, coffn);
            __builtin_amdgcn_sched_barrier(0); VB_AXPY(wb, tt, 3); __builtin_amdgcn_sched_barrier(0);
#pragma unroll
            for (int i = 0; i < 8; ++i) {
                auto sx_ = __builtin_amdgcn_permlane32_swap(__float_as_uint(y[i].x), __float_as_uint(y[i + 8].x), false, false); auto sy_ = __builtin_amdgcn_permlane32_swap(__float_as_uint(y[i].y), __float_as_uint(y[i + 8].y), false, false);
                y[i] = (f32x2){__uint_as_float(sx_[0]), __uint_as_float(sy_[0])} + (f32x2){__uint_as_float(sx_[1]), __uint_as_float(sy_[1])}; }
#pragma unroll
            for (int i = 0; i < 4; ++i) {
                auto sx_ = __builtin_amdgcn_permlane16_swap(__float_as_uint(y[i].x), __float_as_uint(y[i + 4].x), false, false); auto sy_ = __builtin_amdgcn_permlane16_swap(__float_as_uint(y[i].y), __float_as_uint(y[i + 4].y), false, false);
                y[i] = (f32x2){__uint_as_float(sx_[0]), __uint_as_float(sy_[0])} + (f32x2){__uint_as_float(sx_[1]), __uint_as_float(sy_[1])}; }
#pragma unroll
            for (int i = 0; i < 2; ++i) { const f32x2 snd = (lane & 8) ? y[i] : y[i + 2]; const f32x2 kp = (lane & 8) ? y[i + 2] : y[i]; y[i] = kp + shx2(snd, 8); }
            const f32x4 x1 = {__uint_as_float(x1w[tt].x << 16), __uint_as_float(x1w[tt].x & 0xffff0000u), __uint_as_float(x1w[tt].y << 16), __uint_as_float(x1w[tt].y & 0xffff0000u)};
            const f32x4 v = x1 + g2 * (f32x4){y[0].x, y[0].y, y[1].x, y[1].y};
            ssq[tt] += (v.x * v.x + v.y * v.y) + (v.z * v.z + v.w * v.w);
            { u32x2 w; w.x = pk2(v.x, v.y); w.y = pk2(v.z, v.w); *(u32x2*)(X2L + tt * D + col) = w; }
        }
    }
#undef VB_AXPY
#undef VB_LOAD
    float rstd[TW];
#pragma unroll
    for (int tt = 0; tt < TW; ++tt) rstd[tt] = rsqrtf(wave_sum(ssq[tt]) * (1.f / D) + RMS_EPS);
#pragma nounroll
    for (int c = 0; c < 8; ++c) {
        const int col = 256 * c + cown; const f32x4 gg = *(const f32x4*)(fg + col);
#pragma unroll
        for (int tt = 0; tt < TW; ++tt) { const u32x2 w = *(const u32x2*)(X2L + tt * D + col);
            const f32x4 v = {__uint_as_float(w.x << 16), __uint_as_float(w.x & 0xffff0000u), __uint_as_float(w.y << 16), __uint_as_float(w.y & 0xffff0000u)};
            __builtin_nontemporal_store(v * rstd[tt] * gg, (f32x4*)(xo + tt * D + col)); }
    }
#undef ROFF
}
}

__global__ void __launch_bounds__(NTHR, 2) fwd_kernel(Args a) {
    extern __shared__ __attribute__((aligned(16))) unsigned char lds[];
    const int tid = threadIdx.x, lane = tid & 63, wave = __builtin_amdgcn_readfirstlane(tid >> 6);
    const int G = gridDim.x, bx = blockIdx.x, vcu = (G % 8 == 0) ? (bx % 8) * (G / 8) + bx / 8 : bx;
    unsigned char* ws = a.ws;
    const int lo = a.ph_lo, hi_ = a.ph_hi;
#if ONE_LAUNCH && SYNC_XCD
    volatile LAS unsigned* bst = (volatile LAS unsigned*)((LAS unsigned char*)lds + LDS_BYTES - 16);
    if (tid < 4) bst[tid] = 0u;
    __syncthreads();
    const XcdBarrier bar = xcd_barrier_post((unsigned*)(ws + WS_CTL) + 1024, bst);
#define SEAM(k) do { if (lo <= (k) && (k) + 1 < hi_) xcd_barrier(bar); } while (0)
#define SEAM_ALWAYS() xcd_barrier(bar)
#elif ONE_LAUNCH
    cg::grid_group grid = cg::this_grid();
#define SEAM(k) do { if (lo <= (k) && (k) + 1 < hi_) grid.sync(); } while (0)
#define SEAM_ALWAYS() grid.sync()
#else
#define SEAM(k) do { } while (0)
#define SEAM_ALWAYS() do { } while (0)
#endif
#ifndef PHASE_MASK
#define PHASE_MASK 0x7ff
#endif
#define IN(k) ((((PHASE_MASK) >> (k)) & 1) && lo <= (k) && (k) < hi_)
    bf16_t* PARTS = (bf16_t*)(ws + WS_PARTS); bf16_t* MIX = (bf16_t*)(ws + WS_MIX);
    const float* sm = (const float*)(ws + WS_SMALL);
#ifndef REPEAT_MASK
#define REPEAT_MASK 0
#endif
#define NREP(k) ((((REPEAT_MASK) >> (k)) & 1) ? 2 : 1)
#define RSEAM(k, rep) do { if ((rep) + 1 < NREP(k)) { SEAM_ALWAYS(); } else { SEAM(k); } } while (0)
    if (IN(0)) {
        p0_prologue(a, lds, vcu, G, tid, lane, wave);
        if (tid == 0) { unsigned* mc = (unsigned*)(ws + WS_CTL) + 12288; unsigned sp = 0;
            while (__hip_atomic_load(mc, __ATOMIC_RELAXED, __HIP_MEMORY_SCOPE_AGENT) < (G < 192 ? (unsigned)G : 192u)) { __builtin_amdgcn_s_sleep(2); if (++sp > (1u << 22)) break; }
            __builtin_amdgcn_fence(__ATOMIC_ACQUIRE, "agent"); }
        asm volatile("s_waitcnt vmcnt(0)" ::: "memory"); __syncthreads();
        norm_phase<0>(a, vcu, G, lane, wave);
        SEAM(0);
    }
    if (IN(2)) for (int rep = 0; rep < NREP(2); ++rep) {
        pg8::Gemm g{(const bf16_t*)(ws + WS_H), (const bf16_t*)(ws + WS_WIN), M1, NIN, D};
        pg8::OrderIn S{G, bx};
        pg8::EpiIn E{PARTS, sm, sm + 4096, sm + 5120, (bf16_t*)(ws + WS_KH), (bf16_t*)(ws + WS_VH)};
        pg8::gemm_phase<pg8::EpiIn, pg8::OrderIn, true, true>((LAS unsigned char*)lds, g, S, E);
        if (G == 256) { if (bx >= 40) pe::cvt_tables(a, (bx - 40) * NWAVES + wave, 216 * NWAVES, lane); }
        else pe::cvt_tables(a, bx * NWAVES + wave, G * NWAVES, lane);
        RSEAM(2, rep);
    }
#define MERGED345 (ONE_LAUNCH && ((REPEAT_MASK) & 0x38) == 0 && (PHASE_MASK) == 0x7ff)
#if MERGED345
    if (lo <= 3 && 5 < hi_) {
        unsigned* const c1 = (unsigned*)(ws + WS_CTL) + 12352; unsigned* const c2 = (unsigned*)(ws + WS_CTL) + 12416;
        const float lam = sm[2048];
        for (int u = vcu; u < 512; u += G) { const int chain = u >> 4, j = u & 15; hg::task_trans(PARTS, (float*)(ws + WS_HST), (float*)(ws + WS_HD), chain >> 4, (chain >> 1) & 7, chain & 1, j, (char*)lds); }
        asm volatile("s_waitcnt vmcnt(0)" ::: "memory"); __syncthreads();
        if (tid == 0) __hip_atomic_fetch_add(c1, 1u, __ATOMIC_RELAXED, __HIP_MEMORY_SCOPE_AGENT);
        for (int u = vcu; u < 256; u += G) { const int bh = (u >> 5); att::attn_unit(PARTS, (const bf16_t*)(ws + WS_KH), (const bf16_t*)(ws + WS_VH), MIX, a.in[I_SUBG], lam, bh >> 3, bh & 7, u & 31, (char*)lds); }
        if (tid == 0) { unsigned sp = 0;
            while (__hip_atomic_load(c1, __ATOMIC_RELAXED, __HIP_MEMORY_SCOPE_AGENT) < (unsigned)G) { __builtin_amdgcn_s_sleep(2); if (++sp > (1u << 22)) break; }
            __builtin_amdgcn_fence(__ATOMIC_ACQUIRE, "agent"); }
        asm volatile("s_waitcnt vmcnt(0) lgkmcnt(0)" ::: "memory"); __syncthreads();
        hg::scan_phase((float*)(ws + WS_HST), (const float*)(ws + WS_HD), vcu, G, tid);
        asm volatile("s_waitcnt vmcnt(0)" ::: "memory"); __syncthreads();
#if SYNC_XCD
        if (tid == 0) {
            const unsigned nloc = bst[0] ? bst[0] : 1u;
            const unsigned old = __hip_atomic_fetch_add((unsigned*)(ws + WS_CTL) + 16704 + 64 * bar.x, 1u, __ATOMIC_RELAXED, __HIP_MEMORY_SCOPE_AGENT);
            if (old + 1u == nloc) { __builtin_amdgcn_fence(__ATOMIC_RELEASE, "agent"); asm volatile("s_waitcnt vmcnt(0)" ::: "memory");
                __hip_atomic_fetch_add(c2, nloc, __ATOMIC_RELAXED, __HIP_MEMORY_SCOPE_AGENT); } }
#else
        if (tid == 0) { __builtin_amdgcn_fence(__ATOMIC_RELEASE, "agent"); asm volatile("s_waitcnt vmcnt(0)" ::: "memory");
            __hip_atomic_fetch_add(c2, 1u, __ATOMIC_RELAXED, __HIP_MEMORY_SCOPE_AGENT); }
#endif
        for (int u = vcu; u < 256; u += G) { const int bh = (u >> 5) + 8; att::attn_unit(PARTS, (const bf16_t*)(ws + WS_KH), (const bf16_t*)(ws + WS_VH), MIX, a.in[I_SUBG], lam, bh >> 3, bh & 7, u & 31, (char*)lds); }
        if (tid == 0) { unsigned sp = 0;
            while (__hip_atomic_load(c2, __ATOMIC_RELAXED, __HIP_MEMORY_SCOPE_AGENT) < (unsigned)G) { __builtin_amdgcn_s_sleep(2); if (++sp > (1u << 22)) break; }
            __builtin_amdgcn_fence(__ATOMIC_ACQUIRE, "agent"); }
        asm volatile("s_waitcnt vmcnt(0) lgkmcnt(0)" ::: "memory"); __syncthreads();
        for (int u = vcu; u < 256; u += G) hg::task_out(PARTS, MIX, (const float*)(ws + WS_HST), (float*)(ws + WS_OF), a.in[I_HGNG], u >> 7, (u >> 4) & 7, u & 15, (char*)lds);
        SEAM(5);
    }
#else
    if (IN(3)) for (int rep = 0; rep < NREP(3); ++rep) {
        { const float lam = sm[2048];
          for (int u = vcu; u < 256; u += G) { const int bh = (u >> 5); att::attn_unit(PARTS, (const bf16_t*)(ws + WS_KH), (const bf16_t*)(ws + WS_VH), MIX, a.in[I_SUBG], lam, bh >> 3, bh & 7, u & 31, (char*)lds); } }
        for (int u = vcu; u < 512; u += G) { const int chain = u >> 4, j = u & 15; hg::task_trans(PARTS, (float*)(ws + WS_HST), (float*)(ws + WS_HD), chain >> 4, (chain >> 1) & 7, chain & 1, j, (char*)lds); }
#if ONE_LAUNCH
        if (rep + 1 < NREP(3)) { SEAM_ALWAYS(); }
        else if (lo <= 3 && 4 < hi_) {
            asm volatile("s_waitcnt vmcnt(0)" ::: "memory"); __syncthreads();
            if (tid == 0) __hip_atomic_fetch_add((unsigned*)(ws + WS_CTL) + 12352, 1u, __ATOMIC_RELAXED, __HIP_MEMORY_SCOPE_AGENT);
        }
#else
        RSEAM(3, rep);
#endif
    }
    if (IN(4)) for (int rep = 0; rep < NREP(4); ++rep) {
        { const float lam = sm[2048];
          for (int u = vcu; u < 256; u += G) { const int bh = (u >> 5) + 8; att::attn_unit(PARTS, (const bf16_t*)(ws + WS_KH), (const bf16_t*)(ws + WS_VH), MIX, a.in[I_SUBG], lam, bh >> 3, bh & 7, u & 31, (char*)lds); } }
#if ONE_LAUNCH
        if (rep == 0 && lo <= 3) {
            if (tid == 0) { unsigned* tc = (unsigned*)(ws + WS_CTL) + 12352; unsigned sp = 0;
                while (__hip_atomic_load(tc, __ATOMIC_RELAXED, __HIP_MEMORY_SCOPE_AGENT) < (unsigned)G) { __builtin_amdgcn_s_sleep(2); if (++sp > (1u << 22)) break; }
                __builtin_amdgcn_fence(__ATOMIC_ACQUIRE, "agent"); }
            asm volatile("s_waitcnt vmcnt(0) lgkmcnt(0)" ::: "memory"); __syncthreads();
        }
#endif
        if (rep == 0) hg::scan_phase((float*)(ws + WS_HST), (const float*)(ws + WS_HD), vcu, G, tid);
        RSEAM(4, rep);
    }
    if (IN(5)) for (int rep = 0; rep < NREP(5); ++rep) {
        for (int u = vcu; u < 256; u += G) hg::task_out(PARTS, MIX, (const float*)(ws + WS_HST), (float*)(ws + WS_OF), a.in[I_HGNG], u >> 7, (u >> 4) & 7, u & 15, (char*)lds);
        RSEAM(5, rep);
    }
#endif
    if (IN(6)) for (int rep = 0; rep < NREP(6); ++rep) {
        pg8::Gemm g{MIX, (const bf16_t*)(ws + WS_WOUT), ML, D, D};
        pg8::StaticOrder S; S.init(ML, D, G, bx);
        if (G == 256) {
            pg8::EpiOutNorm E{a.in[I_X], (bf16_t*)(ws + WS_X1B), (bf16_t*)(ws + WS_H), (const float*)(ws + WS_MOD), a.in[I_BADA], a.in[I_N2G], (unsigned*)(ws + WS_HD + 512 * 1024), (unsigned*)(ws + WS_CTL) + 8192};
            pg8::gemm_phase<pg8::EpiOutNorm, pg8::StaticOrder, false, true>((LAS unsigned char*)lds, g, S, E);
        } else {
            pg8::EpiOut E{a.in[I_X], (bf16_t*)(ws + WS_X1B), (const float*)(ws + WS_MOD), a.in[I_BADA]};
            pg8::gemm_phase<pg8::EpiOut, pg8::StaticOrder, true, true>((LAS unsigned char*)lds, g, S, E);
        }
        RSEAM(6, rep);
    }
    if (IN(7) && G != 256) for (int rep = 0; rep < NREP(7); ++rep) { norm_phase<1>(a, vcu, G, lane, wave); RSEAM(7, rep); }
    if (IN(8)) for (int rep = 0; rep < NREP(8); ++rep) {
        pg8::Gemm g{(const bf16_t*)(ws + WS_H), (const bf16_t*)(ws + WS_WQ), ML, D, D};
        pg8::StaticOrder S; S.init(ML, D, G, bx);
        if (G == 256) {
            pg8::EpiLds E{};
            pg8::gemm_phase<pg8::EpiLds, pg8::StaticOrder, false, true>((LAS unsigned char*)lds, g, S, E);
            asm volatile("s_waitcnt lgkmcnt(0)" ::: "memory"); __syncthreads();
            pg8::Unit uu; S.next(0, uu);
            for (int hb = 0; hb < 2; ++hb)
                tk::task((const bf16_t*)lds + hb * 128 * pg8::EpiLds::PITCH, pg8::EpiLds::PITCH, (const bf16_t*)(ws + WS_SMALL + 512 * 1024), (int*)(ws + WS_IDX), (float*)(ws + WS_COEF), 2 * uu.pm + hb, uu.pn, (char*)lds + 256 * pg8::EpiLds::PITCH * 2);
        } else {
            pg8::EpiBf16<0> E{(bf16_t*)(ws + WS_QP), D, nullptr, 0, 0, 1.f};
            pg8::gemm_phase<pg8::EpiBf16<0>, pg8::StaticOrder, true, true>((LAS unsigned char*)lds, g, S, E);
            asm volatile("s_waitcnt vmcnt(0)" ::: "memory"); __syncthreads();
            pg8::Unit uu; for (int i = 0; S.next(i, uu); ++i) for (int hb = 0; hb < 2; ++hb)
                tk::task((const bf16_t*)(ws + WS_QP) + (size_t)((2 * uu.pm + hb) * 128) * D + uu.pn * 256, D, (const bf16_t*)(ws + WS_SMALL + 512 * 1024), (int*)(ws + WS_IDX), (float*)(ws + WS_COEF), 2 * uu.pm + hb, uu.pn, (char*)lds);
        }
        RSEAM(8, rep);
    }
    if (IN(10)) for (int rep = 0; rep < NREP(10); ++rep) {
        const int gw = vcu * NWAVES + wave, NGW = G * NWAVES;
        float* xb = (rep + 1 < NREP(10)) ? (float*)(ws + WS_PARTS + 32 * MiB) : a.out;
        for (int t4 = gw; t4 < ML / pe::TW; t4 += NGW) pe::wave_task(a, xb, pe::TW * t4, lane, (unsigned*)lds + wave * (pe::TW * 128), (bf16_t*)(lds + 16384) + wave * (pe::TW * D));
        if (rep + 1 < NREP(10)) SEAM_ALWAYS();
    }
#undef IN
#undef SEAM
#undef SEAM_ALWAYS
}

constexpr int N_PHASES = 11;
extern "C" void kernel_launch(void* const* d_in, const int* in_sizes, int n_in, void* d_out, int out_size, void* d_ws, size_t ws_size, hipStream_t stream) {
    static int grid = 0;
    if (grid == 0) {
        if (n_in != 22 || out_size != ML * D || ws_size < WS_END) { fprintf(stderr, "kernel_launch: unexpected shapes (n_in %d out %d ws %zu, need ws >= %zu); nothing launched\n", n_in, out_size, ws_size, (size_t)WS_END); grid = -1; return; }
        int dev = 0, cus = 0, per_cu = 0;
        if (hipGetDevice(&dev) != hipSuccess || hipDeviceGetAttribute(&cus, hipDeviceAttributeMultiprocessorCount, dev) != hipSuccess) { fprintf(stderr, "kernel_launch: device query failed\n"); grid = -1; return; }
        if (hipFuncSetAttribute((const void*)fwd_kernel, hipFuncAttributeMaxDynamicSharedMemorySize, LDS_BYTES) != hipSuccess) { fprintf(stderr, "kernel_launch: hipFuncSetAttribute failed\n"); grid = -1; return; }
        if (hipOccupancyMaxActiveBlocksPerMultiprocessor(&per_cu, (const void*)fwd_kernel, NTHR, LDS_BYTES) != hipSuccess || per_cu < 1) { fprintf(stderr, "kernel_launch: occupancy query says %d blocks per CU\n", per_cu); (void)hipGetLastError(); grid = -1; return; }
        grid = cus;
        if (grid > 256) grid = 256;
    }
    if (grid < 0) return;
    (void)hipMemsetAsync((char*)d_ws + WS_CTL, 0, CTL_BYTES, stream);
    Args a{};
    for (int i = 0; i < 22; ++i) a.in[i] = (const float*)d_in[i];
    a.out = (float*)d_out; a.ws = (unsigned char*)d_ws;
#if ONE_LAUNCH
    a.ph_lo = 0; a.ph_hi = N_PHASES;
    void* args[] = {&a};
    hipError_t e = hipLaunchCooperativeKernel((const void*)fwd_kernel, dim3(grid), dim3(NTHR), args, LDS_BYTES, stream);
    if (e != hipSuccess) fprintf(stderr, "kernel_launch: cooperative launch failed: %s (grid %d)\n", hipGetErrorString(e), grid);
#else
    for (int k = 0; k < N_PHASES; ++k) { a.ph_lo = k; a.ph_hi = k + 1; hipLaunchKernelGGL(fwd_kernel, dim3(grid), dim3(NTHR), LDS_BYTES, stream, a); }
    const hipError_t le = hipPeekAtLastError();
    if (le != hipSuccess) fprintf(stderr, "kernel_launch: launch failed: %s\n", hipGetErrorName(le));
#endif
}
```
